# Optimizing an MI355X kernel written in HIP

```python
import jax, jax.numpy as jnp
from jax import lax
import numpy as np

D_MODEL = 1024
BATCH = 4
SEQ = 8192
DEPTH = 1

N_META = 16
D_MIX = D_MODEL
D_CONV = D_MIX // 2
D_POOL = D_MIX - D_CONV
CONV_HEADS = 8
CONV_WIDTH = 3
POOL_WINDOWS = (2, 4, 8, 16)
N_POOL_GROUPS = len(POOL_WINDOWS)
POOL_GROUP_DIM = D_POOL // N_POOL_GROUPS
D_IN_PROJ = 3 * D_CONV + D_POOL
N_EXPERT_GROUPS = 4
EXPERTS_PER_GROUP = 8
N_EXPERTS = N_EXPERT_GROUPS * EXPERTS_PER_GROUP
TOP_K = 2
D_EXPERT = D_MODEL // 4
EPS = 1e-6

kernel_name = 'hymba_conv_pool_hier_moe_layer'


def rmsnorm(x, g):
    xf = x.astype(jnp.float32)
    y = xf * lax.rsqrt(jnp.mean(xf * xf, axis=-1, keepdims=True) + EPS)
    return (y * g.astype(jnp.float32)).astype(x.dtype)


def short_conv_mixer(b_gate, c_gate, v, conv_w):
    L = v.shape[1]
    u = c_gate * v
    up = jnp.pad(u, ((0, 0), (CONV_WIDTH - 1, 0), (0, 0)))
    conv = conv_w[0] * up[:, 0:L]
    for k in range(1, CONV_WIDTH):
        conv = conv + conv_w[k] * up[:, k:k + L]
    return b_gate * conv


def pool_mixer(v, pool_w, pool_scale):
    Bn, L, _ = v.shape
    vf = v.astype(jnp.float32)
    cs = jnp.concatenate([jnp.zeros((Bn, 1, D_POOL), jnp.float32),
                          jnp.cumsum(vf, axis=1)], axis=1)
    pos = jnp.arange(L, dtype=jnp.int32)
    outs = []
    for g, w in enumerate(POOL_WINDOWS):
        sl = slice(g * POOL_GROUP_DIM, (g + 1) * POOL_GROUP_DIM)
        csg = cs[:, :, sl]
        upper = csg[:, 1:]
        lower = jnp.pad(csg[:, :L + 1 - w], ((0, 0), (w - 1, 0), (0, 0)))
        count = jnp.minimum(pos + 1, w).astype(jnp.float32)[None, :, None]
        outs.append((upper - lower) / count - vf[:, :, sl])
    pooled = jnp.stack(outs, axis=2).astype(v.dtype)
    mixed = jnp.einsum('blgc,gcd->blgd', pooled, pool_w)
    return mixed.reshape(Bn, L, D_POOL) * pool_scale


def hierarchical_moe(h, w_router_group, w_router_expert, w_gate, w_up, w_down):
    T = h.shape[0]
    lg = jnp.einsum('td,dg->tg', h, w_router_group).astype(jnp.float32)
    pg = jax.nn.softmax(lg, axis=-1)
    gsel = jnp.argmax(lg, axis=-1)
    g1 = jnp.take_along_axis(pg, gsel[:, None], axis=-1)
    le = jnp.einsum('td,de->te', h, w_router_expert).astype(jnp.float32)
    le = le.reshape(T, N_EXPERT_GROUPS, EXPERTS_PER_GROUP)
    le_sel = jnp.take_along_axis(le, gsel[:, None, None], axis=1)[:, 0]
    pe = jax.nn.softmax(le_sel, axis=-1)
    topv, topi = lax.top_k(pe, TOP_K)
    topv = topv / jnp.sum(topv, axis=-1, keepdims=True)
    within = jnp.sum(jax.nn.one_hot(topi, EXPERTS_PER_GROUP, dtype=jnp.float32)
                     * topv[..., None], axis=1)
    group_gate = jax.nn.one_hot(gsel, N_EXPERT_GROUPS, dtype=jnp.float32) * g1
    gates = (group_gate[:, :, None] * within[:, None, :]).reshape(T, N_EXPERTS).astype(h.dtype)
    out = jnp.zeros_like(h)
    for e in range(N_EXPERTS):
        a = jax.nn.silu(h @ w_gate[e]) * (h @ w_up[e])
        out = out + gates[:, e:e + 1] * (a @ w_down[e])
    return out


def setup_inputs(seed: int = 0) -> dict:
    key = jax.random.key(seed)
    ks = jax.random.split(key, 20)
    f32 = jnp.float32
    nrm = lambda k, shape, s: jax.random.normal(k, shape, f32) * s
    gain = lambda k, shape: 1.0 + 0.02 * jax.random.normal(k, shape, f32)
    return {
        'x': jax.random.normal(ks[0], (BATCH, SEQ, D_MODEL), f32),
        'meta_tokens': nrm(ks[1], (N_META, D_MODEL), 1.0),
        'norm_mix': gain(ks[2], (DEPTH, D_MODEL)),
        'w_in': nrm(ks[3], (DEPTH, D_MODEL, D_IN_PROJ), D_MODEL ** -0.5),
        'conv_w': nrm(ks[4], (DEPTH, CONV_WIDTH, D_CONV), CONV_WIDTH ** -0.5),
        'norm_conv_out': gain(ks[5], (DEPTH, D_CONV)),
        'pool_w': nrm(ks[6], (DEPTH, N_POOL_GROUPS, POOL_GROUP_DIM, POOL_GROUP_DIM), POOL_GROUP_DIM ** -0.5),
        'pool_scale': gain(ks[7], (DEPTH, D_POOL)) + 0.1 * jax.random.normal(ks[8], (DEPTH, D_POOL), f32),
        'norm_pool_out': gain(ks[9], (DEPTH, D_POOL)),
        'w_out': nrm(ks[10], (DEPTH, D_MIX, D_MODEL), D_MIX ** -0.5),
        'norm_ffn': gain(ks[11], (DEPTH, D_MODEL)),
        'w_router_group': nrm(ks[12], (DEPTH, D_MODEL, N_EXPERT_GROUPS), D_MODEL ** -0.5),
        'w_router_expert': nrm(ks[13], (DEPTH, D_MODEL, N_EXPERTS), D_MODEL ** -0.5),
        'w_gate': nrm(ks[14], (DEPTH, N_EXPERTS, D_MODEL, D_EXPERT), D_MODEL ** -0.5),
        'w_up': nrm(ks[15], (DEPTH, N_EXPERTS, D_MODEL, D_EXPERT), D_MODEL ** -0.5),
        'w_down': nrm(ks[16], (DEPTH, N_EXPERTS, D_EXPERT, D_MODEL), D_EXPERT ** -0.5),
        'final_norm': gain(ks[17], (D_MODEL,)),
    }


def reference(x, meta_tokens, norm_mix, w_in, conv_w, norm_conv_out, pool_w, pool_scale,
              norm_pool_out, w_out, norm_ffn, w_router_group, w_router_expert,
              w_gate, w_up, w_down, final_norm):
    Bn = x.shape[0]
    meta = jnp.broadcast_to(meta_tokens.astype(x.dtype)[None], (Bn, N_META, D_MODEL))
    h = jnp.concatenate([meta, x], axis=1)
    L = h.shape[1]
    for layer in range(DEPTH):
        hn = rmsnorm(h, norm_mix[layer])
        proj = jnp.einsum('bld,dc->blc', hn, w_in[layer])
        b_gate = proj[..., 0:D_CONV]
        c_gate = proj[..., D_CONV:2 * D_CONV]
        v_conv = proj[..., 2 * D_CONV:3 * D_CONV]
        v_pool = proj[..., 3 * D_CONV:]
        y_conv = rmsnorm(short_conv_mixer(b_gate, c_gate, v_conv, conv_w[layer]), norm_conv_out[layer])
        y_pool = rmsnorm(pool_mixer(v_pool, pool_w[layer], pool_scale[layer]), norm_pool_out[layer])
        y = jnp.concatenate([y_conv, y_pool], axis=-1)
        h = h + jnp.einsum('blc,cd->bld', y, w_out[layer])
        hf = rmsnorm(h, norm_ffn[layer]).reshape(Bn * L, D_MODEL)
        moe = hierarchical_moe(hf, w_router_group[layer], w_router_expert[layer],
                               w_gate[layer], w_up[layer], w_down[layer])
        h = h + moe.reshape(Bn, L, D_MODEL)
    out = rmsnorm(h, final_norm)
    return out[:, N_META:]
```

```cpp
#include <hip/hip_runtime.h>
#include <hip/hip_cooperative_groups.h>
#include <cstdio>
#include <cstdint>
namespace cg = cooperative_groups;
#define MEGA 1
#define FAST_P2 1

typedef unsigned short bf16_t;
typedef short bf16x8 __attribute__((ext_vector_type(8)));
typedef float f32x4 __attribute__((ext_vector_type(4)));
typedef unsigned u32x4 __attribute__((ext_vector_type(4)));

constexpr int T = 32768, SEQ = 8192, D = 1024, NP = 2048, DC = 512, NE = 32, DE = 256, NBUCK = 112;
constexpr float EPS = 1e-6f;
constexpr size_t MiB = 1024 * 1024;
constexpr size_t OFF_A = 0;
constexpr size_t OFF_B = 64 * MiB;
constexpr size_t OFF_C = 192 * MiB;
constexpr size_t OFF_WIN = 256 * MiB;
constexpr size_t OFF_WOUT = 260 * MiB;
constexpr size_t OFF_WGU = 262 * MiB;
constexpr size_t OFF_WD = 294 * MiB;
constexpr size_t OFF_POOL = 310 * MiB;
constexpr size_t OFF_WR = OFF_POOL + 128 * 1024;
constexpr size_t OFF_PM = OFF_WR + 128 * 1024;
constexpr size_t OFF_RSTD1 = OFF_PM + 64 * 1024;
constexpr size_t OFF_SSQ2 = OFF_RSTD1 + 128 * 1024;
constexpr size_t OFF_RT = OFF_SSQ2 + 2 * MiB;
constexpr size_t OFF_CNT = OFF_RT + 512 * 1024;
constexpr size_t OFF_EL = OFF_CNT + 4096;
constexpr size_t OFF_PL = OFF_EL + 4 * MiB;
constexpr size_t WS_END = OFF_PL + 14 * MiB;

struct Params {
    const float *x, *meta, *norm_mix, *w_in, *conv_w, *norm_conv_out, *pool_w, *pool_scale, *norm_pool_out, *w_out, *norm_ffn,
        *w_rg, *w_re, *w_gate, *w_up, *w_down, *final_norm;
    float* out;
    unsigned char* ws;
};

__device__ __forceinline__ float bf2f(bf16_t v) { return __uint_as_float(((unsigned)v) << 16); }
__device__ __forceinline__ bf16_t f2bf(float f) { unsigned u = __float_as_uint(f); u += 0x7fffu + ((u >> 16) & 1u); return (bf16_t)(u >> 16); }
__device__ __forceinline__ unsigned pack2(float lo, float hi) { return (unsigned)f2bf(lo) | ((unsigned)f2bf(hi) << 16); }
__device__ __forceinline__ float wave_sum(float v) {
#pragma unroll
    for (int o = 32; o > 0; o >>= 1) v += __shfl_xor(v, o);
    return v;
}
__device__ __forceinline__ int pair_off(int a) { return a * 8 - (a * (a + 1)) / 2; }

template <class RowMap>
__device__ __forceinline__ void tr_tile(float* tile  , const float* src, int ld_src, bf16_t* dst, int ld_dst, int k0, int n0, const float* kscale, RowMap dstrow) {
    const int t = threadIdx.x;
#pragma unroll
    for (int i = 0; i < 8; ++i) {
        const int idx = t + 512 * i, k = idx >> 6, n = idx & 63;
        float v = src[(size_t)(k0 + k) * ld_src + n0 + n];
        if (kscale) v *= kscale[k0 + k];
        tile[k * 65 + n] = v;
    }
    __syncthreads();
    {
        const int n = t >> 3, ko = t & 7;
        unsigned w[4];
#pragma unroll
        for (int j = 0; j < 4; ++j) w[j] = pack2(tile[(ko * 8 + 2 * j) * 65 + n], tile[(ko * 8 + 2 * j + 1) * 65 + n]);
        *(uint4*)(dst + (size_t)dstrow(n0 + n) * ld_dst + k0 + ko * 8) = make_uint4(w[0], w[1], w[2], w[3]);
    }
    __syncthreads();
}

constexpr int P0_XROWS = 4096;
constexpr int P0_WIN = 16 * 32, P0_WOUT = 16 * 16, P0_GATE = 32 * 16 * 4, P0_UP = P0_GATE, P0_DOWN = 32 * 4 * 16, P0_POOL = 16, P0_WR = 16, P0_PM = 32, P0_CNT = 1;
constexpr int P0_ITEMS = P0_XROWS + P0_WIN + P0_WOUT + P0_GATE + P0_UP + P0_DOWN + P0_POOL + P0_WR + P0_PM + P0_CNT;

__device__ __forceinline__ void phase0(const Params& p, unsigned char* lds, int bid, int nb) {
    float* tile = (float*)lds;
    const int t = threadIdx.x, wid = t >> 6, lane = t & 63;
    bf16_t* xb = (bf16_t*)(p.ws + OFF_A);
    float* rstd1 = (float*)(p.ws + OFF_RSTD1);
    for (int it = bid; it < P0_ITEMS; it += nb) {
        int i = it;
        if (i < P0_XROWS) {
            const int r = i * 8 + wid;
            const float* xr = p.x + (size_t)r * D;
            float ss = 0.f;
#pragma unroll
            for (int j = 0; j < 2; ++j) {
                const int c = j * 512 + lane * 8;
                const float4 a = *(const float4*)(xr + c), b = *(const float4*)(xr + c + 4);
                ss += a.x * a.x + a.y * a.y + a.z * a.z + a.w * a.w + b.x * b.x + b.y * b.y + b.z * b.z + b.w * b.w;
                *(uint4*)(xb + (size_t)r * D + c) = make_uint4(pack2(a.x, a.y), pack2(a.z, a.w), pack2(b.x, b.y), pack2(b.z, b.w));
            }
            ss = wave_sum(ss);
            if (lane == 0) rstd1[r] = rsqrtf(ss * (1.0f / D) + EPS);
            continue;
        }
        i -= P0_XROWS;
        if (i < P0_WIN) { const int kt = i & 15, nt = i >> 4;
            tr_tile(tile, p.w_in, NP, (bf16_t*)(p.ws + OFF_WIN), D, kt * 64, nt * 64, p.norm_mix, [](int n) { return n; }); continue; }
        i -= P0_WIN;
        if (i < P0_WOUT) { const int kt = i & 15, nt = i >> 4;
            const int k0 = kt * 64;
            const float* ks = (k0 < DC) ? (p.norm_conv_out) : (p.norm_pool_out - DC);
            tr_tile(tile, p.w_out, D, (bf16_t*)(p.ws + OFF_WOUT), D, k0, nt * 64, ks, [](int n) { return n; }); continue; }
        i -= P0_WOUT;
        if (i < P0_GATE + P0_UP) { const int up = i >= P0_GATE; if (up) i -= P0_GATE;
            const int e = i >> 6, kt = (i >> 2) & 15, nt = i & 3;
            const float* src = (up ? p.w_up : p.w_gate) + (size_t)e * D * DE;
            bf16_t* dst = (bf16_t*)(p.ws + OFF_WGU) + (size_t)e * 512 * D;
            tr_tile(tile, src, DE, dst, D, kt * 64, nt * 64, nullptr, [up](int h) { return ((h >> 5) << 6) + (h & 31) + (up ? 32 : 0); }); continue; }
        i -= P0_GATE + P0_UP;
        if (i < P0_DOWN) { const int e = i >> 6, kt = (i >> 4) & 3, nt = i & 15;
            tr_tile(tile, p.w_down + (size_t)e * DE * D, D, (bf16_t*)(p.ws + OFF_WD) + (size_t)e * D * DE, DE, kt * 64, nt * 64, nullptr, [](int n) { return n; }); continue; }
        i -= P0_DOWN;
        if (i < P0_POOL) { const int g = i >> 2, kt = (i >> 1) & 1, nt = i & 1;
            tr_tile(tile, p.pool_w + (size_t)g * 128 * 128, 128, (bf16_t*)(p.ws + OFF_POOL) + (size_t)g * 128 * 128, 128, kt * 64, nt * 64, nullptr, [](int n) { return n; }); continue; }
        i -= P0_POOL;
        if (i < P0_WR) {
            bf16_t* wr = (bf16_t*)(p.ws + OFF_WR);
            for (int q = t; q < 4096; q += 512) { const int j = q >> 6, k = i * 64 + (q & 63);
                float v = 0.f; if (j < 4) v = p.w_rg[k * 4 + j]; else if (j < 36) v = p.w_re[k * 32 + (j - 4)];
                wr[(size_t)j * D + k] = f2bf(v); }
            continue; }
        i -= P0_WR;
        if (i < P0_PM) {
            float* metan = (float*)lds;
            float* red = (float*)(lds + 65536);
            for (int rr = 0; rr < 2; ++rr) { const int r = wid * 2 + rr; const float* mr = p.meta + (size_t)r * D;
                float v[16]; float ss = 0.f;
#pragma unroll
                for (int j = 0; j < 16; ++j) { v[j] = mr[j * 64 + lane]; ss += v[j] * v[j]; }
                ss = wave_sum(ss); const float rs = rsqrtf(ss * (1.0f / D) + EPS);
#pragma unroll
                for (int j = 0; j < 16; ++j) metan[r * D + j * 64 + lane] = v[j] * rs * p.norm_mix[j * 64 + lane]; }
            __syncthreads();
            const int col = i * 64 + lane, ks = wid;
            float acc[16];
#pragma unroll
            for (int r = 0; r < 16; ++r) acc[r] = 0.f;
            for (int k = ks * 128; k < ks * 128 + 128; ++k) { const float w = p.w_in[(size_t)k * NP + col];
#pragma unroll
                for (int r = 0; r < 16; ++r) acc[r] += metan[r * D + k] * w; }
#pragma unroll
            for (int r = 0; r < 16; ++r) red[(ks * 16 + r) * 64 + lane] = acc[r];
            __syncthreads();
            bf16_t* pm = (bf16_t*)(p.ws + OFF_PM);
            for (int q = t; q < 1024; q += 512) { const int r = q >> 6, c = q & 63; float s = 0.f;
#pragma unroll
                for (int k8 = 0; k8 < 8; ++k8) s += red[(k8 * 16 + r) * 64 + c];
                pm[(size_t)r * NP + i * 64 + c] = f2bf(s); }
            __syncthreads();
            continue; }
        i -= P0_PM;
        { int* cnt = (int*)(p.ws + OFF_CNT); if (t < 256) cnt[t] = 0; }
    }
}

__device__ __forceinline__ float dot_bf16(const bf16_t* a, const bf16_t* b, int K) {
    float acc = 0.f;
    for (int k = 0; k < K; k += 8) {
        const uint4 va = *(const uint4*)(a + k), vb = *(const uint4*)(b + k);
        const unsigned aa[4] = {va.x, va.y, va.z, va.w}, bb[4] = {vb.x, vb.y, vb.z, vb.w};
#pragma unroll
        for (int j = 0; j < 4; ++j) { acc += __uint_as_float(aa[j] << 16) * __uint_as_float(bb[j] << 16); acc += __uint_as_float(aa[j] & 0xffff0000u) * __uint_as_float(bb[j] & 0xffff0000u); }
    }
    return acc;
}
__global__ void __launch_bounds__(512) p0_kernel(Params p) { extern __shared__ __attribute__((aligned(16))) unsigned char lds[]; phase0(p, lds, blockIdx.x, gridDim.x); }

__global__ void __launch_bounds__(256) nv_inproj(Params p) {
    const size_t gid = (size_t)blockIdx.x * 256 + threadIdx.x; const int r = (int)(gid >> 11), n = (int)(gid & 2047);
    const bf16_t* xb = (const bf16_t*)(p.ws + OFF_A); const bf16_t* w = (const bf16_t*)(p.ws + OFF_WIN);
    const float* rstd1 = (const float*)(p.ws + OFF_RSTD1);
    ((bf16_t*)(p.ws + OFF_B))[gid] = f2bf(rstd1[r] * dot_bf16(xb + (size_t)r * D, w + (size_t)n * D, D));
}
__device__ __forceinline__ const bf16_t* proj_row(const Params& p, int b, int s) {
    return s >= 0 ? (const bf16_t*)(p.ws + OFF_B) + ((size_t)b * SEQ + s) * NP : (const bf16_t*)(p.ws + OFF_PM) + (size_t)(16 + s) * NP;
}
__global__ void __launch_bounds__(256) nv_mixer(Params p) {
    __shared__ float pooled[512]; __shared__ float red[8];
    const int r = blockIdx.x, b = r >> 13, s = r & 8191, t = threadIdx.x;
    bf16_t* y = (bf16_t*)(p.ws + OFF_C) + (size_t)r * D;
    const bf16_t *r0 = proj_row(p, b, s), *r1 = proj_row(p, b, s - 1), *r2 = proj_row(p, b, s - 2);
    float cv[2]; float ss = 0.f;
    for (int j = 0; j < 2; ++j) { const int c = t + 256 * j;
        const float u0 = bf2f(r0[512 + c]) * bf2f(r0[1024 + c]), u1 = bf2f(r1[512 + c]) * bf2f(r1[1024 + c]), u2 = bf2f(r2[512 + c]) * bf2f(r2[1024 + c]);
        const float conv = p.conv_w[c] * u2 + p.conv_w[512 + c] * u1 + p.conv_w[1024 + c] * u0;
        cv[j] = bf2f(r0[c]) * conv; ss += cv[j] * cv[j]; }
    ss = wave_sum(ss); if ((t & 63) == 0) red[t >> 6] = ss; __syncthreads();
    float tot = red[0] + red[1] + red[2] + red[3]; const float rc = rsqrtf(tot * (1.0f / 512) + EPS);
    for (int j = 0; j < 2; ++j) y[t + 256 * j] = f2bf(cv[j] * rc);
    for (int j = 0; j < 2; ++j) { const int c = t + 256 * j, g = c >> 7, w = 2 << g; float sum = 0.f;
        for (int q = 0; q < w; ++q) sum += bf2f(proj_row(p, b, s - q)[1536 + c]);
        pooled[c] = bf2f(f2bf(sum / (float)w - bf2f(r0[1536 + c]))); }
    __syncthreads();
    const bf16_t* pw = (const bf16_t*)(p.ws + OFF_POOL);
    float pv[2]; ss = 0.f;
    for (int j = 0; j < 2; ++j) { const int d = t + 256 * j, g = d >> 7, dd = d & 127; float acc = 0.f;
        for (int c = 0; c < 128; ++c) acc += pooled[g * 128 + c] * bf2f(pw[(size_t)(g * 128 + dd) * 128 + c]);
        pv[j] = acc * p.pool_scale[d]; ss += pv[j] * pv[j]; }
    ss = wave_sum(ss); __syncthreads(); if ((t & 63) == 0) red[4 + (t >> 6)] = ss; __syncthreads();
    tot = red[4] + red[5] + red[6] + red[7]; const float rp = rsqrtf(tot * (1.0f / 512) + EPS);
    for (int j = 0; j < 2; ++j) y[512 + t + 256 * j] = f2bf(pv[j] * rp);
}
__global__ void __launch_bounds__(256) nv_outproj(Params p) {
    const size_t gid = (size_t)blockIdx.x * 256 + threadIdx.x; const int r = (int)(gid >> 10), n = (int)(gid & 1023);
    const bf16_t* y = (const bf16_t*)(p.ws + OFF_C); const bf16_t* w = (const bf16_t*)(p.ws + OFF_WOUT);
    const float v = p.x[gid] + dot_bf16(y + (size_t)r * D, w + (size_t)n * D, D);
    p.out[gid] = v; ((bf16_t*)(p.ws + OFF_A))[gid] = f2bf(v * p.norm_ffn[n]);
}
__global__ void __launch_bounds__(256) nv_ssq(Params p) {
    __shared__ float red[4]; const int r = blockIdx.x, t = threadIdx.x; float ss = 0.f;
    for (int j = 0; j < 4; ++j) { const float v = p.out[(size_t)r * D + t + 256 * j]; ss += v * v; }
    ss = wave_sum(ss); if ((t & 63) == 0) red[t >> 6] = ss; __syncthreads();
    float* q = (float*)(p.ws + OFF_SSQ2) + (size_t)r * 16;
    if (t == 0) q[0] = red[0] + red[1] + red[2] + red[3]; else if (t < 16) q[t] = 0.f;
}
__device__ __forceinline__ void route_token(const Params& p, int r, const float* lg, float rstd2) {
    int gs = 0; for (int j = 1; j < 4; ++j) if (lg[j] > lg[gs]) gs = j;
    float den = 0.f; for (int j = 0; j < 4; ++j) den += __expf(lg[j] - lg[gs]);
    const float g1 = 1.0f / den;
    const float* le = lg + 4 + gs * 8;
    int i0 = 0; for (int j = 1; j < 8; ++j) if (le[j] > le[i0]) i0 = j;
    int i1 = (i0 == 0) ? 1 : 0; for (int j = 0; j < 8; ++j) if (j != i0 && le[j] > le[i1]) i1 = j;
    const float w0 = 1.0f / (1.0f + __expf(le[i1] - le[i0])), w1 = 1.0f - w0;
    int a = i0, b = i1; float ga = g1 * w0, gb = g1 * w1;
    if (a > b) { int ti = a; a = b; b = ti; float tf = ga; ga = gb; gb = tf; }
    const int e0 = gs * 8 + a, e1 = gs * 8 + b, bucket = gs * 28 + pair_off(a) + (b - a - 1);
    int4 rec; rec.x = e0 | (e1 << 8) | (bucket << 16); rec.y = __float_as_int(ga); rec.z = __float_as_int(gb); rec.w = __float_as_int(rstd2);
    ((int4*)(p.ws + OFF_RT))[r] = rec;
    int* cnt = (int*)(p.ws + OFF_CNT); int* el = (int*)(p.ws + OFF_EL); int* pl = (int*)(p.ws + OFF_PL);
    int pos = atomicAdd(&cnt[e0], 1); el[(size_t)e0 * T + pos] = r * 2;
    pos = atomicAdd(&cnt[e1], 1); el[(size_t)e1 * T + pos] = r * 2 + 1;
    pos = atomicAdd(&cnt[32 + bucket], 1); pl[(size_t)bucket * T + pos] = r;
}
__global__ void __launch_bounds__(64) nv_router(Params p) {
    const int r = blockIdx.x * 64 + threadIdx.x;
    const float* q = (const float*)(p.ws + OFF_SSQ2) + (size_t)r * 16; float ss = 0.f; for (int j = 0; j < 16; ++j) ss += q[j];
    const float rstd2 = rsqrtf(ss * (1.0f / D) + EPS);
    const bf16_t* h = (const bf16_t*)(p.ws + OFF_A) + (size_t)r * D; const bf16_t* wr = (const bf16_t*)(p.ws + OFF_WR);
    __shared__ float lgs[64 * 37]; float* lg = lgs + threadIdx.x * 37;
    for (int j = 0; j < 36; ++j) lg[j] = rstd2 * dot_bf16(h, wr + (size_t)j * D, D);
    route_token(p, r, lg, rstd2);
}
__global__ void __launch_bounds__(256) nv_gateup(Params p) {
    const size_t gid = (size_t)blockIdx.x * 256 + threadIdx.x; const int tok = (int)(gid >> 9), slot = (int)((gid >> 8) & 1), h = (int)(gid & 255);
    const int4 rec = ((const int4*)(p.ws + OFF_RT))[tok]; const int e = slot ? ((rec.x >> 8) & 255) : (rec.x & 255);
    const float gate = __int_as_float(slot ? rec.z : rec.y), rstd2 = __int_as_float(rec.w);
    const bf16_t* hf = (const bf16_t*)(p.ws + OFF_A) + (size_t)tok * D; const bf16_t* w = (const bf16_t*)(p.ws + OFF_WGU) + (size_t)e * 512 * D;
    const int rg = ((h >> 5) << 6) + (h & 31);
    const float G = rstd2 * dot_bf16(hf, w + (size_t)rg * D, D), U = rstd2 * dot_bf16(hf, w + (size_t)(rg + 32) * D, D);
    ((bf16_t*)(p.ws + OFF_B))[gid] = f2bf(G / (1.0f + __expf(-G)) * U * gate);
}
__global__ void __launch_bounds__(256) nv_down(Params p) {
    const size_t gid = (size_t)blockIdx.x * 256 + threadIdx.x; const int tok = (int)(gid >> 10), n = (int)(gid & 1023);
    const int4 rec = ((const int4*)(p.ws + OFF_RT))[tok]; const int e0 = rec.x & 255, e1 = (rec.x >> 8) & 255;
    const bf16_t* a = (const bf16_t*)(p.ws + OFF_B) + (size_t)tok * 512; const bf16_t* wd = (const bf16_t*)(p.ws + OFF_WD);
    p.out[gid] += dot_bf16(a, wd + ((size_t)e0 * D + n) * DE, DE) + dot_bf16(a + 256, wd + ((size_t)e1 * D + n) * DE, DE);
}
__global__ void __launch_bounds__(256) nv_final(Params p) {
    __shared__ float red[4]; const int r = blockIdx.x, t = threadIdx.x; float v[4]; float ss = 0.f;
    for (int j = 0; j < 4; ++j) { v[j] = p.out[(size_t)r * D + t + 256 * j]; ss += v[j] * v[j]; }
    ss = wave_sum(ss); if ((t & 63) == 0) red[t >> 6] = ss; __syncthreads();
    const float rs = rsqrtf((red[0] + red[1] + red[2] + red[3]) * (1.0f / D) + EPS);
    for (int j = 0; j < 4; ++j) p.out[(size_t)r * D + t + 256 * j] = v[j] * rs * p.final_norm[t + 256 * j];
}


#define LAS __attribute__((address_space(3)))
constexpr int LDS_STAGE = 147456, LDS_MISC = LDS_STAGE, LDS_BYTES = LDS_STAGE + 4096;

template <int WM_, int WN_, int TM_, int TN_, int BK_, int NST_>
struct GemmCfg {
    static constexpr int WM = WM_, WN = WN_, TM = TM_, TN = TN_, BK = BK_, NST = NST_;
    static constexpr int BM = WM * TM * 16, BN = WN * TN * 16;
    static constexpr int SL = BK / 8, RPC = 64 / SL;
    static constexpr int A_CH = BM / RPC, B_CH = BN / RPC, NA = (A_CH + 7) / 8, NB = (B_CH + 7) / 8;
    static constexpr int ROWB = BK * 2, A_BYTES = BM * ROWB, B_BYTES = BN * ROWB, ST_BYTES = A_BYTES + B_BYTES, KS = BK / 32;
    static_assert(WM * WN == 8, "8 waves");
    static_assert(NST * ST_BYTES <= LDS_STAGE, "LDS");
};
template <int BK> __device__ __forceinline__ int swz_slot(int row, int slot) {
    if (BK == 64) return slot ^ ((row >> 1) & 7);
    return slot ^ ((0 - (row >> 2)) & 3);
}
#define WAIT_VM(n) asm volatile("s_waitcnt vmcnt(" #n ")" ::: "memory")

template <class C, class AOff, class BOff, class ABase, class BBase, class Epi>
__device__ __forceinline__ void gemm_unit(LAS unsigned char* lds, const int nk, AOff aoff, BOff boff, ABase abase, BBase bbase, Epi epi) {
    const int tid = threadIdx.x, wid = __builtin_amdgcn_readfirstlane(tid >> 6), lane = tid & 63, wr = wid / C::WN, wc = wid % C::WN, fr = lane & 15, fq = lane >> 4;
    unsigned offA[C::NA], offB[C::NB];
#pragma unroll
    for (int i = 0; i < C::NA; ++i) { const int c = wid + 8 * i, row = c * C::RPC + lane / C::SL, sp = lane % C::SL;
        offA[i] = (c < C::A_CH) ? aoff(row) + (unsigned)swz_slot<C::BK>(row, sp) * 16u : 0u; }
#pragma unroll
    for (int i = 0; i < C::NB; ++i) { const int c = wid + 8 * i, row = c * C::RPC + lane / C::SL, sp = lane % C::SL;
        offB[i] = (c < C::B_CH) ? boff(row) + (unsigned)swz_slot<C::BK>(row, sp) * 16u : 0u; }
    int aread[C::KS], bread[C::KS];
#pragma unroll
    for (int ks = 0; ks < C::KS; ++ks) {
        aread[ks] = (wr * C::TM * 16 + fr) * C::ROWB + swz_slot<C::BK>(fr, ks * 4 + fq) * 16;
        bread[ks] = C::A_BYTES + (wc * C::TN * 16 + fr) * C::ROWB + swz_slot<C::BK>(fr, ks * 4 + fq) * 16;
    }
    f32x4 acc[C::TM][C::TN];
#pragma unroll
    for (int m = 0; m < C::TM; ++m)
#pragma unroll
        for (int n = 0; n < C::TN; ++n) acc[m][n] = (f32x4){0.f, 0.f, 0.f, 0.f};

    auto stage = [&](int kt, int buf) {
        const char* ab = abase(kt); const char* bb = bbase(kt);
        LAS unsigned char* sa = lds + buf * C::ST_BYTES;
#pragma unroll
        for (int i = 0; i < C::NA; ++i) { const int c = wid + 8 * i;
            if (c < C::A_CH) __builtin_amdgcn_global_load_lds((const unsigned*)(ab + offA[i]), (LAS unsigned*)(sa + c * 1024), 16, 0, 0); }
#pragma unroll
        for (int i = 0; i < C::NB; ++i) { const int c = wid + 8 * i;
            if (c < C::B_CH) __builtin_amdgcn_global_load_lds((const unsigned*)(bb + offB[i]), (LAS unsigned*)(sa + C::A_BYTES + c * 1024), 16, 0, 0); }
    };
    auto compute = [&](int buf) {
        const LAS unsigned char* sa = lds + buf * C::ST_BYTES;
#pragma unroll
        for (int ks = 0; ks < C::KS; ++ks) {
            bf16x8 af[C::TM], bfr[C::TN];
#pragma unroll
            for (int m = 0; m < C::TM; ++m) af[m] = *(const LAS bf16x8*)(sa + aread[ks] + m * 16 * C::ROWB);
#pragma unroll
            for (int n = 0; n < C::TN; ++n) bfr[n] = *(const LAS bf16x8*)(sa + bread[ks] + n * 16 * C::ROWB);
#pragma unroll
            for (int m = 0; m < C::TM; ++m)
#pragma unroll
                for (int n = 0; n < C::TN; ++n) acc[m][n] = __builtin_amdgcn_mfma_f32_16x16x32_bf16(bfr[n], af[m], acc[m][n], 0, 0, 0);
        }
    };
    __syncthreads();
    stage(0, 0);
    if (C::NST == 3 && nk > 1) stage(1, 1);
    for (int kt = 0; kt < nk; ++kt) {
        if (C::NST == 3 && kt + 1 < nk) { if (C::NA + C::NB == 6) WAIT_VM(6); else if (C::NA + C::NB == 3) WAIT_VM(3); else WAIT_VM(0); }
        else WAIT_VM(0);
        __builtin_amdgcn_s_barrier();
        asm volatile("" ::: "memory");
        if (kt + C::NST - 1 < nk) stage(kt + C::NST - 1, (kt + C::NST - 1) % C::NST);
        compute(kt % C::NST);
    }
    epi(acc, wr, wc, fr, fq);
}

typedef GemmCfg<4, 2, 4, 4, 64, 2> CfgA;
typedef GemmCfg<8, 1, 1, 4, 64, 2> CfgR;
typedef GemmCfg<1, 8, 4, 8, 32, 2> CfgD;

__device__ __forceinline__ void phase1(const Params& p, LAS unsigned char* lds, int bid, int nb) {
    const char* xb = (const char*)(p.ws + OFF_A); const char* w = (const char*)(p.ws + OFF_WIN);
    bf16_t* proj = (bf16_t*)(p.ws + OFF_B); const float* rstd1 = (const float*)(p.ws + OFF_RSTD1);
    for (int u = bid; u < 2048; u += nb) {
        const int g = u >> 8, b = u & 255, xcd = b & 7, j = b >> 3;
        const int mt = g * 16 + (xcd >> 1) * 4 + (j >> 3), nt = (xcd & 1) * 8 + (j & 7);
        gemm_unit<CfgA>(lds, 16,
            [&](int row) { return (unsigned)(mt * 256 + row) * 2048u; }, [&](int row) { return (unsigned)(nt * 128 + row) * 2048u; },
            [&](int kt) { return xb + kt * 128; }, [&](int kt) { return w + kt * 128; },
            [&](auto& acc, int wr, int wc, int fr, int fq) {
#pragma unroll
                for (int m = 0; m < 4; ++m) { const int row = mt * 256 + wr * 64 + m * 16 + fr; const float rs = rstd1[row];
#pragma unroll
                    for (int n = 0; n < 4; ++n) { const int col = nt * 128 + wc * 64 + n * 16 + fq * 4; const f32x4 v = acc[m][n] * rs;
                        *(uint2*)(proj + (size_t)row * NP + col) = make_uint2(pack2(v[0], v[1]), pack2(v[2], v[3])); } }
            });
    }
}
__device__ __forceinline__ void phase3(const Params& p, LAS unsigned char* lds, int bid, int nb) {
    const char* y = (const char*)(p.ws + OFF_C); const char* w = (const char*)(p.ws + OFF_WOUT);
    bf16_t* hfu = (bf16_t*)(p.ws + OFF_A); float* ssq2 = (float*)(p.ws + OFF_SSQ2);
    for (int u = bid; u < 1024; u += nb) {
        const int g = u >> 8, b = u & 255, xcd = b & 7, j = b >> 3;
        const int mt = g * 32 + xcd * 4 + (j >> 3), nt = j & 7;
        gemm_unit<CfgA>(lds, 16,
            [&](int row) { return (unsigned)(mt * 256 + row) * 2048u; }, [&](int row) { return (unsigned)(nt * 128 + row) * 2048u; },
            [&](int kt) { return y + kt * 128; }, [&](int kt) { return w + kt * 128; },
            [&](auto& acc, int wr, int wc, int fr, int fq) {
#pragma unroll
                for (int m = 0; m < 4; ++m) { const int row = mt * 256 + wr * 64 + m * 16 + fr; float ss = 0.f;
#pragma unroll
                    for (int n = 0; n < 4; ++n) { const int col = nt * 128 + wc * 64 + n * 16 + fq * 4; const size_t o = (size_t)row * D + col;
                        const float4 xr = *(const float4*)(p.x + o); const float4 gf = *(const float4*)(p.norm_ffn + col);
                        const float v0 = acc[m][n][0] + xr.x, v1 = acc[m][n][1] + xr.y, v2 = acc[m][n][2] + xr.z, v3 = acc[m][n][3] + xr.w;
                        *(float4*)(p.out + o) = make_float4(v0, v1, v2, v3);
                        *(uint2*)(hfu + o) = make_uint2(pack2(v0 * gf.x, v1 * gf.y), pack2(v2 * gf.z, v3 * gf.w));
                        ss += v0 * v0 + v1 * v1 + v2 * v2 + v3 * v3; }
                    ss += __shfl_xor(ss, 16); ss += __shfl_xor(ss, 32);
                    if (fq == 0) ssq2[(size_t)row * 16 + nt * 2 + wc] = ss; }
            });
    }
}
__device__ __forceinline__ void phase4(const Params& p, LAS unsigned char* lds, int bid, int nb) {
    const char* hfu = (const char*)(p.ws + OFF_A); const char* w = (const char*)(p.ws + OFF_WR);
    const float* ssq2 = (const float*)(p.ws + OFF_SSQ2);
    for (int u = bid; u < 256; u += nb) {
        gemm_unit<CfgR>(lds, 16,
            [&](int row) { return (unsigned)(u * 128 + row) * 2048u; }, [&](int row) { return (unsigned)row * 2048u; },
            [&](int kt) { return hfu + kt * 128; }, [&](int kt) { return w + kt * 128; },
            [&](auto& acc, int wr, int wc, int fr, int fq) {
                __syncthreads();
                LAS float* lg = (LAS float*)lds;
#pragma unroll
                for (int n = 0; n < 4; ++n)
#pragma unroll
                    for (int j = 0; j < 4; ++j) lg[(wr * 16 + fr) * 65 + n * 16 + fq * 4 + j] = acc[0][n][j];
                __syncthreads();
                if (threadIdx.x < 128) { const int r = u * 128 + threadIdx.x; const float* q = ssq2 + (size_t)r * 16; float ss = 0.f;
#pragma unroll
                    for (int j = 0; j < 16; ++j) ss += q[j];
                    const float rstd2 = rsqrtf(ss * (1.0f / D) + EPS);
                    float* mine = (float*)(lg + threadIdx.x * 65);
                    for (int j = 0; j < 36; ++j) mine[j] *= rstd2;
                    route_token(p, r, mine, rstd2); }
            });
    }
}
__device__ __forceinline__ void phase5a(const Params& p, LAS unsigned char* lds, int bid, int nb) {
    const char* hfu = (const char*)(p.ws + OFF_A); const char* wgu = (const char*)(p.ws + OFF_WGU);
    bf16_t* act = (bf16_t*)(p.ws + OFF_B); const int* cnt = (const int*)(p.ws + OFF_CNT); const int* el = (const int*)(p.ws + OFF_EL);
    const int4* rt = (const int4*)(p.ws + OFF_RT);
    LAS int* pre = (LAS int*)(lds + LDS_MISC);
    __syncthreads();
    if (threadIdx.x == 0) { int s = 0; for (int e = 0; e < NE; ++e) { pre[e] = s; s += ((cnt[e] + 255) >> 8) * 4; } pre[NE] = s; }
    __syncthreads();
    const int total = pre[NE];
    for (int u = bid; u < total; u += nb) {
        int e = 0; while (pre[e + 1] <= u) ++e;
        const int local = u - pre[e], mtile = local >> 2, ntile = local & 3, ce = cnt[e];
        const int* list = el + (size_t)e * T;
        gemm_unit<CfgA>(lds, 16,
            [&](int row) { const int li = min(mtile * 256 + row, ce - 1); return (unsigned)(list[li] >> 1) * 2048u; },
            [&](int row) { return (unsigned)(e * 512 + ntile * 128 + row) * 2048u; },
            [&](int kt) { return hfu + kt * 128; }, [&](int kt) { return wgu + kt * 128; },
            [&](auto& acc, int wr, int wc, int fr, int fq) {
#pragma unroll
                for (int m = 0; m < 4; ++m) { const int li = mtile * 256 + wr * 64 + m * 16 + fr;
                    if (li < ce) { const int ent = list[li], tok = ent >> 1, slot = ent & 1; const int4 rec = rt[tok];
                        const float gate = __int_as_float(slot ? rec.z : rec.y), rs = __int_as_float(rec.w);
#pragma unroll
                        for (int n = 0; n < 2; ++n) { float a[4];
#pragma unroll
                            for (int j = 0; j < 4; ++j) { const float G = acc[m][n][j] * rs, U = acc[m][n + 2][j] * rs; a[j] = G / (1.0f + __expf(-G)) * U * gate; }
                            const int hid = ntile * 64 + wc * 32 + n * 16 + fq * 4;
                            *(uint2*)(act + (size_t)tok * 512 + slot * 256 + hid) = make_uint2(pack2(a[0], a[1]), pack2(a[2], a[3])); } } }
            });
    }
}
__device__ __forceinline__ void phase5b(const Params& p, LAS unsigned char* lds, int bid, int nb) {
    const char* act = (const char*)(p.ws + OFF_B); const char* wd = (const char*)(p.ws + OFF_WD);
    const int* cnt = (const int*)(p.ws + OFF_CNT) + 32; const int* pl = (const int*)(p.ws + OFF_PL);
    LAS int* pre = (LAS int*)(lds + LDS_MISC);
    LAS float* red = (LAS float*)(lds + LDS_MISC + 1024);
    __syncthreads();
    if (threadIdx.x == 0) { int s = 0; for (int b = 0; b < NBUCK; ++b) { pre[b] = s; s += (cnt[b] + 63) >> 6; } pre[NBUCK] = s; }
    __syncthreads();
    const int total = pre[NBUCK];
    for (int u = bid; u < total; u += nb) {
        int b = 0; while (pre[b + 1] <= u) ++b;
        const int mtile = u - pre[b], cb = cnt[b], g = b / 28, pi = b % 28;
        int a = 0; while (a < 6 && pair_off(a + 1) <= pi) ++a;
        const int e0 = g * 8 + a, e1 = g * 8 + a + 1 + (pi - pair_off(a));
        const int* list = pl + (size_t)b * T;
        const char* w0 = wd + (size_t)e0 * (D * DE * 2); const char* w1 = wd + (size_t)e1 * (D * DE * 2);
        gemm_unit<CfgD>(lds, 16,
            [&](int row) { const int li = min(mtile * 64 + row, cb - 1); return (unsigned)list[li] * 1024u; },
            [&](int row) { return (unsigned)row * 512u; },
            [&](int kt) { return act + kt * 64; }, [&](int kt) { return kt < 8 ? w0 + kt * 64 : w1 + (kt - 8) * 64; },
            [&](auto& acc, int wr, int wc, int fr, int fq) {
                int tok[4]; bool ok[4];
#pragma unroll
                for (int m = 0; m < 4; ++m) { const int li = mtile * 64 + m * 16 + fr; ok[m] = li < cb; tok[m] = list[min(li, cb - 1)]; float ss = 0.f;
#pragma unroll
                    for (int n = 0; n < 8; ++n) { const int col = wc * 128 + n * 16 + fq * 4; const float4 h = *(const float4*)(p.out + (size_t)tok[m] * D + col);
                        acc[m][n][0] += h.x; acc[m][n][1] += h.y; acc[m][n][2] += h.z; acc[m][n][3] += h.w;
                        ss += acc[m][n][0] * acc[m][n][0] + acc[m][n][1] * acc[m][n][1] + acc[m][n][2] * acc[m][n][2] + acc[m][n][3] * acc[m][n][3]; }
                    ss += __shfl_xor(ss, 16); ss += __shfl_xor(ss, 32);
                    if (fq == 0) red[(m * 16 + fr) * 8 + wc] = ss; }
                __syncthreads();
#pragma unroll
                for (int m = 0; m < 4; ++m) { float ss = 0.f;
#pragma unroll
                    for (int w8 = 0; w8 < 8; ++w8) ss += red[(m * 16 + fr) * 8 + w8];
                    const float rs = rsqrtf(ss * (1.0f / D) + EPS);
                    if (ok[m]) {
#pragma unroll
                        for (int n = 0; n < 8; ++n) { const int col = wc * 128 + n * 16 + fq * 4; const float4 gf = *(const float4*)(p.final_norm + col);
                            *(float4*)(p.out + (size_t)tok[m] * D + col) = make_float4(acc[m][n][0] * rs * gf.x, acc[m][n][1] * rs * gf.y, acc[m][n][2] * rs * gf.z, acc[m][n][3] * rs * gf.w); } } }
            });
    }
}
__device__ __forceinline__ void unpack8(const uint4 v, float* f) {
    f[0] = __uint_as_float(v.x << 16); f[1] = __uint_as_float(v.x & 0xffff0000u); f[2] = __uint_as_float(v.y << 16); f[3] = __uint_as_float(v.y & 0xffff0000u);
    f[4] = __uint_as_float(v.z << 16); f[5] = __uint_as_float(v.z & 0xffff0000u); f[6] = __uint_as_float(v.w << 16); f[7] = __uint_as_float(v.w & 0xffff0000u);
}
__device__ __forceinline__ void phase2(const Params& p, LAS unsigned char* lds, int bid, int nb) {
    const int tid = threadIdx.x, wid = __builtin_amdgcn_readfirstlane(tid >> 6), lane = tid & 63, fr = lane & 15, fq = lane >> 4;
    bf16_t* y = (bf16_t*)(p.ws + OFF_C);
    LAS float* red = (LAS float*)(lds + LDS_MISC + 1024);
    const int cch = lane * 8;
    const int g = wid >> 1, nh = wid & 1;
    const bf16_t* pw = (const bf16_t*)(p.ws + OFF_POOL);
    for (int unit = bid; unit < T / 64; unit += nb) {
        const int R0 = unit * 64, b = R0 >> 13, s0 = R0 & 8191;
        __syncthreads();
        {
            const int cvl = lane & 15, rq = lane >> 4, rbase = (wid & 1) * 32 + rq * 8, col = 1536 + g * 128 + cvl * 8, w = 2 << g;
            const float invw = 1.0f / (float)w;
            float run[8], f[8];
#pragma unroll
            for (int j = 0; j < 8; ++j) run[j] = 0.f;
            for (int q = 1; q < w; ++q) { unpack8(*(const uint4*)(proj_row(p, b, s0 + rbase - q) + col), f);
#pragma unroll
                for (int j = 0; j < 8; ++j) run[j] += f[j]; }
#pragma unroll
            for (int i = 0; i < 8; ++i) { const int row = rbase + i, s = s0 + row;
                unpack8(*(const uint4*)(proj_row(p, b, s) + col), f);
                float pv[8];
#pragma unroll
                for (int j = 0; j < 8; ++j) { run[j] += f[j]; pv[j] = run[j] * invw - f[j]; }
                *(LAS u32x4*)(lds + g * 16384 + (cvl >> 3) * 8192 + row * 128 + swz_slot<64>(row, cvl & 7) * 16) = (u32x4){pack2(pv[0], pv[1]), pack2(pv[2], pv[3]), pack2(pv[4], pv[5]), pack2(pv[6], pv[7])};
                unpack8(*(const uint4*)(proj_row(p, b, s - w + 1) + col), f);
#pragma unroll
                for (int j = 0; j < 8; ++j) run[j] -= f[j]; }
        }
        {
            float u2[8], u1[8], c8[8], v8[8], b8[8];
            float w0[8], w1[8], w2[8];
#pragma unroll
            for (int j = 0; j < 8; ++j) { w0[j] = p.conv_w[cch + j]; w1[j] = p.conv_w[512 + cch + j]; w2[j] = p.conv_w[1024 + cch + j]; }
            const int sb = s0 + wid * 8;
            { const bf16_t* r = proj_row(p, b, sb - 2); unpack8(*(const uint4*)(r + 512 + cch), c8); unpack8(*(const uint4*)(r + 1024 + cch), v8);
#pragma unroll
              for (int j = 0; j < 8; ++j) u2[j] = c8[j] * v8[j]; }
            { const bf16_t* r = proj_row(p, b, sb - 1); unpack8(*(const uint4*)(r + 512 + cch), c8); unpack8(*(const uint4*)(r + 1024 + cch), v8);
#pragma unroll
              for (int j = 0; j < 8; ++j) u1[j] = c8[j] * v8[j]; }
#pragma unroll
            for (int i = 0; i < 8; ++i) { const bf16_t* r = proj_row(p, b, sb + i);
                unpack8(*(const uint4*)(r + cch), b8); unpack8(*(const uint4*)(r + 512 + cch), c8); unpack8(*(const uint4*)(r + 1024 + cch), v8);
                float raw[8]; float ss = 0.f;
#pragma unroll
                for (int j = 0; j < 8; ++j) { const float u0 = c8[j] * v8[j]; raw[j] = b8[j] * (w0[j] * u2[j] + w1[j] * u1[j] + w2[j] * u0); ss += raw[j] * raw[j]; u2[j] = u1[j]; u1[j] = u0; }
                ss = wave_sum(ss); const float rs = rsqrtf(ss * (1.0f / 512) + EPS);
                *(uint4*)(y + (size_t)(R0 + wid * 8 + i) * D + cch) = make_uint4(pack2(raw[0] * rs, raw[1] * rs), pack2(raw[2] * rs, raw[3] * rs), pack2(raw[4] * rs, raw[5] * rs), pack2(raw[6] * rs, raw[7] * rs)); }
        }
        __syncthreads();
        f32x4 acc[4][4];
#pragma unroll
        for (int m = 0; m < 4; ++m)
#pragma unroll
            for (int n = 0; n < 4; ++n) acc[m][n] = (f32x4){0.f, 0.f, 0.f, 0.f};
#pragma unroll
        for (int ks = 0; ks < 4; ++ks) {
            bf16x8 af[4], bfr[4];
#pragma unroll
            for (int n = 0; n < 4; ++n) bfr[n] = *(const bf16x8*)(pw + (size_t)(g * 128 + nh * 64 + n * 16 + fr) * 128 + ks * 32 + fq * 8);
#pragma unroll
            for (int m = 0; m < 4; ++m) af[m] = *(const LAS bf16x8*)(lds + g * 16384 + (ks >> 1) * 8192 + (m * 16 + fr) * 128 + swz_slot<64>(fr, (ks & 1) * 4 + fq) * 16);
#pragma unroll
            for (int m = 0; m < 4; ++m)
#pragma unroll
                for (int n = 0; n < 4; ++n) acc[m][n] = __builtin_amdgcn_mfma_f32_16x16x32_bf16(bfr[n], af[m], acc[m][n], 0, 0, 0);
        }
#pragma unroll
        for (int m = 0; m < 4; ++m) { float ss = 0.f;
#pragma unroll
            for (int n = 0; n < 4; ++n) { acc[m][n] *= *(const f32x4*)(p.pool_scale + g * 128 + nh * 64 + n * 16 + fq * 4); ss += acc[m][n][0] * acc[m][n][0] + acc[m][n][1] * acc[m][n][1] + acc[m][n][2] * acc[m][n][2] + acc[m][n][3] * acc[m][n][3]; }
            ss += __shfl_xor(ss, 16); ss += __shfl_xor(ss, 32);
            if (fq == 0) red[(m * 16 + fr) * 8 + wid] = ss; }
        __syncthreads();
#pragma unroll
        for (int m = 0; m < 4; ++m) { float ss = 0.f;
#pragma unroll
            for (int w8 = 0; w8 < 8; ++w8) ss += red[(m * 16 + fr) * 8 + w8];
            const float rs = rsqrtf(ss * (1.0f / 512) + EPS);
#pragma unroll
            for (int n = 0; n < 4; ++n) { const f32x4 v = acc[m][n] * rs;
                *(uint2*)(y + (size_t)(R0 + m * 16 + fr) * D + 512 + g * 128 + nh * 64 + n * 16 + fq * 4) = make_uint2(pack2(v[0], v[1]), pack2(v[2], v[3])); } }
    }
}
template <int PH> __global__ void __launch_bounds__(512, 2) phase_kernel(Params p) {
    extern __shared__ __attribute__((aligned(16))) unsigned char lds_raw[];
    LAS unsigned char* lds = (LAS unsigned char*)lds_raw;
    if (PH == 1) phase1(p, lds, blockIdx.x, gridDim.x);
    if (PH == 2) phase2(p, lds, blockIdx.x, gridDim.x);
    if (PH == 3) phase3(p, lds, blockIdx.x, gridDim.x);
    if (PH == 4) phase4(p, lds, blockIdx.x, gridDim.x);
    if (PH == 5) phase5a(p, lds, blockIdx.x, gridDim.x);
    if (PH == 6) phase5b(p, lds, blockIdx.x, gridDim.x);
}


__global__ void __launch_bounds__(512, 2) mega_kernel(Params p) {
    extern __shared__ __attribute__((aligned(16))) unsigned char lds_raw[];
    LAS unsigned char* lds = (LAS unsigned char*)lds_raw;
    cg::grid_group grid = cg::this_grid();
    const int bid = blockIdx.x, nb = gridDim.x;
    phase0(p, lds_raw, bid, nb); grid.sync();
    phase1(p, lds, bid, nb); grid.sync();
    phase2(p, lds, bid, nb); grid.sync();
    phase3(p, lds, bid, nb); grid.sync();
    phase4(p, lds, bid, nb); grid.sync();
    phase5a(p, lds, bid, nb); grid.sync();
    phase5b(p, lds, bid, nb);
}

extern "C" void kernel_launch(void* const* d_in, const int* in_sizes, int n_in, void* d_out, int out_size, void* d_ws, size_t ws_size, hipStream_t stream) {
    static int init = 0;
    static int grid_blocks = 0;
    if (!init) {
        if (ws_size < WS_END) { fprintf(stderr, "workspace too small: %zu < %zu\n", ws_size, (size_t)WS_END); init = -1; return; }
        (void)hipFuncSetAttribute((const void*)p0_kernel, hipFuncAttributeMaxDynamicSharedMemorySize, 98304);
        (void)hipFuncSetAttribute((const void*)phase_kernel<1>, hipFuncAttributeMaxDynamicSharedMemorySize, LDS_BYTES);
        (void)hipFuncSetAttribute((const void*)phase_kernel<3>, hipFuncAttributeMaxDynamicSharedMemorySize, LDS_BYTES);
        (void)hipFuncSetAttribute((const void*)phase_kernel<4>, hipFuncAttributeMaxDynamicSharedMemorySize, LDS_BYTES);
        (void)hipFuncSetAttribute((const void*)phase_kernel<5>, hipFuncAttributeMaxDynamicSharedMemorySize, LDS_BYTES);
        (void)hipFuncSetAttribute((const void*)phase_kernel<6>, hipFuncAttributeMaxDynamicSharedMemorySize, LDS_BYTES);
        (void)hipFuncSetAttribute((const void*)phase_kernel<2>, hipFuncAttributeMaxDynamicSharedMemorySize, LDS_BYTES);
        (void)hipFuncSetAttribute((const void*)mega_kernel, hipFuncAttributeMaxDynamicSharedMemorySize, LDS_BYTES);
        int dev = 0, cus = 0, per_cu = 0;
        (void)hipGetDevice(&dev);
        (void)hipDeviceGetAttribute(&cus, hipDeviceAttributeMultiprocessorCount, dev);
        (void)hipOccupancyMaxActiveBlocksPerMultiprocessor(&per_cu, (const void*)mega_kernel, 512, LDS_BYTES);
        if (per_cu < 1) { fprintf(stderr, "occupancy query says %d blocks/CU\n", per_cu); per_cu = 1; }
        if (per_cu > 1) per_cu = 1;
        grid_blocks = cus * per_cu;
        init = 1;
    }
    if (init < 0) return;
    Params p{};
    const float** f = (const float**)&p;
    for (int i = 0; i < 17; ++i) f[i] = (const float*)d_in[i];
    p.out = (float*)d_out; p.ws = (unsigned char*)d_ws;
#if MEGA
    void* args[] = {&p};
    hipError_t e = hipLaunchCooperativeKernel((const void*)mega_kernel, dim3(grid_blocks), dim3(512), args, LDS_BYTES, stream);
    if (e != hipSuccess) fprintf(stderr, "cooperative launch failed: %s (grid %d)\n", hipGetErrorString(e), grid_blocks);
#else
    p0_kernel<<<1024, 512, 98304, stream>>>(p);
    phase_kernel<1><<<256, 512, LDS_BYTES, stream>>>(p);
#if FAST_P2
    phase_kernel<2><<<256, 512, LDS_BYTES, stream>>>(p);
#else
    nv_mixer<<<T, 256, 0, stream>>>(p);
#endif
    phase_kernel<3><<<256, 512, LDS_BYTES, stream>>>(p);
    phase_kernel<4><<<256, 512, LDS_BYTES, stream>>>(p);
    phase_kernel<5><<<256, 512, LDS_BYTES, stream>>>(p);
    phase_kernel<6><<<256, 512, LDS_BYTES, stream>>>(p);
#endif
}
```

```cpp
#include <hip/hip_runtime.h>
#include <hip/hip_cooperative_groups.h>
#include <cstdio>
#include <cstdint>
namespace cg = cooperative_groups;
#define PROBE_DUP -1

typedef unsigned short bf16_t;
typedef short bf16x8 __attribute__((ext_vector_type(8)));
typedef float f32x4 __attribute__((ext_vector_type(4)));
typedef unsigned u32x4 __attribute__((ext_vector_type(4)));

constexpr int T = 32768, SEQ = 8192, D = 1024, NP = 2048, DC = 512, NE = 32, DE = 256, NBUCK = 112;
constexpr float EPS = 1e-6f;
constexpr size_t MiB = 1024 * 1024;
constexpr size_t OFF_A = 0;
constexpr size_t OFF_B = 64 * MiB;
constexpr size_t OFF_C = 192 * MiB;
constexpr size_t OFF_WIN = 256 * MiB;
constexpr size_t OFF_WOUT = 260 * MiB;
constexpr size_t OFF_WGU = 262 * MiB;
constexpr size_t OFF_WD = 294 * MiB;
constexpr size_t OFF_POOL = 310 * MiB;
constexpr size_t OFF_WR = OFF_POOL + 128 * 1024;
constexpr size_t OFF_PM = OFF_WR + 128 * 1024;
constexpr size_t OFF_RSTD1 = OFF_PM + 64 * 1024;
constexpr size_t OFF_SSQ2 = OFF_RSTD1 + 128 * 1024;
constexpr size_t OFF_RT = OFF_SSQ2 + 2 * MiB;
constexpr size_t OFF_EL = OFF_RT + 512 * 1024;
constexpr size_t OFF_PL = OFF_EL + 4 * MiB;
constexpr size_t OFF_H = 336 * MiB;
constexpr size_t OFF_BAR = OFF_H + 64 * MiB;
constexpr size_t WS_END = OFF_BAR + 16384;
constexpr size_t OFF_CNT = OFF_BAR + 14336;

struct Params {
    const float *x, *meta, *norm_mix, *w_in, *conv_w, *norm_conv_out, *pool_w, *pool_scale, *norm_pool_out, *w_out, *norm_ffn,
        *w_rg, *w_re, *w_gate, *w_up, *w_down, *final_norm;
    float* out;
    unsigned char* ws;
};

__device__ __forceinline__ float bf2f(bf16_t v) { return __uint_as_float(((unsigned)v) << 16); }
__device__ __forceinline__ bf16_t f2bf(float f) { unsigned u = __float_as_uint(f); u += 0x7fffu + ((u >> 16) & 1u); return (bf16_t)(u >> 16); }
__device__ __forceinline__ unsigned pack2(float lo, float hi) { return (unsigned)f2bf(lo) | ((unsigned)f2bf(hi) << 16); }
__device__ __forceinline__ float wave_sum(float v) {
#pragma unroll
    for (int o = 32; o > 0; o >>= 1) v += __shfl_xor(v, o);
    return v;
}
__device__ __forceinline__ int pair_off(int a) { return a * 8 - (a * (a + 1)) / 2; }

template <class RowMap>
__device__ __forceinline__ void tr_tile(float* tile  , const float* src, int ld_src, bf16_t* dst, int ld_dst, int k0, int n0, const float* kscale, RowMap dstrow) {
    const int t = threadIdx.x;
#pragma unroll
    for (int i = 0; i < 8; ++i) {
        const int idx = t + 512 * i, k = idx >> 6, n = idx & 63;
        float v = src[(size_t)(k0 + k) * ld_src + n0 + n];
        if (kscale) v *= kscale[k0 + k];
        tile[k * 65 + n] = v;
    }
    __syncthreads();
    {
        const int n = t >> 3, ko = t & 7;
        unsigned w[4];
#pragma unroll
        for (int j = 0; j < 4; ++j) w[j] = pack2(tile[(ko * 8 + 2 * j) * 65 + n], tile[(ko * 8 + 2 * j + 1) * 65 + n]);
        *(uint4*)(dst + (size_t)dstrow(n0 + n) * ld_dst + k0 + ko * 8) = make_uint4(w[0], w[1], w[2], w[3]);
    }
    __syncthreads();
}

constexpr int P0_XROWS = 4096;
constexpr int P0_WIN = 16 * 32, P0_WOUT = 16 * 16, P0_GATE = 32 * 16 * 4, P0_UP = P0_GATE, P0_DOWN = 32 * 4 * 16, P0_POOL = 16, P0_WR = 16, P0_PM = 32;
constexpr int P0_ITEMS = P0_XROWS + P0_WIN + P0_WOUT + P0_GATE + P0_UP + P0_DOWN + P0_POOL + P0_WR + P0_PM;

__device__ __forceinline__ void phase0(const Params& p, unsigned char* lds, int bid, int nb) {
    float* tile = (float*)lds;
    const int t = threadIdx.x, wid = t >> 6, lane = t & 63;
    bf16_t* xb = (bf16_t*)(p.ws + OFF_A);
    float* rstd1 = (float*)(p.ws + OFF_RSTD1);
    for (int it = bid; it < P0_ITEMS; it += nb) {
        int i = it;
        if (i < P0_XROWS) {
            const int r = i * 8 + wid;
            const float* xr = p.x + (size_t)r * D;
            float ss = 0.f;
#pragma unroll
            for (int j = 0; j < 2; ++j) {
                const int c = j * 512 + lane * 8;
                const float4 a = *(const float4*)(xr + c), b = *(const float4*)(xr + c + 4);
                ss += a.x * a.x + a.y * a.y + a.z * a.z + a.w * a.w + b.x * b.x + b.y * b.y + b.z * b.z + b.w * b.w;
                *(uint4*)(xb + (size_t)r * D + c) = make_uint4(pack2(a.x, a.y), pack2(a.z, a.w), pack2(b.x, b.y), pack2(b.z, b.w));
            }
            ss = wave_sum(ss);
            if (lane == 0) rstd1[r] = rsqrtf(ss * (1.0f / D) + EPS);
            continue;
        }
        i -= P0_XROWS;
        if (i < P0_WIN) { const int kt = i & 15, nt = i >> 4;
            tr_tile(tile, p.w_in, NP, (bf16_t*)(p.ws + OFF_WIN), D, kt * 64, nt * 64, p.norm_mix, [](int n) { return n; }); continue; }
        i -= P0_WIN;
        if (i < P0_WOUT) { const int kt = i & 15, nt = i >> 4;
            const int k0 = kt * 64;
            const float* ks = (k0 < DC) ? (p.norm_conv_out) : (p.norm_pool_out - DC);
            tr_tile(tile, p.w_out, D, (bf16_t*)(p.ws + OFF_WOUT), D, k0, nt * 64, ks, [](int n) { return n; }); continue; }
        i -= P0_WOUT;
        if (i < P0_GATE + P0_UP) { const int up = i >= P0_GATE; if (up) i -= P0_GATE;
            const int e = i >> 6, kt = (i >> 2) & 15, nt = i & 3;
            const float* src = (up ? p.w_up : p.w_gate) + (size_t)e * D * DE;
            bf16_t* dst = (bf16_t*)(p.ws + OFF_WGU) + (size_t)e * 512 * D;
            tr_tile(tile, src, DE, dst, D, kt * 64, nt * 64, p.norm_ffn, [up](int h) { return ((h >> 5) << 6) + (h & 31) + (up ? 32 : 0); }); continue; }
        i -= P0_GATE + P0_UP;
        if (i < P0_DOWN) { const int e = i >> 6, kt = (i >> 4) & 3, nt = i & 15;
            tr_tile(tile, p.w_down + (size_t)e * DE * D, D, (bf16_t*)(p.ws + OFF_WD) + (size_t)e * D * DE, DE, kt * 64, nt * 64, nullptr, [](int n) { return n; }); continue; }
        i -= P0_DOWN;
        if (i < P0_POOL) { const int g = i >> 2, kt = (i >> 1) & 1, nt = i & 1;
            tr_tile(tile, p.pool_w + (size_t)g * 128 * 128, 128, (bf16_t*)(p.ws + OFF_POOL) + (size_t)g * 128 * 128, 128, kt * 64, nt * 64, nullptr, [](int n) { return n; }); continue; }
        i -= P0_POOL;
        if (i < P0_WR) {
            bf16_t* wr = (bf16_t*)(p.ws + OFF_WR);
            for (int q = t; q < 4096; q += 512) { const int j = q >> 6, k = i * 64 + (q & 63);
                float v = 0.f; if (j < 4) v = p.w_rg[k * 4 + j]; else if (j < 36) v = p.w_re[k * 32 + (j - 4)];
                wr[(size_t)j * D + k] = f2bf(v * p.norm_ffn[k]); }
            continue; }
        i -= P0_WR;
        if (i < P0_PM) {
            float* metan = (float*)lds;
            float* red = (float*)(lds + 65536);
            for (int rr = 0; rr < 2; ++rr) { const int r = wid * 2 + rr; const float* mr = p.meta + (size_t)r * D;
                float v[16]; float ss = 0.f;
#pragma unroll
                for (int j = 0; j < 16; ++j) { v[j] = mr[j * 64 + lane]; ss += v[j] * v[j]; }
                ss = wave_sum(ss); const float rs = rsqrtf(ss * (1.0f / D) + EPS);
#pragma unroll
                for (int j = 0; j < 16; ++j) metan[r * D + j * 64 + lane] = v[j] * rs * p.norm_mix[j * 64 + lane]; }
            __syncthreads();
            const int col = i * 64 + lane, ks = wid;
            float acc[16];
#pragma unroll
            for (int r = 0; r < 16; ++r) acc[r] = 0.f;
            for (int k = ks * 128; k < ks * 128 + 128; ++k) { const float w = p.w_in[(size_t)k * NP + col];
#pragma unroll
                for (int r = 0; r < 16; ++r) acc[r] += metan[r * D + k] * w; }
#pragma unroll
            for (int r = 0; r < 16; ++r) red[(ks * 16 + r) * 64 + lane] = acc[r];
            __syncthreads();
            bf16_t* pm = (bf16_t*)(p.ws + OFF_PM);
            for (int q = t; q < 1024; q += 512) { const int r = q >> 6, c = q & 63; float s = 0.f;
#pragma unroll
                for (int k8 = 0; k8 < 8; ++k8) s += red[(k8 * 16 + r) * 64 + c];
                pm[(size_t)r * NP + i * 64 + c] = f2bf(s); }
            __syncthreads();
            continue; }
    }
}

__device__ __forceinline__ const bf16_t* proj_row(const Params& p, int b, int s) {
    return s >= 0 ? (const bf16_t*)(p.ws + OFF_B) + ((size_t)b * SEQ + s) * NP : (const bf16_t*)(p.ws + OFF_PM) + (size_t)(16 + s) * NP;
}
#define LAS __attribute__((address_space(3)))
constexpr int LDS_STAGE = 147456, LDS_MISC = LDS_STAGE, LDS_BYTES = LDS_STAGE + 4096;

template <int WM_, int WN_, int TM_, int TN_, int BK_, int NST_>
struct GemmCfg {
    static constexpr int WM = WM_, WN = WN_, TM = TM_, TN = TN_, BK = BK_, NST = NST_;
    static constexpr int BM = WM * TM * 16, BN = WN * TN * 16;
    static constexpr int SL = BK / 8, RPC = 64 / SL;
    static constexpr int A_CH = BM / RPC, B_CH = BN / RPC, NA = (A_CH + 7) / 8, NB = (B_CH + 7) / 8;
    static constexpr int ROWB = BK * 2, A_BYTES = BM * ROWB, B_BYTES = BN * ROWB, ST_BYTES = A_BYTES + B_BYTES, KS = BK / 32;
    static_assert(WM * WN == 8, "8 waves");
    static_assert(NST * ST_BYTES <= LDS_STAGE, "LDS");
};
template <int BK> __device__ __forceinline__ int swz_slot(int row, int slot) {
    if (BK == 64) return slot ^ ((row >> 1) & 7);
    return slot ^ ((0 - (row >> 2)) & 3);
}
#define WAIT_VM(n) asm volatile("s_waitcnt vmcnt(" #n ")" ::: "memory")

template <class C, class AOff, class BOff, class ABase, class BBase, class Epi>
__device__ __forceinline__ void gemm_unit(LAS unsigned char* lds, const int nk, AOff aoff, BOff boff, ABase abase, BBase bbase, Epi epi) {
    const int tid = threadIdx.x, wid = __builtin_amdgcn_readfirstlane(tid >> 6), lane = tid & 63, wr = wid / C::WN, wc = wid % C::WN, fr = lane & 15, fq = lane >> 4;
    unsigned offA[C::NA], offB[C::NB];
#pragma unroll
    for (int i = 0; i < C::NA; ++i) { const int c = wid + 8 * i, row = c * C::RPC + lane / C::SL, sp = lane % C::SL;
        offA[i] = (c < C::A_CH) ? aoff(row) + (unsigned)swz_slot<C::BK>(row, sp) * 16u : 0u; }
#pragma unroll
    for (int i = 0; i < C::NB; ++i) { const int c = wid + 8 * i, row = c * C::RPC + lane / C::SL, sp = lane % C::SL;
        offB[i] = (c < C::B_CH) ? boff(row) + (unsigned)swz_slot<C::BK>(row, sp) * 16u : 0u; }
    int aread[C::KS], bread[C::KS];
#pragma unroll
    for (int ks = 0; ks < C::KS; ++ks) {
        aread[ks] = (wr * C::TM * 16 + fr) * C::ROWB + swz_slot<C::BK>(fr, ks * 4 + fq) * 16;
        bread[ks] = C::A_BYTES + (wc * C::TN * 16 + fr) * C::ROWB + swz_slot<C::BK>(fr, ks * 4 + fq) * 16;
    }
    f32x4 acc[C::TM][C::TN];
#pragma unroll
    for (int m = 0; m < C::TM; ++m)
#pragma unroll
        for (int n = 0; n < C::TN; ++n) acc[m][n] = (f32x4){0.f, 0.f, 0.f, 0.f};

    auto stage = [&](int kt, int buf) {
        const char* ab = abase(kt); const char* bb = bbase(kt);
        LAS unsigned char* sa = lds + buf * C::ST_BYTES;
#pragma unroll
        for (int i = 0; i < C::NA; ++i) { const int c = wid + 8 * i;
            if (c < C::A_CH) __builtin_amdgcn_global_load_lds((const unsigned*)(ab + offA[i]), (LAS unsigned*)(sa + c * 1024), 16, 0, 0); }
#pragma unroll
        for (int i = 0; i < C::NB; ++i) { const int c = wid + 8 * i;
            if (c < C::B_CH) __builtin_amdgcn_global_load_lds((const unsigned*)(bb + offB[i]), (LAS unsigned*)(sa + C::A_BYTES + c * 1024), 16, 0, 0); }
    };
    auto compute = [&](int buf) {
        const LAS unsigned char* sa = lds + buf * C::ST_BYTES;
#pragma unroll
        for (int ks = 0; ks < C::KS; ++ks) {
            bf16x8 af[C::TM], bfr[C::TN];
#pragma unroll
            for (int m = 0; m < C::TM; ++m) af[m] = *(const LAS bf16x8*)(sa + aread[ks] + m * 16 * C::ROWB);
#pragma unroll
            for (int n = 0; n < C::TN; ++n) bfr[n] = *(const LAS bf16x8*)(sa + bread[ks] + n * 16 * C::ROWB);
#pragma unroll
            for (int m = 0; m < C::TM; ++m)
#pragma unroll
                for (int n = 0; n < C::TN; ++n) acc[m][n] = __builtin_amdgcn_mfma_f32_16x16x32_bf16(bfr[n], af[m], acc[m][n], 0, 0, 0);
        }
    };
    __syncthreads();
    stage(0, 0);
    if (C::NST == 3 && nk > 1) stage(1, 1);
    for (int kt = 0; kt < nk; ++kt) {
        if (C::NST == 3 && kt + 1 < nk) { if (C::NA + C::NB == 6) WAIT_VM(6); else if (C::NA + C::NB == 3) WAIT_VM(3); else WAIT_VM(0); }
        else WAIT_VM(0);
        __builtin_amdgcn_s_barrier();
        asm volatile("" ::: "memory");
        if (kt + C::NST - 1 < nk) stage(kt + C::NST - 1, (kt + C::NST - 1) % C::NST);
        compute(kt % C::NST);
    }
    epi(acc, wr, wc, fr, fq);
}

typedef GemmCfg<4, 2, 4, 4, 64, 2> CfgA;
typedef GemmCfg<8, 1, 1, 4, 64, 2> CfgR;
typedef GemmCfg<1, 8, 4, 8, 32, 2> CfgD;

__device__ __forceinline__ void phase1(const Params& p, LAS unsigned char* lds, int bid, int nb) {
    const char* xb = (const char*)(p.ws + OFF_A); const char* w = (const char*)(p.ws + OFF_WIN);
    bf16_t* proj = (bf16_t*)(p.ws + OFF_B); const float* rstd1 = (const float*)(p.ws + OFF_RSTD1);
    for (int u = bid; u < 2048; u += nb) {
        const int g = u >> 8, b = u & 255, xcd = b & 7, j = b >> 3;
        const int mt = g * 16 + (xcd >> 1) * 4 + (j >> 3), nt = (xcd & 1) * 8 + (j & 7);
        gemm_unit<CfgA>(lds, 16,
            [&](int row) { return (unsigned)(mt * 256 + row) * 2048u; }, [&](int row) { return (unsigned)(nt * 128 + row) * 2048u; },
            [&](int kt) { return xb + kt * 128; }, [&](int kt) { return w + kt * 128; },
            [&](auto& acc, int wr, int wc, int fr, int fq) {
#pragma unroll
                for (int m = 0; m < 4; ++m) { const int row = mt * 256 + wr * 64 + m * 16 + fr; const float rs = rstd1[row];
#pragma unroll
                    for (int n = 0; n < 4; ++n) { const int col = nt * 128 + wc * 64 + n * 16 + fq * 4; const f32x4 v = acc[m][n] * rs;
                        *(uint2*)(proj + (size_t)row * NP + col) = make_uint2(pack2(v[0], v[1]), pack2(v[2], v[3])); } }
            });
    }
}
__device__ __forceinline__ void phase3(const Params& p, LAS unsigned char* lds, int bid, int nb) {
    const char* y = (const char*)(p.ws + OFF_C); const char* w = (const char*)(p.ws + OFF_WOUT);
    const bf16_t* xb = (const bf16_t*)(p.ws + OFF_A); bf16_t* hb = (bf16_t*)(p.ws + OFF_H); float* ssq2 = (float*)(p.ws + OFF_SSQ2);
    for (int u = bid; u < 1024; u += nb) {
        const int g = u >> 8, b = u & 255, xcd = b & 7, j = b >> 3;
        const int mt = g * 32 + xcd * 4 + (j >> 3), nt = j & 7;
        gemm_unit<CfgA>(lds, 16,
            [&](int row) { return (unsigned)(mt * 256 + row) * 2048u; }, [&](int row) { return (unsigned)(nt * 128 + row) * 2048u; },
            [&](int kt) { return y + kt * 128; }, [&](int kt) { return w + kt * 128; },
            [&](auto& acc, int wr, int wc, int fr, int fq) {
#pragma unroll
                for (int m = 0; m < 4; ++m) { const int row = mt * 256 + wr * 64 + m * 16 + fr; float ss = 0.f;
#pragma unroll
                    for (int n = 0; n < 4; ++n) { const int col = nt * 128 + wc * 64 + n * 16 + fq * 4; const size_t o = (size_t)row * D + col;
                        const uint2 xr = *(const uint2*)(xb + o);
                        const float v0 = acc[m][n][0] + __uint_as_float(xr.x << 16), v1 = acc[m][n][1] + __uint_as_float(xr.x & 0xffff0000u);
                        const float v2 = acc[m][n][2] + __uint_as_float(xr.y << 16), v3 = acc[m][n][3] + __uint_as_float(xr.y & 0xffff0000u);
                        *(uint2*)(hb + o) = make_uint2(pack2(v0, v1), pack2(v2, v3));
                        ss += v0 * v0 + v1 * v1 + v2 * v2 + v3 * v3; }
                    ss += __shfl_xor(ss, 16); ss += __shfl_xor(ss, 32);
                    if (fq == 0) ssq2[(size_t)row * 16 + nt * 2 + wc] = ss; }
            });
    }
}
__device__ __forceinline__ void phase4(const Params& p, LAS unsigned char* lds, int bid, int nb) {
    const char* hb = (const char*)(p.ws + OFF_H); const char* w = (const char*)(p.ws + OFF_WR);
    const float* ssq2 = (const float*)(p.ws + OFF_SSQ2);
    LAS int* hist = (LAS int*)(lds + LDS_MISC);
    LAS int* base = (LAS int*)(lds + LDS_MISC + 1024);
    int* cnt = (int*)(p.ws + OFF_CNT); int* el = (int*)(p.ws + OFF_EL); int* pl = (int*)(p.ws + OFF_PL);
    for (int u = bid; u < 256; u += nb) {
        gemm_unit<CfgR>(lds, 16,
            [&](int row) { return (unsigned)(u * 128 + row) * 2048u; }, [&](int row) { return (unsigned)row * 2048u; },
            [&](int kt) { return hb + kt * 128; }, [&](int kt) { return w + kt * 128; },
            [&](auto& acc, int wr, int wc, int fr, int fq) {
                __syncthreads();
                LAS float* lg = (LAS float*)lds;
#pragma unroll
                for (int n = 0; n < 4; ++n)
#pragma unroll
                    for (int j = 0; j < 4; ++j) lg[(wr * 16 + fr) * 65 + n * 16 + fq * 4 + j] = acc[0][n][j];
                if (threadIdx.x < 144) hist[threadIdx.x] = 0;
                __syncthreads();
                const int t = threadIdx.x, r = u * 128 + t;
                int e0 = 0, e1 = 0, bucket = 0, r0 = 0, r1 = 0, rb = 0; float ga = 0.f, gb = 0.f, rstd2 = 0.f;
                if (t < 128) { const float* q = ssq2 + (size_t)r * 16; float ss = 0.f;
#pragma unroll
                    for (int j = 0; j < 16; ++j) ss += q[j];
                    rstd2 = rsqrtf(ss * (1.0f / D) + EPS);
                    const LAS float* mine = lg + t * 65;
                    int gs = 0; float gm = mine[0];
#pragma unroll
                    for (int j = 1; j < 4; ++j) { const float v = mine[j]; if (v > gm) { gm = v; gs = j; } }
                    float den = 0.f;
#pragma unroll
                    for (int j = 0; j < 4; ++j) den += __expf((mine[j] - gm) * rstd2);
                    const float g1 = 1.0f / den;
                    const LAS float* le = mine + 4 + gs * 8;
                    int i0 = 0; float l0 = le[0];
#pragma unroll
                    for (int j = 1; j < 8; ++j) { const float v = le[j]; if (v > l0) { l0 = v; i0 = j; } }
                    int i1 = -1; float l1 = -3.0e38f;
#pragma unroll
                    for (int j = 0; j < 8; ++j) { const float v = le[j]; if (j != i0 && v > l1) { l1 = v; i1 = j; } }
                    const float w0 = 1.0f / (1.0f + __expf((l1 - l0) * rstd2)), w1 = 1.0f - w0;
                    int a = i0, bb = i1; ga = g1 * w0; gb = g1 * w1;
                    if (a > bb) { const int ti = a; a = bb; bb = ti; const float tf = ga; ga = gb; gb = tf; }
                    e0 = gs * 8 + a; e1 = gs * 8 + bb; bucket = gs * 28 + pair_off(a) + (bb - a - 1);
                    r0 = __hip_atomic_fetch_add(&hist[e0], 1, __ATOMIC_RELAXED, __HIP_MEMORY_SCOPE_WORKGROUP); r1 = __hip_atomic_fetch_add(&hist[e1], 1, __ATOMIC_RELAXED, __HIP_MEMORY_SCOPE_WORKGROUP); rb = __hip_atomic_fetch_add(&hist[32 + bucket], 1, __ATOMIC_RELAXED, __HIP_MEMORY_SCOPE_WORKGROUP); }
                __syncthreads();
                if (t < 144) { const int c = hist[t]; base[t] = c ? atomicAdd(&cnt[t], c) : 0; }
                __syncthreads();
                if (t < 128) { int4 rec; rec.x = e0 | (e1 << 8) | (bucket << 16); rec.y = __float_as_int(ga); rec.z = __float_as_int(gb); rec.w = __float_as_int(rstd2);
                    ((int4*)(p.ws + OFF_RT))[r] = rec;
                    el[(size_t)e0 * T + base[e0] + r0] = r * 2; el[(size_t)e1 * T + base[e1] + r1] = r * 2 + 1; pl[(size_t)bucket * T + base[32 + bucket] + rb] = r; }
            });
    }
}
__device__ __forceinline__ void phase5a(const Params& p, LAS unsigned char* lds, int bid, int nb) {
    const char* hfu = (const char*)(p.ws + OFF_H); const char* wgu = (const char*)(p.ws + OFF_WGU);
    bf16_t* act = (bf16_t*)(p.ws + OFF_B); const int* cnt = (const int*)(p.ws + OFF_CNT); const int* el = (const int*)(p.ws + OFF_EL);
    const int4* rt = (const int4*)(p.ws + OFF_RT);
    LAS int* pre = (LAS int*)(lds + LDS_MISC);
    __syncthreads();
    if (threadIdx.x == 0) { int s = 0; for (int e = 0; e < NE; ++e) { pre[e] = s; s += ((cnt[e] + 255) >> 8) * 4; } pre[NE] = s; }
    __syncthreads();
    const int total = pre[NE];
    for (int u = bid; u < total; u += nb) {
        int e = 0; while (pre[e + 1] <= u) ++e;
        const int local = u - pre[e], mtile = local >> 2, ntile = local & 3, ce = cnt[e];
        const int* list = el + (size_t)e * T;
        gemm_unit<CfgA>(lds, 16,
            [&](int row) { const int li = min(mtile * 256 + row, ce - 1); return (unsigned)(list[li] >> 1) * 2048u; },
            [&](int row) { return (unsigned)(e * 512 + ntile * 128 + row) * 2048u; },
            [&](int kt) { return hfu + kt * 128; }, [&](int kt) { return wgu + kt * 128; },
            [&](auto& acc, int wr, int wc, int fr, int fq) {
#pragma unroll
                for (int m = 0; m < 4; ++m) { const int li = mtile * 256 + wr * 64 + m * 16 + fr;
                    if (li < ce) { const int ent = list[li], tok = ent >> 1, slot = ent & 1; const int4 rec = rt[tok];
                        const float gate = __int_as_float(slot ? rec.z : rec.y), rs = __int_as_float(rec.w);
#pragma unroll
                        for (int n = 0; n < 2; ++n) { float a[4];
#pragma unroll
                            for (int j = 0; j < 4; ++j) { const float G = acc[m][n][j] * rs, U = acc[m][n + 2][j] * rs; a[j] = G / (1.0f + __expf(-G)) * U * gate; }
                            const int hid = ntile * 64 + wc * 32 + n * 16 + fq * 4;
                            *(uint2*)(act + (size_t)tok * 512 + slot * 256 + hid) = make_uint2(pack2(a[0], a[1]), pack2(a[2], a[3])); } } }
            });
    }
}
__device__ __forceinline__ void phase5b(const Params& p, LAS unsigned char* lds, int bid, int nb, float* dst) {
    const char* act = (const char*)(p.ws + OFF_B); const char* wd = (const char*)(p.ws + OFF_WD);
    const int* cnt = (const int*)(p.ws + OFF_CNT) + 32; const bf16_t* hb = (const bf16_t*)(p.ws + OFF_H); const int* pl = (const int*)(p.ws + OFF_PL);
    LAS int* pre = (LAS int*)(lds + LDS_MISC);
    LAS float* red = (LAS float*)(lds + LDS_MISC + 1024);
    __syncthreads();
    if (threadIdx.x == 0) { int s = 0; for (int b = 0; b < NBUCK; ++b) { pre[b] = s; s += (cnt[b] + 63) >> 6; } pre[NBUCK] = s; }
    __syncthreads();
    const int total = pre[NBUCK];
    for (int u = bid; u < total; u += nb) {
        int b = 0; while (pre[b + 1] <= u) ++b;
        const int mtile = u - pre[b], cb = cnt[b], g = b / 28, pi = b % 28;
        int a = 0; while (a < 6 && pair_off(a + 1) <= pi) ++a;
        const int e0 = g * 8 + a, e1 = g * 8 + a + 1 + (pi - pair_off(a));
        const int* list = pl + (size_t)b * T;
        const char* w0 = wd + (size_t)e0 * (D * DE * 2); const char* w1 = wd + (size_t)e1 * (D * DE * 2);
        gemm_unit<CfgD>(lds, 16,
            [&](int row) { const int li = min(mtile * 64 + row, cb - 1); return (unsigned)list[li] * 1024u; },
            [&](int row) { return (unsigned)row * 512u; },
            [&](int kt) { return act + kt * 64; }, [&](int kt) { return kt < 8 ? w0 + kt * 64 : w1 + (kt - 8) * 64; },
            [&](auto& acc, int wr, int wc, int fr, int fq) {
                int tok[4]; bool ok[4];
#pragma unroll
                for (int m = 0; m < 4; ++m) { const int li = mtile * 64 + m * 16 + fr; ok[m] = li < cb; tok[m] = list[min(li, cb - 1)]; float ss = 0.f;
#pragma unroll
                    for (int n = 0; n < 8; ++n) { const int col = wc * 128 + n * 16 + fq * 4; const uint2 h = *(const uint2*)(hb + (size_t)tok[m] * D + col);
                        acc[m][n][0] += __uint_as_float(h.x << 16); acc[m][n][1] += __uint_as_float(h.x & 0xffff0000u); acc[m][n][2] += __uint_as_float(h.y << 16); acc[m][n][3] += __uint_as_float(h.y & 0xffff0000u);
                        ss += acc[m][n][0] * acc[m][n][0] + acc[m][n][1] * acc[m][n][1] + acc[m][n][2] * acc[m][n][2] + acc[m][n][3] * acc[m][n][3]; }
                    ss += __shfl_xor(ss, 16); ss += __shfl_xor(ss, 32);
                    if (fq == 0) red[(m * 16 + fr) * 8 + wc] = ss; }
                __syncthreads();
#pragma unroll
                for (int m = 0; m < 4; ++m) { float ss = 0.f;
#pragma unroll
                    for (int w8 = 0; w8 < 8; ++w8) ss += red[(m * 16 + fr) * 8 + w8];
                    const float rs = rsqrtf(ss * (1.0f / D) + EPS);
                    if (ok[m]) {
#pragma unroll
                        for (int n = 0; n < 8; ++n) { const int col = wc * 128 + n * 16 + fq * 4; const float4 gf = *(const float4*)(p.final_norm + col);
                            *(float4*)(dst + (size_t)tok[m] * D + col) = make_float4(acc[m][n][0] * rs * gf.x, acc[m][n][1] * rs * gf.y, acc[m][n][2] * rs * gf.z, acc[m][n][3] * rs * gf.w); } } }
            });
    }
}
__device__ __forceinline__ void unpack8(const uint4 v, float* f) {
    f[0] = __uint_as_float(v.x << 16); f[1] = __uint_as_float(v.x & 0xffff0000u); f[2] = __uint_as_float(v.y << 16); f[3] = __uint_as_float(v.y & 0xffff0000u);
    f[4] = __uint_as_float(v.z << 16); f[5] = __uint_as_float(v.z & 0xffff0000u); f[6] = __uint_as_float(v.w << 16); f[7] = __uint_as_float(v.w & 0xffff0000u);
}
__device__ __forceinline__ void phase2(const Params& p, LAS unsigned char* lds, int bid, int nb) {
    const int tid = threadIdx.x, wid = __builtin_amdgcn_readfirstlane(tid >> 6), lane = tid & 63, fr = lane & 15, fq = lane >> 4;
    bf16_t* y = (bf16_t*)(p.ws + OFF_C);
    LAS float* red = (LAS float*)(lds + LDS_MISC + 1024);
    const int cch = lane * 8;
    const int g = wid >> 1, nh = wid & 1;
    const bf16_t* pw = (const bf16_t*)(p.ws + OFF_POOL);
    for (int unit = bid; unit < T / 64; unit += nb) {
        const int R0 = unit * 64, b = R0 >> 13, s0 = R0 & 8191;
        __syncthreads();
        {
            const int cvl = lane & 15, rq = lane >> 4, rbase = (wid & 1) * 32 + rq * 8, col = 1536 + g * 128 + cvl * 8, w = 2 << g;
            const float invw = 1.0f / (float)w;
            float run[8], f[8];
#pragma unroll
            for (int j = 0; j < 8; ++j) run[j] = 0.f;
            for (int q = 1; q < w; ++q) { unpack8(*(const uint4*)(proj_row(p, b, s0 + rbase - q) + col), f);
#pragma unroll
                for (int j = 0; j < 8; ++j) run[j] += f[j]; }
#pragma unroll
            for (int i = 0; i < 8; ++i) { const int row = rbase + i, s = s0 + row;
                unpack8(*(const uint4*)(proj_row(p, b, s) + col), f);
                float pv[8];
#pragma unroll
                for (int j = 0; j < 8; ++j) { run[j] += f[j]; pv[j] = run[j] * invw - f[j]; }
                *(LAS u32x4*)(lds + g * 16384 + (cvl >> 3) * 8192 + row * 128 + swz_slot<64>(row, cvl & 7) * 16) = (u32x4){pack2(pv[0], pv[1]), pack2(pv[2], pv[3]), pack2(pv[4], pv[5]), pack2(pv[6], pv[7])};
                unpack8(*(const uint4*)(proj_row(p, b, s - w + 1) + col), f);
#pragma unroll
                for (int j = 0; j < 8; ++j) run[j] -= f[j]; }
        }
        {
            float u2[8], u1[8], c8[8], v8[8], b8[8];
            float w0[8], w1[8], w2[8];
#pragma unroll
            for (int j = 0; j < 8; ++j) { w0[j] = p.conv_w[cch + j]; w1[j] = p.conv_w[512 + cch + j]; w2[j] = p.conv_w[1024 + cch + j]; }
            const int sb = s0 + wid * 8;
            { const bf16_t* r = proj_row(p, b, sb - 2); unpack8(*(const uint4*)(r + 512 + cch), c8); unpack8(*(const uint4*)(r + 1024 + cch), v8);
#pragma unroll
              for (int j = 0; j < 8; ++j) u2[j] = c8[j] * v8[j]; }
            { const bf16_t* r = proj_row(p, b, sb - 1); unpack8(*(const uint4*)(r + 512 + cch), c8); unpack8(*(const uint4*)(r + 1024 + cch), v8);
#pragma unroll
              for (int j = 0; j < 8; ++j) u1[j] = c8[j] * v8[j]; }
#pragma unroll
            for (int i = 0; i < 8; ++i) { const bf16_t* r = proj_row(p, b, sb + i);
                unpack8(*(const uint4*)(r + cch), b8); unpack8(*(const uint4*)(r + 512 + cch), c8); unpack8(*(const uint4*)(r + 1024 + cch), v8);
                float raw[8]; float ss = 0.f;
#pragma unroll
                for (int j = 0; j < 8; ++j) { const float u0 = c8[j] * v8[j]; raw[j] = b8[j] * (w0[j] * u2[j] + w1[j] * u1[j] + w2[j] * u0); ss += raw[j] * raw[j]; u2[j] = u1[j]; u1[j] = u0; }
                ss = wave_sum(ss); const float rs = rsqrtf(ss * (1.0f / 512) + EPS);
                *(uint4*)(y + (size_t)(R0 + wid * 8 + i) * D + cch) = make_uint4(pack2(raw[0] * rs, raw[1] * rs), pack2(raw[2] * rs, raw[3] * rs), pack2(raw[4] * rs, raw[5] * rs), pack2(raw[6] * rs, raw[7] * rs)); }
        }
        __syncthreads();
        f32x4 acc[4][4];
#pragma unroll
        for (int m = 0; m < 4; ++m)
#pragma unroll
            for (int n = 0; n < 4; ++n) acc[m][n] = (f32x4){0.f, 0.f, 0.f, 0.f};
#pragma unroll
        for (int ks = 0; ks < 4; ++ks) {
            bf16x8 af[4], bfr[4];
#pragma unroll
            for (int n = 0; n < 4; ++n) bfr[n] = *(const bf16x8*)(pw + (size_t)(g * 128 + nh * 64 + n * 16 + fr) * 128 + ks * 32 + fq * 8);
#pragma unroll
            for (int m = 0; m < 4; ++m) af[m] = *(const LAS bf16x8*)(lds + g * 16384 + (ks >> 1) * 8192 + (m * 16 + fr) * 128 + swz_slot<64>(fr, (ks & 1) * 4 + fq) * 16);
#pragma unroll
            for (int m = 0; m < 4; ++m)
#pragma unroll
                for (int n = 0; n < 4; ++n) acc[m][n] = __builtin_amdgcn_mfma_f32_16x16x32_bf16(bfr[n], af[m], acc[m][n], 0, 0, 0);
        }
#pragma unroll
        for (int m = 0; m < 4; ++m) { float ss = 0.f;
#pragma unroll
            for (int n = 0; n < 4; ++n) { acc[m][n] *= *(const f32x4*)(p.pool_scale + g * 128 + nh * 64 + n * 16 + fq * 4); ss += acc[m][n][0] * acc[m][n][0] + acc[m][n][1] * acc[m][n][1] + acc[m][n][2] * acc[m][n][2] + acc[m][n][3] * acc[m][n][3]; }
            ss += __shfl_xor(ss, 16); ss += __shfl_xor(ss, 32);
            if (fq == 0) red[(m * 16 + fr) * 8 + wid] = ss; }
        __syncthreads();
#pragma unroll
        for (int m = 0; m < 4; ++m) { float ss = 0.f;
#pragma unroll
            for (int w8 = 0; w8 < 8; ++w8) ss += red[(m * 16 + fr) * 8 + w8];
            const float rs = rsqrtf(ss * (1.0f / 512) + EPS);
#pragma unroll
            for (int n = 0; n < 4; ++n) { const f32x4 v = acc[m][n] * rs;
                *(uint2*)(y + (size_t)(R0 + m * 16 + fr) * D + 512 + g * 128 + nh * 64 + n * 16 + fq * 4) = make_uint2(pack2(v[0], v[1]), pack2(v[2], v[3])); } }
    }
}

#define XB_TMO      128
#define XB_XCNT(j)  (256  + 64 * (j))
#define XB_XSUB(j)  (1280 + 64 * (j))
#define XB_XGEN(j)  (2304 + 64 * (j))
#define XB_TOP      3328
#define XB_TOPGEN   3392
#define XCD_BAR_WORDS 3456
#define XB_SPIN_CAP (1u << 18)
__device__ __forceinline__ unsigned xb_ld(unsigned* p)              { return __hip_atomic_load(p, __ATOMIC_RELAXED, __HIP_MEMORY_SCOPE_AGENT); }
__device__ __forceinline__ unsigned xb_add(unsigned* p, unsigned v) { return __hip_atomic_fetch_add(p, v, __ATOMIC_RELAXED, __HIP_MEMORY_SCOPE_AGENT); }
__device__ __forceinline__ unsigned xb_xcc_id() { return (unsigned)__builtin_amdgcn_s_getreg((3 << 11) | 20) & 0xFu; }
#define XB_SPIN(cond, bar) do { unsigned _sp = 0; while (cond) { __builtin_amdgcn_s_sleep(1); \
    if ((++_sp & 255u) == 0u) { if (xb_ld(&(bar)[XB_TMO])) break; if (_sp > XB_SPIN_CAP) { atomicAdd(&(bar)[XB_TMO], 1u); break; } } } } while (0)
struct XcdBarrier { unsigned* bar; unsigned x; volatile __attribute__((address_space(3))) unsigned* st; };
__device__ __forceinline__ XcdBarrier xcd_barrier_post(unsigned* bar, volatile __attribute__((address_space(3))) unsigned* st) {
    XcdBarrier b; b.bar = bar; b.x = xb_xcc_id(); b.st = st;
    if (threadIdx.x == 0) (void)xb_add(&bar[XB_XCNT(b.x)], 1u);
    return b;
}
__device__ __forceinline__ void xcd_barrier_complete(unsigned* bar, unsigned x, unsigned& nloc, unsigned& nx) {
    const unsigned G = gridDim.x * gridDim.y * gridDim.z;
    unsigned sum, cnt, mine, sp = 0u;
    for (;;) {
        sum = 0u; cnt = 0u; mine = 0u;
#pragma unroll
        for (unsigned j = 0; j < 16; ++j) { const unsigned c = xb_ld(&bar[XB_XCNT(j)]); sum += c; cnt += (c > 0u) ? 1u : 0u; mine = (j == x) ? c : mine; }
        if (sum == G) break;
        __builtin_amdgcn_s_sleep(1);
        if ((++sp & 255u) == 0u) { if (xb_ld(&bar[XB_TMO])) break; if (sp > XB_SPIN_CAP) { atomicAdd(&bar[XB_TMO], 1u); break; } }
    }
    nloc = mine > 0u ? mine : 1u; nx = cnt > 0u ? cnt : 1u;
}
__device__ __forceinline__ void xcd_barrier(const XcdBarrier& b) {
    asm volatile("s_waitcnt vmcnt(0)" ::: "memory");
    __syncthreads();
    if (threadIdx.x == 0) {
        unsigned* bar = b.bar;
        __builtin_amdgcn_s_waitcnt(0);
        unsigned nloc = b.st[0], nx = b.st[1];
        if (nloc == 0u) { xcd_barrier_complete(bar, b.x, nloc, nx); b.st[0] = nloc; b.st[1] = nx; }
        const unsigned old = xb_add(&bar[XB_XSUB(b.x)], 1u);
        const unsigned gen = old / nloc;
        if (old + 1u == (gen + 1u) * nloc) {
            __builtin_amdgcn_fence(__ATOMIC_RELEASE, "agent");
            asm volatile("s_waitcnt vmcnt(0)" ::: "memory");
            const unsigned og = xb_add(&bar[XB_TOP], 1u);
            const unsigned tg = og / nx;
            if (og + 1u == (tg + 1u) * nx) xb_add(&bar[XB_TOPGEN], 1u);
            else XB_SPIN(xb_ld(&bar[XB_TOPGEN]) == tg, bar);
            __builtin_amdgcn_fence(__ATOMIC_ACQUIRE, "agent");
            xb_add(&bar[XB_XGEN(b.x)], 1u);
            asm volatile("s_waitcnt vmcnt(0)" ::: "memory");
        } else {
            XB_SPIN(xb_ld(&bar[XB_XGEN(b.x)]) == gen, bar);
            __builtin_amdgcn_fence(__ATOMIC_ACQUIRE, "agent");
            asm volatile("s_waitcnt vmcnt(0)" ::: "memory");
        }
    }
    __syncthreads();
}

__global__ void __launch_bounds__(512, 2) mega_kernel(Params p) {
    extern __shared__ __attribute__((aligned(16))) unsigned char lds_raw[];
    LAS unsigned char* lds = (LAS unsigned char*)lds_raw;
    cg::grid_group grid = cg::this_grid();
    const int bid = blockIdx.x, nb = gridDim.x;
    volatile LAS unsigned* st = (volatile LAS unsigned*)(lds + LDS_MISC + 3072);
    if (threadIdx.x == 0) { st[0] = 0u; st[1] = 0u; }
    __syncthreads();
    XcdBarrier xb = xcd_barrier_post((unsigned*)(p.ws + OFF_BAR), st);
    if (p.ws == nullptr) grid.sync();
#define SEAM() xcd_barrier(xb)
    phase0(p, lds_raw, bid, nb); SEAM();
#if PROBE_DUP == 0
    phase0(p, lds_raw, bid, nb); SEAM();
#endif
    phase1(p, lds, bid, nb); SEAM();
#if PROBE_DUP == 1
    phase1(p, lds, bid, nb); SEAM();
#endif
    phase2(p, lds, bid, nb); SEAM();
#if PROBE_DUP == 2
    phase2(p, lds, bid, nb); SEAM();
#endif
    phase3(p, lds, bid, nb); SEAM();
#if PROBE_DUP == 3
    phase3(p, lds, bid, nb); SEAM();
#endif
    phase4(p, lds, bid, nb); SEAM();
#if PROBE_DUP == 4
    { int* cnt = (int*)(p.ws + OFF_CNT); if (bid == 0 && threadIdx.x < 256) cnt[threadIdx.x] = 0; } SEAM();
    phase4(p, lds, bid, nb); SEAM();
#endif
    phase5a(p, lds, bid, nb); SEAM();
#if PROBE_DUP == 5
    phase5a(p, lds, bid, nb); SEAM();
#endif
    phase5b(p, lds, bid, nb, p.out);
}

extern "C" void kernel_launch(void* const* d_in, const int* in_sizes, int n_in, void* d_out, int out_size, void* d_ws, size_t ws_size, hipStream_t stream) {
    static int init = 0;
    static int grid_blocks = 0;
    if (!init) {
        if (ws_size < WS_END) { fprintf(stderr, "workspace too small: %zu < %zu\n", ws_size, (size_t)WS_END); init = -1; return; }
        (void)hipFuncSetAttribute((const void*)mega_kernel, hipFuncAttributeMaxDynamicSharedMemorySize, LDS_BYTES);
        int dev = 0, cus = 0, per_cu = 0;
        (void)hipGetDevice(&dev);
        (void)hipDeviceGetAttribute(&cus, hipDeviceAttributeMultiprocessorCount, dev);
        (void)hipOccupancyMaxActiveBlocksPerMultiprocessor(&per_cu, (const void*)mega_kernel, 512, LDS_BYTES);
        if (per_cu < 1) { fprintf(stderr, "occupancy query says %d blocks/CU\n", per_cu); per_cu = 1; }
        if (per_cu > 1) per_cu = 1;
        grid_blocks = cus * per_cu;
        init = 1;
    }
    if (init < 0) return;
    Params p{};
    const float** f = (const float**)&p;
    for (int i = 0; i < 17; ++i) f[i] = (const float*)d_in[i];
    p.out = (float*)d_out; p.ws = (unsigned char*)d_ws;
    (void)hipMemsetAsync((unsigned char*)d_ws + OFF_BAR, 0, 16384, stream);
    void* args[] = {&p};
    hipError_t e = hipLaunchCooperativeKernel((const void*)mega_kernel, dim3(grid_blocks), dim3(512), args, LDS_BYTES, stream);
    if (e != hipSuccess) fprintf(stderr, "cooperative launch failed: %s (grid %d)\n", hipGetErrorString(e), grid_blocks);
}
```

```cpp
#include <hip/hip_runtime.h>
#include <hip/hip_cooperative_groups.h>
#include <cstdio>
#include <cstdint>
namespace cg = cooperative_groups;
#define PROBE_DUP -1
#define PROBE_MODE 0

typedef unsigned short bf16_t;
typedef short bf16x8 __attribute__((ext_vector_type(8)));
typedef float f32x4 __attribute__((ext_vector_type(4)));
typedef unsigned u32x4 __attribute__((ext_vector_type(4)));

constexpr int T = 32768, SEQ = 8192, D = 1024, NP = 2048, DC = 512, NE = 32, DE = 256, NBUCK = 112;
constexpr float EPS = 1e-6f;
constexpr size_t MiB = 1024 * 1024;
constexpr size_t OFF_A = 0;
constexpr size_t OFF_B = 64 * MiB;
constexpr size_t OFF_C = 192 * MiB;
constexpr size_t OFF_WIN = 256 * MiB;
constexpr size_t OFF_WOUT = 260 * MiB;
constexpr size_t OFF_WGU = 262 * MiB;
constexpr size_t OFF_WD = 294 * MiB;
constexpr size_t OFF_POOL = 310 * MiB;
constexpr size_t OFF_WR = OFF_POOL + 128 * 1024;
constexpr size_t OFF_PM = OFF_WR + 128 * 1024;
constexpr size_t OFF_RSTD1 = OFF_PM + 64 * 1024;
constexpr size_t OFF_SSQ2 = OFF_RSTD1 + 128 * 1024;
constexpr size_t OFF_RT = OFF_SSQ2 + 2 * MiB;
constexpr size_t OFF_EL = OFF_RT + 512 * 1024;
constexpr size_t OFF_PL = OFF_EL + 4 * MiB;
constexpr size_t OFF_H = 336 * MiB;
constexpr size_t OFF_BAR = OFF_H + 64 * MiB;
constexpr size_t WS_END = OFF_BAR + 16384;
constexpr size_t OFF_CNT = OFF_BAR + 14336;

struct Params {
    const float *x, *meta, *norm_mix, *w_in, *conv_w, *norm_conv_out, *pool_w, *pool_scale, *norm_pool_out, *w_out, *norm_ffn,
        *w_rg, *w_re, *w_gate, *w_up, *w_down, *final_norm;
    float* out;
    unsigned char* ws;
};

__device__ __forceinline__ float bf2f(bf16_t v) { return __uint_as_float(((unsigned)v) << 16); }
__device__ __forceinline__ bf16_t f2bf(float f) { unsigned u = __float_as_uint(f); u += 0x7fffu + ((u >> 16) & 1u); return (bf16_t)(u >> 16); }
__device__ __forceinline__ unsigned pack2(float lo, float hi) { return (unsigned)f2bf(lo) | ((unsigned)f2bf(hi) << 16); }
__device__ __forceinline__ float wave_sum(float v) {
#pragma unroll
    for (int o = 32; o > 0; o >>= 1) v += __shfl_xor(v, o);
    return v;
}
__device__ __forceinline__ int pair_off(int a) { return a * 8 - (a * (a + 1)) / 2; }

struct TrItem { const float* src; bf16_t* dst; const float* kscale; int ld_src, ld_dst, k0, n0, mapmode; };
__device__ __forceinline__ int tr_map(int mode, int h) { return mode == 0 ? h : ((h >> 5) << 6) + (h & 31) + (mode == 2 ? 32 : 0); }

constexpr int P0_PM = 32, P0_XR = 1024  , P0_WIN = 16 * 8, P0_WOUT = 16 * 4, P0_GATE = 32 * 16, P0_UP = P0_GATE, P0_DOWN = 32 * 4 * 4, P0_WR = 16, P0_POOL = 8;
constexpr int P0_TR0 = P0_PM + P0_XR, P0_TR = P0_WIN + P0_WOUT + P0_GATE + P0_UP + P0_DOWN, P0_ITEMS = P0_TR0 + P0_TR + P0_WR + P0_POOL;

__device__ __forceinline__ bool p0_tr_decode(const Params& p, int it, TrItem& t) {
    int i = it - P0_TR0; if (i < 0 || i >= P0_TR) return false;
    if (i < P0_WIN) { t.src = p.w_in; t.ld_src = NP; t.dst = (bf16_t*)(p.ws + OFF_WIN); t.ld_dst = D; t.k0 = (i & 15) * 64; t.n0 = (i >> 4) * 256; t.kscale = p.norm_mix; t.mapmode = 0; return true; }
    i -= P0_WIN;
    if (i < P0_WOUT) { t.src = p.w_out; t.ld_src = D; t.dst = (bf16_t*)(p.ws + OFF_WOUT); t.ld_dst = D; t.k0 = (i & 15) * 64; t.n0 = (i >> 4) * 256;
        t.kscale = (t.k0 < DC) ? p.norm_conv_out : (p.norm_pool_out - DC); t.mapmode = 0; return true; }
    i -= P0_WOUT;
    if (i < P0_GATE + P0_UP) { const int up = i >= P0_GATE; if (up) i -= P0_GATE; const int ex = i >> 4;
        t.src = (up ? p.w_up : p.w_gate) + (size_t)ex * D * DE; t.ld_src = DE; t.dst = (bf16_t*)(p.ws + OFF_WGU) + (size_t)ex * 512 * D; t.ld_dst = D; t.k0 = (i & 15) * 64; t.n0 = 0;
        t.kscale = p.norm_ffn; t.mapmode = up ? 2 : 1; return true; }
    i -= P0_GATE + P0_UP;
    { const int ex = i >> 4; t.src = p.w_down + (size_t)ex * DE * D; t.ld_src = D; t.dst = (bf16_t*)(p.ws + OFF_WD) + (size_t)ex * D * DE; t.ld_dst = DE; t.k0 = ((i >> 2) & 3) * 64; t.n0 = (i & 3) * 256;
      t.kscale = nullptr; t.mapmode = 0; return true; }
}
__device__ __forceinline__ void p0_tr_load(const TrItem& t, float4 (&v)[8]) {
    const int tid = threadIdx.x;
#pragma unroll
    for (int i = 0; i < 8; ++i) { const int idx = tid + 512 * i, k = idx >> 6, n4 = idx & 63;
        v[i] = *(const float4*)(t.src + (size_t)(t.k0 + k) * t.ld_src + t.n0 + n4 * 4);
        if (t.kscale) { const float s = t.kscale[t.k0 + k]; v[i].x *= s; v[i].y *= s; v[i].z *= s; v[i].w *= s; } }
}

__device__ __forceinline__ void phase0(const Params& p, unsigned char* lds, int bid, int nb) {
    float* tile = (float*)lds;
    const int t = threadIdx.x, wid = t >> 6, lane = t & 63;
    bf16_t* xb = (bf16_t*)(p.ws + OFF_A);
    float* rstd1 = (float*)(p.ws + OFF_RSTD1);
    float4 v[8];
    TrItem cur, nxt;
    int first = bid; while (first < P0_TR0) first += nb;
    bool have = p0_tr_decode(p, first, cur);
    if (have) p0_tr_load(cur, v);
    for (int it = bid; it < P0_ITEMS; it += nb) {
        if (it < P0_PM) {
            const int i = it;
            float* metan = (float*)lds;
            float* red = (float*)(lds + 65536);
            for (int rr = 0; rr < 2; ++rr) { const int r = wid * 2 + rr; const float* mr = p.meta + (size_t)r * D;
                float mv[16]; float ss = 0.f;
#pragma unroll
                for (int j = 0; j < 16; ++j) { mv[j] = mr[j * 64 + lane]; ss += mv[j] * mv[j]; }
                ss = wave_sum(ss); const float rs = rsqrtf(ss * (1.0f / D) + EPS);
#pragma unroll
                for (int j = 0; j < 16; ++j) metan[r * D + j * 64 + lane] = mv[j] * rs * p.norm_mix[j * 64 + lane]; }
            __syncthreads();
            const int col = i * 64 + lane, ks = wid;
            float acc[16];
#pragma unroll
            for (int r = 0; r < 16; ++r) acc[r] = 0.f;
#pragma unroll 4
            for (int k = ks * 128; k < ks * 128 + 128; ++k) { const float w = p.w_in[(size_t)k * NP + col];
#pragma unroll
                for (int r = 0; r < 16; ++r) acc[r] += metan[r * D + k] * w; }
#pragma unroll
            for (int r = 0; r < 16; ++r) red[(ks * 16 + r) * 64 + lane] = acc[r];
            __syncthreads();
            bf16_t* pm = (bf16_t*)(p.ws + OFF_PM);
            for (int q = t; q < 1024; q += 512) { const int r = q >> 6, c = q & 63; float s = 0.f;
#pragma unroll
                for (int k8 = 0; k8 < 8; ++k8) s += red[(k8 * 16 + r) * 64 + c];
                pm[(size_t)r * NP + i * 64 + c] = f2bf(s); }
            __syncthreads();
        } else if (it < P0_TR0) {
            const int r0 = (it - P0_PM) * 32 + wid * 4;
            float4 a[4][4];
#pragma unroll
            for (int q = 0; q < 4; ++q)
#pragma unroll
                for (int j = 0; j < 2; ++j) { const float* xr = p.x + (size_t)(r0 + q) * D + j * 512 + lane * 8; a[q][2 * j] = *(const float4*)xr; a[q][2 * j + 1] = *(const float4*)(xr + 4); }
#pragma unroll
            for (int q = 0; q < 4; ++q) { float ss = 0.f;
#pragma unroll
                for (int j = 0; j < 2; ++j) { const float4 u0 = a[q][2 * j], u1 = a[q][2 * j + 1];
                    ss += u0.x * u0.x + u0.y * u0.y + u0.z * u0.z + u0.w * u0.w + u1.x * u1.x + u1.y * u1.y + u1.z * u1.z + u1.w * u1.w;
                    *(uint4*)(xb + (size_t)(r0 + q) * D + j * 512 + lane * 8) = make_uint4(pack2(u0.x, u0.y), pack2(u0.z, u0.w), pack2(u1.x, u1.y), pack2(u1.z, u1.w)); }
                ss = wave_sum(ss);
                if (lane == 0) rstd1[r0 + q] = rsqrtf(ss * (1.0f / D) + EPS); }
        } else if (it < P0_TR0 + P0_TR) {
            __syncthreads();
#pragma unroll
            for (int i = 0; i < 8; ++i) { const int idx = t + 512 * i, k = idx >> 6, n4 = idx & 63; float* d = tile + (n4 >> 4) * (64 * 65) + k * 65 + (n4 & 15) * 4;
                d[0] = v[i].x; d[1] = v[i].y; d[2] = v[i].z; d[3] = v[i].w; }
            const bool hn = p0_tr_decode(p, it + nb, nxt);
            if (hn) p0_tr_load(nxt, v);
            __syncthreads();
            { const int n = t >> 3, ko = t & 7;
#pragma unroll
              for (int sub = 0; sub < 4; ++sub) { const float* s = tile + sub * (64 * 65) + (ko * 8) * 65 + n;
                  *(uint4*)(cur.dst + (size_t)tr_map(cur.mapmode, cur.n0 + sub * 64 + n) * cur.ld_dst + cur.k0 + ko * 8) =
                      make_uint4(pack2(s[0], s[65]), pack2(s[130], s[195]), pack2(s[260], s[325]), pack2(s[390], s[455])); } }
            cur = nxt; have = hn;
        } else if (it < P0_TR0 + P0_TR + P0_WR) {
            const int i = it - (P0_TR0 + P0_TR);
            bf16_t* wr = (bf16_t*)(p.ws + OFF_WR);
            for (int q = t; q < 4096; q += 512) { const int j = q >> 6, k = i * 64 + (q & 63);
                float val = 0.f; if (j < 4) val = p.w_rg[k * 4 + j]; else if (j < 36) val = p.w_re[k * 32 + (j - 4)];
                wr[(size_t)j * D + k] = f2bf(val * p.norm_ffn[k]); }
        } else {
            const int i = it - (P0_TR0 + P0_TR + P0_WR);
            bf16_t* pt = (bf16_t*)(p.ws + OFF_POOL);
            for (int q = t; q < 8192; q += 512) { const int o = i * 8192 + q, g = o >> 14, dd = (o >> 7) & 127, c = o & 127;
                pt[o] = f2bf(p.pool_w[(size_t)g * 16384 + c * 128 + dd]); }
        }
    }
    (void)have;
}
__device__ __forceinline__ const bf16_t* proj_row(const Params& p, int b, int s) {
    return s >= 0 ? (const bf16_t*)(p.ws + OFF_B) + ((size_t)b * SEQ + s) * NP : (const bf16_t*)(p.ws + OFF_PM) + (size_t)(16 + s) * NP;
}
#define LAS __attribute__((address_space(3)))
constexpr int LDS_STAGE = 147456, LDS_MISC = LDS_STAGE, LDS_BYTES = LDS_STAGE + 4096;

template <int WM_, int WN_, int TM_, int TN_, int BK_, int NST_>
struct GemmCfg {
    static constexpr int WM = WM_, WN = WN_, TM = TM_, TN = TN_, BK = BK_, NST = NST_;
    static constexpr int BM = WM * TM * 16, BN = WN * TN * 16;
    static constexpr int SL = BK / 8, RPC = 64 / SL;
    static constexpr int A_CH = BM / RPC, B_CH = BN / RPC, NA = (A_CH + 7) / 8, NB = (B_CH + 7) / 8;
    static constexpr int ROWB = BK * 2, A_BYTES = BM * ROWB, B_BYTES = BN * ROWB, ST_BYTES = A_BYTES + B_BYTES, KS = BK / 32;
    static constexpr bool UNIFORM = (A_CH % 8 == 0) && (B_CH % 8 == 0);
    static_assert(WM * WN == 8, "8 waves");
    static_assert(NST * ST_BYTES <= LDS_STAGE, "LDS");
    static_assert(NST == 2 || UNIFORM, "counted waits need uniform piece counts");
};
template <int BK> __device__ __forceinline__ int swz_slot(int row, int slot) {
    if (BK == 64) return slot ^ ((row >> 1) & 7);
    return slot ^ ((0 - (row >> 2)) & 3);
}
template <int TN> __device__ __forceinline__ int perm_row(int rho) {
    const int g = rho / (TN * 16), w = rho % (TN * 16), n = w >> 4, q = (w >> 2) & 3, j = w & 3;
    return g * (TN * 16) + q * (TN * 4) + n * 4 + j;
}
template <int N> __device__ __forceinline__ void wait_vm() {
    static_assert(N == 0 || N == 3 || N == 6 || N == 9 || N == 12 || N == 15, "add the count");
    if (N == 0) asm volatile("s_waitcnt vmcnt(0)" ::: "memory");
    else if (N == 3) asm volatile("s_waitcnt vmcnt(3)" ::: "memory");
    else if (N == 6) asm volatile("s_waitcnt vmcnt(6)" ::: "memory");
    else if (N == 9) asm volatile("s_waitcnt vmcnt(9)" ::: "memory");
    else if (N == 12) asm volatile("s_waitcnt vmcnt(12)" ::: "memory");
    else asm volatile("s_waitcnt vmcnt(15)" ::: "memory");
}

template <class C, class D, int MODE = 0>
__device__ __forceinline__ void gemm_stream(LAS unsigned char* lds, const D& d) {
    typedef typename D::U U;
    const int tid = threadIdx.x, wid = __builtin_amdgcn_readfirstlane(tid >> 6), lane = tid & 63, wr = wid / C::WN, wc = wid % C::WN, fr = lane & 15, fq = lane >> 4;
    const int nk = d.nk();
    U us, uc;
    int is = 0, kts = 0;
    bool more = d.get(0, us);
    unsigned offA[C::NA], offB[C::NB];
    auto set_offsets = [&](const U& u) {
#pragma unroll
        for (int i = 0; i < C::NA; ++i) { const int c = wid + 8 * i, row = c * C::RPC + lane / C::SL, sp = lane % C::SL;
            offA[i] = (c < C::A_CH) ? d.aoff(u, row) + (unsigned)swz_slot<C::BK>(row, sp) * 16u : 0u; }
#pragma unroll
        for (int i = 0; i < C::NB; ++i) { const int c = wid + 8 * i, row = c * C::RPC + lane / C::SL, sp = lane % C::SL;
            offB[i] = (c < C::B_CH) ? d.boff(u, row) + (unsigned)swz_slot<C::BK>(row, sp) * 16u : 0u; }
    };
    if (more) set_offsets(us);
    int aread[C::KS], bread[C::KS];
#pragma unroll
    for (int ks = 0; ks < C::KS; ++ks) {
        aread[ks] = (wr * C::TM * 16 + fr) * C::ROWB + swz_slot<C::BK>(fr, ks * 4 + fq) * 16;
        bread[ks] = C::A_BYTES + (wc * C::TN * 16 + fr) * C::ROWB + swz_slot<C::BK>(fr, ks * 4 + fq) * 16;
    }
    f32x4 acc[C::TM][C::TN];
    typename D::R rs;
    int issued = 0, sbuf = 0;
    auto stage_next = [&]() {
        if (!more) return;
        const char* ab = d.abase(us, kts); const char* bb = d.bbase(us, kts);
        LAS unsigned char* sa = lds + sbuf;
        if (!(MODE & 4)) {
#pragma unroll
        for (int i = 0; i < C::NA; ++i) { const int c = wid + 8 * i;
            if (c < C::A_CH) __builtin_amdgcn_global_load_lds((const unsigned*)(ab + offA[i]), (LAS unsigned*)(sa + c * 1024), 16, 0, 0); }
#pragma unroll
        for (int i = 0; i < C::NB; ++i) { const int c = wid + 8 * i;
            if (c < C::B_CH) __builtin_amdgcn_global_load_lds((const unsigned*)(bb + offB[i]), (LAS unsigned*)(sa + C::A_BYTES + c * 1024), 16, 0, 0); }
        }
        ++issued; sbuf += C::ST_BYTES; if (sbuf == C::NST * C::ST_BYTES) sbuf = 0;
        if (++kts == nk) { kts = 0; ++is; more = d.get(is, us); if (more) set_offsets(us); }
    };
    __syncthreads();
    stage_next();
    if (C::NST == 3) stage_next();
    int g = 0, cbuf = 0;
    for (int ic = 0; d.get(ic, uc); ++ic) {
        d.init(uc, acc, rs, wr, wc, fr, fq);
        for (int kt = 0; kt < nk; ++kt, ++g) {
            if (C::NST == 3 && issued > g + 1) wait_vm<C::UNIFORM ? C::NA + C::NB : 0>(); else wait_vm<0>();
            __builtin_amdgcn_s_barrier();
            asm volatile("" ::: "memory");
            stage_next();
            const LAS unsigned char* sa = lds + cbuf;
            if (!(MODE & 2)) {
#pragma unroll
            for (int ks = 0; ks < C::KS; ++ks) {
                bf16x8 af[C::TM], bfr[C::TN];
#pragma unroll
                for (int m = 0; m < C::TM; ++m) af[m] = *(const LAS bf16x8*)(sa + aread[ks] + m * 16 * C::ROWB);
#pragma unroll
                for (int n = 0; n < C::TN; ++n) bfr[n] = *(const LAS bf16x8*)(sa + bread[ks] + n * 16 * C::ROWB);
#pragma unroll
                for (int m = 0; m < C::TM; ++m)
#pragma unroll
                    for (int n = 0; n < C::TN; ++n) acc[m][n] = __builtin_amdgcn_mfma_f32_16x16x32_bf16(bfr[n], af[m], acc[m][n], 0, 0, 0);
            }
            }
            cbuf += C::ST_BYTES; if (cbuf == C::NST * C::ST_BYTES) cbuf = 0;
        }
        if (!(MODE & 1)) d.epi(uc, acc, rs, wr, wc, fr, fq);
        else { float s = 0.f;
#pragma unroll
            for (int m = 0; m < C::TM; ++m)
#pragma unroll
                for (int n = 0; n < C::TN; ++n) s += acc[m][n][0] + acc[m][n][1] + acc[m][n][2] + acc[m][n][3];
            if (s == 123.456f) *(float*)d.sink() = s; }
    }
}

template <class C, class D, int MODE = 0>
__device__ __forceinline__ void gemm_stream3(LAS unsigned char* lds, const D& d) {
    static_assert(C::KS == 2 && C::UNIFORM && C::NST == 3, "BK = 64, 3 buffers, uniform pieces");
    constexpr int P = C::NA + C::NB;
    typedef typename D::U U;
    const int tid = threadIdx.x, wid = __builtin_amdgcn_readfirstlane(tid >> 6), lane = tid & 63, wr = wid / C::WN, wc = wid % C::WN, fr = lane & 15, fq = lane >> 4;
    const int half = wid >> 2;
    const int nk = d.nk();
    U us, uc;
    int is = 0, kts = 0;
    bool more = d.get(0, us);
    if (!more) return;
    unsigned offA[C::NA], offB[C::NB];
    auto set_offsets = [&](const U& u) {
#pragma unroll
        for (int i = 0; i < C::NA; ++i) { const int c = wid + 8 * i, row = c * C::RPC + lane / C::SL, sp = lane % C::SL;
            offA[i] = d.aoff(u, row) + (unsigned)swz_slot<C::BK>(row, sp) * 16u; }
#pragma unroll
        for (int i = 0; i < C::NB; ++i) { const int c = wid + 8 * i, row = c * C::RPC + lane / C::SL, sp = lane % C::SL;
            offB[i] = d.boff(u, row) + (unsigned)swz_slot<C::BK>(row, sp) * 16u; }
    };
    set_offsets(us);
    int aread[2], bread[2];
#pragma unroll
    for (int ks = 0; ks < 2; ++ks) {
        aread[ks] = (wr * C::TM * 16 + fr) * C::ROWB + swz_slot<C::BK>(fr, ks * 4 + fq) * 16;
        bread[ks] = C::A_BYTES + (wc * C::TN * 16 + fr) * C::ROWB + swz_slot<C::BK>(fr, ks * 4 + fq) * 16;
    }
    f32x4 acc[C::TM][C::TN];
    typename D::R rs;
    int sbuf = 0;
    auto stage_next = [&]() -> bool {
        if (!more) return false;
        const char* ab = d.abase(us, kts); const char* bb = d.bbase(us, kts);
        LAS unsigned char* sa = lds + sbuf;
        if (!(MODE & 4)) {
#pragma unroll
        for (int i = 0; i < C::NA; ++i) __builtin_amdgcn_global_load_lds((const unsigned*)(ab + offA[i]), (LAS unsigned*)(sa + (wid + 8 * i) * 1024), 16, 0, 0);
#pragma unroll
        for (int i = 0; i < C::NB; ++i) __builtin_amdgcn_global_load_lds((const unsigned*)(bb + offB[i]), (LAS unsigned*)(sa + C::A_BYTES + (wid + 8 * i) * 1024), 16, 0, 0);
        }
        sbuf += C::ST_BYTES; if (sbuf == C::NST * C::ST_BYTES) sbuf = 0;
        if (++kts == nk) { kts = 0; ++is; more = d.get(is, us); if (more) set_offsets(us); }
        return true;
    };
    bf16x8 fa[C::TM], fb[C::TN];
    int cbuf = 0;
    auto read_frags = [&](int ks) {
        const LAS unsigned char* sa = lds + cbuf;
        if (!(MODE & 2)) {
#pragma unroll
        for (int m = 0; m < C::TM; ++m) fa[m] = *(const LAS bf16x8*)(sa + aread[ks] + m * 16 * C::ROWB);
#pragma unroll
        for (int n = 0; n < C::TN; ++n) fb[n] = *(const LAS bf16x8*)(sa + bread[ks] + n * 16 * C::ROWB);
        }
    };
    auto mma = [&]() {
        asm volatile("s_waitcnt lgkmcnt(0)" ::: "memory");
        if (!(MODE & 2)) {
        __builtin_amdgcn_s_setprio(1);
#pragma unroll
        for (int m = 0; m < C::TM; ++m)
#pragma unroll
            for (int n = 0; n < C::TN; ++n) acc[m][n] = __builtin_amdgcn_mfma_f32_16x16x32_bf16(fb[n], fa[m], acc[m][n], 0, 0, 0);
        __builtin_amdgcn_s_setprio(0);
        }
    };
#define GS3_BAR() do { asm volatile("" ::: "memory"); __builtin_amdgcn_s_barrier(); asm volatile("" ::: "memory"); } while (0)
    __syncthreads();
    stage_next();
    const bool two = stage_next();
    if (two) wait_vm<P>(); else wait_vm<0>();
    GS3_BAR();
    if (half) GS3_BAR();
    for (int ic = 0; d.get(ic, uc); ++ic) {
        d.init(uc, acc, rs, wr, wc, fr, fq);
        for (int kt = 0; kt < nk; ++kt) {
            read_frags(0);
            GS3_BAR();
            mma();
            GS3_BAR();
            read_frags(1);
            if (stage_next()) wait_vm<P>(); else wait_vm<0>();
            GS3_BAR();
            mma();
            GS3_BAR();
            cbuf += C::ST_BYTES; if (cbuf == C::NST * C::ST_BYTES) cbuf = 0;
        }
        if (!(MODE & 1)) d.epi(uc, acc, rs, wr, wc, fr, fq);
        else { float s = 0.f;
#pragma unroll
            for (int m = 0; m < C::TM; ++m)
#pragma unroll
                for (int n = 0; n < C::TN; ++n) s += acc[m][n][0] + acc[m][n][1] + acc[m][n][2] + acc[m][n][3];
            if (s == 123.456f) *(float*)d.sink() = s; }
    }
    if (!half) GS3_BAR();
    asm volatile("s_waitcnt vmcnt(0) lgkmcnt(0)" ::: "memory");
#undef GS3_BAR
}

typedef GemmCfg<4, 2, 4, 4, 64, 3> CfgA;
typedef GemmCfg<8, 1, 1, 4, 64, 2> CfgR;
typedef GemmCfg<1, 8, 4, 8, 32, 2> CfgD;

__device__ __forceinline__ float lo_bf(unsigned w) { return __uint_as_float(w << 16); }
__device__ __forceinline__ float hi_bf(unsigned w) { return __uint_as_float(w & 0xffff0000u); }

struct P1Desc {
    struct U { int mt, nt; };
    struct R { float rs[4]; };
    const char* xb; const char* w; bf16_t* proj; const float* rstd1; int bid, nb;
    __device__ __forceinline__ bool get(int i, U& u) const { const int uu = i * nb + bid; if (uu >= 2048) return false;
        const int g = uu >> 8, b = uu & 255, xcd = b & 7, j = b >> 3; u.mt = g * 16 + (xcd >> 1) * 4 + (j >> 3); u.nt = (xcd & 1) * 8 + (j & 7); return true; }
    __device__ __forceinline__ int nk() const { return 16; }
    __device__ __forceinline__ unsigned aoff(const U& u, int row) const { return (unsigned)(u.mt * 256 + row) * 2048u; }
    __device__ __forceinline__ unsigned boff(const U& u, int rho) const { return (unsigned)(u.nt * 128 + perm_row<4>(rho)) * 2048u; }
    __device__ __forceinline__ const char* abase(const U&, int kt) const { return xb + kt * 128; }
    __device__ __forceinline__ const char* bbase(const U&, int kt) const { return w + kt * 128; }
    __device__ __forceinline__ void* sink() const { return (void*)proj; }
    template <class Acc> __device__ __forceinline__ void init(const U& u, Acc& acc, R& r, int wr, int wc, int fr, int fq) const {
#pragma unroll
        for (int m = 0; m < 4; ++m) { r.rs[m] = rstd1[u.mt * 256 + wr * 64 + m * 16 + fr];
#pragma unroll
            for (int n = 0; n < 4; ++n) acc[m][n] = (f32x4){0.f, 0.f, 0.f, 0.f}; }
    }
    template <class Acc> __device__ __forceinline__ void epi(const U& u, Acc& acc, const R& r, int wr, int wc, int fr, int fq) const {
        const int col = u.nt * 128 + wc * 64 + fq * 16;
#pragma unroll
        for (int m = 0; m < 4; ++m) { const int row = u.mt * 256 + wr * 64 + m * 16 + fr; const float rs = r.rs[m];
            bf16_t* dst = proj + (size_t)row * NP + col;
#pragma unroll
            for (int h = 0; h < 2; ++h) { const f32x4 a = acc[m][2 * h] * rs, b = acc[m][2 * h + 1] * rs;
                *(uint4*)(dst + 8 * h) = make_uint4(pack2(a[0], a[1]), pack2(a[2], a[3]), pack2(b[0], b[1]), pack2(b[2], b[3])); } }
    }
};
template <int MODE = 0> __device__ __forceinline__ void phase1(const Params& p, LAS unsigned char* lds, int bid, int nb) {
    P1Desc d; d.xb = (const char*)(p.ws + OFF_A); d.w = (const char*)(p.ws + OFF_WIN); d.proj = (bf16_t*)(p.ws + OFF_B); d.rstd1 = (const float*)(p.ws + OFF_RSTD1); d.bid = bid; d.nb = nb;
    gemm_stream3<CfgA, P1Desc, MODE>(lds, d);
}
struct P3Desc {
    __device__ __forceinline__ void* sink() const { return (void*)hb; }
    struct U { int mt, nt; };
    struct R { int dummy; };
    const char* y; const char* w; const bf16_t* xb; bf16_t* hb; float* ssq2; int bid, nb;
    __device__ __forceinline__ bool get(int i, U& u) const { const int uu = i * nb + bid; if (uu >= 1024) return false;
        const int g = uu >> 8, b = uu & 255, xcd = b & 7, j = b >> 3; u.mt = g * 32 + xcd * 4 + (j >> 3); u.nt = j & 7; return true; }
    __device__ __forceinline__ int nk() const { return 16; }
    __device__ __forceinline__ unsigned aoff(const U& u, int row) const { return (unsigned)(u.mt * 256 + row) * 2048u; }
    __device__ __forceinline__ unsigned boff(const U& u, int rho) const { return (unsigned)(u.nt * 128 + perm_row<4>(rho)) * 2048u; }
    __device__ __forceinline__ const char* abase(const U&, int kt) const { return y + kt * 128; }
    __device__ __forceinline__ const char* bbase(const U&, int kt) const { return w + kt * 128; }
    template <class Acc> __device__ __forceinline__ void init(const U& u, Acc& acc, R& r, int wr, int wc, int fr, int fq) const {
        const int col = u.nt * 128 + wc * 64 + fq * 16;
#pragma unroll
        for (int m = 0; m < 4; ++m) { const size_t o = (size_t)(u.mt * 256 + wr * 64 + m * 16 + fr) * D + col;
#pragma unroll
            for (int h = 0; h < 2; ++h) { const uint4 xr = *(const uint4*)(xb + o + 8 * h);
                acc[m][2 * h] = (f32x4){lo_bf(xr.x), hi_bf(xr.x), lo_bf(xr.y), hi_bf(xr.y)}; acc[m][2 * h + 1] = (f32x4){lo_bf(xr.z), hi_bf(xr.z), lo_bf(xr.w), hi_bf(xr.w)}; } }
    }
    template <class Acc> __device__ __forceinline__ void epi(const U& u, Acc& acc, const R& r, int wr, int wc, int fr, int fq) const {
        const int col = u.nt * 128 + wc * 64 + fq * 16;
#pragma unroll
        for (int m = 0; m < 4; ++m) { const int row = u.mt * 256 + wr * 64 + m * 16 + fr; const size_t o = (size_t)row * D + col; float ss = 0.f;
#pragma unroll
            for (int h = 0; h < 2; ++h) { const f32x4 a = acc[m][2 * h], b = acc[m][2 * h + 1];
                *(uint4*)(hb + o + 8 * h) = make_uint4(pack2(a[0], a[1]), pack2(a[2], a[3]), pack2(b[0], b[1]), pack2(b[2], b[3]));
                ss += a[0] * a[0] + a[1] * a[1] + a[2] * a[2] + a[3] * a[3] + b[0] * b[0] + b[1] * b[1] + b[2] * b[2] + b[3] * b[3]; }
            ss += __shfl_xor(ss, 16); ss += __shfl_xor(ss, 32);
            if (fq == 0) ssq2[(size_t)row * 16 + u.nt * 2 + wc] = ss; }
    }
};
__device__ __forceinline__ void phase3(const Params& p, LAS unsigned char* lds, int bid, int nb) {
    P3Desc d; d.y = (const char*)(p.ws + OFF_C); d.w = (const char*)(p.ws + OFF_WOUT); d.xb = (const bf16_t*)(p.ws + OFF_A); d.hb = (bf16_t*)(p.ws + OFF_H);
    d.ssq2 = (float*)(p.ws + OFF_SSQ2); d.bid = bid; d.nb = nb;
    gemm_stream3<CfgA>(lds, d);
}
struct P4Desc {
    __device__ __forceinline__ void* sink() const { return (void*)ws; }
    struct U { int u; };
    struct R { int dummy; };
    template <class Acc> __device__ __forceinline__ void init(const U&, Acc& acc, R&, int, int, int, int) const {
#pragma unroll
        for (int n = 0; n < 4; ++n) acc[0][n] = (f32x4){0.f, 0.f, 0.f, 0.f}; }
    const char* hb; const char* w; const float* ssq2; unsigned char* ws; LAS unsigned char* lds; int bid, nb;
    __device__ __forceinline__ bool get(int i, U& u) const { u.u = i * nb + bid; return u.u < 256; }
    __device__ __forceinline__ int nk() const { return 16; }
    __device__ __forceinline__ unsigned aoff(const U& u, int row) const { return (unsigned)(u.u * 128 + row) * 2048u; }
    __device__ __forceinline__ unsigned boff(const U&, int rho) const { return (unsigned)rho * 2048u; }
    __device__ __forceinline__ const char* abase(const U&, int kt) const { return hb + kt * 128; }
    __device__ __forceinline__ const char* bbase(const U&, int kt) const { return w + kt * 128; }
    template <class Acc> __device__ __forceinline__ void epi(const U& uu, Acc& acc, const R&, int wr, int wc, int fr, int fq) const {
        LAS int* hist = (LAS int*)(lds + LDS_MISC);
        LAS int* base = (LAS int*)(lds + LDS_MISC + 1024);
        LAS float* lg = (LAS float*)(lds + 65536);
        int* cnt = (int*)(ws + OFF_CNT); int* el = (int*)(ws + OFF_EL); int* pl = (int*)(ws + OFF_PL);
        __syncthreads();
#pragma unroll
        for (int n = 0; n < 4; ++n)
#pragma unroll
            for (int j = 0; j < 4; ++j) { const int col = n * 16 + fq * 4 + j; if (col < 36) lg[(wr * 16 + fr) * 37 + col] = acc[0][n][j]; }
        if (threadIdx.x < 144) hist[threadIdx.x] = 0;
        __syncthreads();
        const int t = threadIdx.x, r = uu.u * 128 + t;
        int e0 = 0, e1 = 0, bucket = 0, r0 = 0, r1 = 0, rb = 0; float ga = 0.f, gb = 0.f, rstd2 = 0.f;
        if (t < 128) { const float* q = ssq2 + (size_t)r * 16; float ss = 0.f;
#pragma unroll
            for (int j = 0; j < 16; ++j) ss += q[j];
            rstd2 = rsqrtf(ss * (1.0f / D) + EPS);
            const LAS float* mine = lg + t * 37;
            int gs = 0; float gm = mine[0];
#pragma unroll
            for (int j = 1; j < 4; ++j) { const float v = mine[j]; if (v > gm) { gm = v; gs = j; } }
            float den = 0.f;
#pragma unroll
            for (int j = 0; j < 4; ++j) den += __expf((mine[j] - gm) * rstd2);
            const float g1 = 1.0f / den;
            const LAS float* le = mine + 4 + gs * 8;
            int i0 = 0; float l0 = le[0];
#pragma unroll
            for (int j = 1; j < 8; ++j) { const float v = le[j]; if (v > l0) { l0 = v; i0 = j; } }
            int i1 = -1; float l1 = -3.0e38f;
#pragma unroll
            for (int j = 0; j < 8; ++j) { const float v = le[j]; if (j != i0 && v > l1) { l1 = v; i1 = j; } }
            const float w0 = 1.0f / (1.0f + __expf((l1 - l0) * rstd2)), w1 = 1.0f - w0;
            int a = i0, bb = i1; ga = g1 * w0; gb = g1 * w1;
            if (a > bb) { const int ti = a; a = bb; bb = ti; const float tf = ga; ga = gb; gb = tf; }
            e0 = gs * 8 + a; e1 = gs * 8 + bb; bucket = gs * 28 + pair_off(a) + (bb - a - 1);
            r0 = __hip_atomic_fetch_add(&hist[e0], 1, __ATOMIC_RELAXED, __HIP_MEMORY_SCOPE_WORKGROUP); r1 = __hip_atomic_fetch_add(&hist[e1], 1, __ATOMIC_RELAXED, __HIP_MEMORY_SCOPE_WORKGROUP);
            rb = __hip_atomic_fetch_add(&hist[32 + bucket], 1, __ATOMIC_RELAXED, __HIP_MEMORY_SCOPE_WORKGROUP); }
        __syncthreads();
        if (t < 144) { const int c = hist[t]; base[t] = c ? atomicAdd(&cnt[t], c) : 0; }
        __syncthreads();
        if (t < 128) { int4 rec; rec.x = e0 | (e1 << 8) | (bucket << 16); rec.y = __float_as_int(ga); rec.z = __float_as_int(gb); rec.w = __float_as_int(rstd2);
            ((int4*)(ws + OFF_RT))[r] = rec;
            el[(size_t)e0 * T + base[e0] + r0] = r * 2; el[(size_t)e1 * T + base[e1] + r1] = r * 2 + 1; pl[(size_t)bucket * T + base[32 + bucket] + rb] = r; }
    }
};
__device__ __forceinline__ void phase4(const Params& p, LAS unsigned char* lds, int bid, int nb) {
    P4Desc d; d.hb = (const char*)(p.ws + OFF_H); d.w = (const char*)(p.ws + OFF_WR); d.ssq2 = (const float*)(p.ws + OFF_SSQ2); d.ws = p.ws; d.lds = lds; d.bid = bid; d.nb = nb;
    gemm_stream<CfgR>(lds, d);
}
struct P5aDesc {
    __device__ __forceinline__ void* sink() const { return (void*)act; }
    struct U { int e, mtile, ntile, ce; };
    struct R { int ent[4]; float gate[4], rs[4]; };
    template <class Acc> __device__ __forceinline__ void init(const U& u, Acc& acc, R& r, int wr, int wc, int fr, int fq) const {
        const int* list = el + (size_t)u.e * T;
#pragma unroll
        for (int m = 0; m < 4; ++m) { const int li = u.mtile * 256 + wr * 64 + m * 16 + fr; r.ent[m] = list[min(li, u.ce - 1)]; }
#pragma unroll
        for (int m = 0; m < 4; ++m) { const int4 rec = rt[r.ent[m] >> 1]; r.gate[m] = __int_as_float((r.ent[m] & 1) ? rec.z : rec.y); r.rs[m] = __int_as_float(rec.w);
#pragma unroll
            for (int n = 0; n < 4; ++n) acc[m][n] = (f32x4){0.f, 0.f, 0.f, 0.f}; }
    }
    const char* hb; const char* wgu; bf16_t* act; const int* cnt; const int* el; const int4* rt; LAS int* pre; int bid, nb;
    __device__ __forceinline__ bool get(int i, U& u) const { const int uu = i * nb + bid; if (uu >= pre[NE]) return false;
        int e = 0; while (pre[e + 1] <= uu) ++e;
        const int local = uu - pre[e]; u.e = e; u.mtile = local >> 2; u.ntile = local & 3; u.ce = cnt[e]; return true; }
    __device__ __forceinline__ int nk() const { return 16; }
    __device__ __forceinline__ unsigned aoff(const U& u, int row) const { const int li = min(u.mtile * 256 + row, u.ce - 1); return (unsigned)(el[(size_t)u.e * T + li] >> 1) * 2048u; }
    __device__ __forceinline__ unsigned boff(const U& u, int rho) const {
        const int w = rho & 31, n2 = w >> 4, q = (w >> 2) & 3, j = w & 3;
        return (unsigned)(u.e * 512 + u.ntile * 128 + (rho & ~31) + q * 8 + n2 * 4 + j) * 2048u; }
    __device__ __forceinline__ const char* abase(const U&, int kt) const { return hb + kt * 128; }
    __device__ __forceinline__ const char* bbase(const U&, int kt) const { return wgu + kt * 128; }
    template <class Acc> __device__ __forceinline__ void epi(const U& u, Acc& acc, const R& r, int wr, int wc, int fr, int fq) const {
#pragma unroll
        for (int m = 0; m < 4; ++m) { const int li = u.mtile * 256 + wr * 64 + m * 16 + fr;
            if (li < u.ce) { const int tok = r.ent[m] >> 1, slot = r.ent[m] & 1; const float gate = r.gate[m], rs = r.rs[m];
                float a[8];
#pragma unroll
                for (int n = 0; n < 2; ++n)
#pragma unroll
                    for (int j = 0; j < 4; ++j) { const float G = acc[m][n][j] * rs, Uv = acc[m][n + 2][j] * rs; a[n * 4 + j] = G / (1.0f + __expf(-G)) * Uv * gate; }
                *(uint4*)(act + (size_t)tok * 512 + slot * 256 + u.ntile * 64 + wc * 32 + fq * 8) = make_uint4(pack2(a[0], a[1]), pack2(a[2], a[3]), pack2(a[4], a[5]), pack2(a[6], a[7])); } }
    }
};
__device__ __forceinline__ void phase5a(const Params& p, LAS unsigned char* lds, int bid, int nb) {
    P5aDesc d; d.hb = (const char*)(p.ws + OFF_H); d.wgu = (const char*)(p.ws + OFF_WGU); d.act = (bf16_t*)(p.ws + OFF_B); d.cnt = (const int*)(p.ws + OFF_CNT);
    d.el = (const int*)(p.ws + OFF_EL); d.rt = (const int4*)(p.ws + OFF_RT); d.pre = (LAS int*)(lds + LDS_MISC); d.bid = bid; d.nb = nb;
    __syncthreads();
    if (threadIdx.x == 0) { int s = 0; for (int e = 0; e < NE; ++e) { d.pre[e] = s; s += ((d.cnt[e] + 255) >> 8) * 4; } d.pre[NE] = s; }
    __syncthreads();
    gemm_stream3<CfgA>(lds, d);
}
struct P5bDesc {
    __device__ __forceinline__ void* sink() const { return (void*)dst; }
    struct U { int b, mtile, cb, e0, e1; };
    struct R { int tok[4]; };
    template <class Acc> __device__ __forceinline__ void init(const U& u, Acc& acc, R& r, int wr, int wc, int fr, int fq) const {
        const int* list = pl + (size_t)u.b * T; const int col = wc * 128 + fq * 32;
#pragma unroll
        for (int m = 0; m < 4; ++m) r.tok[m] = list[min(u.mtile * 64 + m * 16 + fr, u.cb - 1)];
#pragma unroll
        for (int m = 0; m < 4; ++m) { const bf16_t* hr = hb + (size_t)r.tok[m] * D + col;
#pragma unroll
            for (int h = 0; h < 4; ++h) { const uint4 xr = *(const uint4*)(hr + 8 * h);
                acc[m][2 * h] = (f32x4){lo_bf(xr.x), hi_bf(xr.x), lo_bf(xr.y), hi_bf(xr.y)}; acc[m][2 * h + 1] = (f32x4){lo_bf(xr.z), hi_bf(xr.z), lo_bf(xr.w), hi_bf(xr.w)}; } }
    }
    const char* act; const char* wd; const int* cnt; const int* pl; const bf16_t* hb; const LAS float* fnorm; float* dst; LAS int* pre; LAS float* red; int bid, nb;
    __device__ __forceinline__ bool get(int i, U& u) const { const int uu = i * nb + bid; if (uu >= pre[NBUCK]) return false;
        int b = 0; while (pre[b + 1] <= uu) ++b;
        u.b = b; u.mtile = uu - pre[b]; u.cb = cnt[b]; const int g = b / 28, pi = b % 28;
        int a = 0; while (a < 6 && pair_off(a + 1) <= pi) ++a;
        u.e0 = g * 8 + a; u.e1 = g * 8 + a + 1 + (pi - pair_off(a)); return true; }
    __device__ __forceinline__ int nk() const { return 16; }
    __device__ __forceinline__ unsigned aoff(const U& u, int row) const { const int li = min(u.mtile * 64 + row, u.cb - 1); return (unsigned)pl[(size_t)u.b * T + li] * 1024u; }
    __device__ __forceinline__ unsigned boff(const U&, int rho) const { return (unsigned)perm_row<8>(rho) * 512u; }
    __device__ __forceinline__ const char* abase(const U&, int kt) const { return act + kt * 64; }
    __device__ __forceinline__ const char* bbase(const U& u, int kt) const { return kt < 8 ? wd + (size_t)u.e0 * (D * DE * 2) + kt * 64 : wd + (size_t)u.e1 * (D * DE * 2) + (kt - 8) * 64; }
    template <class Acc> __device__ __forceinline__ void epi(const U& u, Acc& acc, const R& r, int wr, int wc, int fr, int fq) const {
        const int col = wc * 128 + fq * 32;
#pragma unroll
        for (int m = 0; m < 4; ++m) { float ss = 0.f;
#pragma unroll
            for (int n = 0; n < 8; ++n) ss += acc[m][n][0] * acc[m][n][0] + acc[m][n][1] * acc[m][n][1] + acc[m][n][2] * acc[m][n][2] + acc[m][n][3] * acc[m][n][3];
            ss += __shfl_xor(ss, 16); ss += __shfl_xor(ss, 32);
            if (fq == 0) red[(m * 16 + fr) * 8 + wc] = ss; }
        __syncthreads();
#pragma unroll
        for (int m = 0; m < 4; ++m) { float ss = 0.f;
#pragma unroll
            for (int w8 = 0; w8 < 8; ++w8) ss += red[(m * 16 + fr) * 8 + w8];
            const float rs = rsqrtf(ss * (1.0f / D) + EPS);
            if (u.mtile * 64 + m * 16 + fr < u.cb) { float* o = dst + (size_t)r.tok[m] * D + col;
#pragma unroll
                for (int n = 0; n < 8; ++n) { const f32x4 gf = *(const LAS f32x4*)(fnorm + col + n * 4);
                    *(float4*)(o + n * 4) = make_float4(acc[m][n][0] * rs * gf[0], acc[m][n][1] * rs * gf[1], acc[m][n][2] * rs * gf[2], acc[m][n][3] * rs * gf[3]); } } }
        __syncthreads();
    }
};
template <int MODE = 0> __device__ __forceinline__ void phase5b(const Params& p, LAS unsigned char* lds, int bid, int nb, float* dst) {
    P5bDesc d; d.act = (const char*)(p.ws + OFF_B); d.wd = (const char*)(p.ws + OFF_WD); d.cnt = (const int*)(p.ws + OFF_CNT) + 32; d.pl = (const int*)(p.ws + OFF_PL);
    d.hb = (const bf16_t*)(p.ws + OFF_H); d.fnorm = (const LAS float*)(lds + 139264); d.dst = dst; d.pre = (LAS int*)(lds + LDS_MISC); d.red = (LAS float*)(lds + LDS_MISC + 1024); d.bid = bid; d.nb = nb;
    __syncthreads();
    { LAS float* fn = (LAS float*)(lds + 139264); fn[threadIdx.x] = p.final_norm[threadIdx.x]; fn[threadIdx.x + 512] = p.final_norm[threadIdx.x + 512]; }
    if (threadIdx.x == 0) { int s = 0; for (int b = 0; b < NBUCK; ++b) { d.pre[b] = s; s += (d.cnt[b] + 63) >> 6; } d.pre[NBUCK] = s; }
    __syncthreads();
    gemm_stream<CfgD, P5bDesc, MODE>(lds, d);
}
__device__ __forceinline__ void unpack8(const uint4 v, float* f) {
    f[0] = __uint_as_float(v.x << 16); f[1] = __uint_as_float(v.x & 0xffff0000u); f[2] = __uint_as_float(v.y << 16); f[3] = __uint_as_float(v.y & 0xffff0000u);
    f[4] = __uint_as_float(v.z << 16); f[5] = __uint_as_float(v.z & 0xffff0000u); f[6] = __uint_as_float(v.w << 16); f[7] = __uint_as_float(v.w & 0xffff0000u);
}
__device__ __forceinline__ void phase2(const Params& p, LAS unsigned char* lds, int bid, int nb) {
    const int tid = threadIdx.x, wid = __builtin_amdgcn_readfirstlane(tid >> 6), lane = tid & 63, fr = lane & 15, fq = lane >> 4;
    bf16_t* y = (bf16_t*)(p.ws + OFF_C);
    LAS float* red = (LAS float*)(lds + LDS_MISC + 1024);
    const int cch = lane * 8;
    const int g = wid >> 1, nh = wid & 1;
    const bf16_t* pw = (const bf16_t*)(p.ws + OFF_POOL);
    for (int unit = bid; unit < T / 64; unit += nb) {
        const int R0 = unit * 64, b = R0 >> 13, s0 = R0 & 8191;
        __syncthreads();
        {
            const int cvl = lane & 15, rq = lane >> 4, rbase = (wid & 1) * 32 + rq * 8, col = 1536 + g * 128 + cvl * 8, w = 2 << g;
            const float invw = 1.0f / (float)w;
            float run[8], f[8];
#pragma unroll
            for (int j = 0; j < 8; ++j) run[j] = 0.f;
            for (int q = 1; q < w; ++q) { unpack8(*(const uint4*)(proj_row(p, b, s0 + rbase - q) + col), f);
#pragma unroll
                for (int j = 0; j < 8; ++j) run[j] += f[j]; }
#pragma unroll
            for (int i = 0; i < 8; ++i) { const int row = rbase + i, s = s0 + row;
                unpack8(*(const uint4*)(proj_row(p, b, s) + col), f);
                float pv[8];
#pragma unroll
                for (int j = 0; j < 8; ++j) { run[j] += f[j]; pv[j] = run[j] * invw - f[j]; }
                *(LAS u32x4*)(lds + g * 16384 + (cvl >> 3) * 8192 + row * 128 + swz_slot<64>(row, cvl & 7) * 16) = (u32x4){pack2(pv[0], pv[1]), pack2(pv[2], pv[3]), pack2(pv[4], pv[5]), pack2(pv[6], pv[7])};
                unpack8(*(const uint4*)(proj_row(p, b, s - w + 1) + col), f);
#pragma unroll
                for (int j = 0; j < 8; ++j) run[j] -= f[j]; }
        }
        {
            float u2[8], u1[8], c8[8], v8[8], b8[8];
            float w0[8], w1[8], w2[8];
#pragma unroll
            for (int j = 0; j < 8; ++j) { w0[j] = p.conv_w[cch + j]; w1[j] = p.conv_w[512 + cch + j]; w2[j] = p.conv_w[1024 + cch + j]; }
            const int sb = s0 + wid * 8;
            { const bf16_t* r = proj_row(p, b, sb - 2); unpack8(*(const uint4*)(r + 512 + cch), c8); unpack8(*(const uint4*)(r + 1024 + cch), v8);
#pragma unroll
              for (int j = 0; j < 8; ++j) u2[j] = c8[j] * v8[j]; }
            { const bf16_t* r = proj_row(p, b, sb - 1); unpack8(*(const uint4*)(r + 512 + cch), c8); unpack8(*(const uint4*)(r + 1024 + cch), v8);
#pragma unroll
              for (int j = 0; j < 8; ++j) u1[j] = c8[j] * v8[j]; }
#pragma unroll
            for (int i = 0; i < 8; ++i) { const bf16_t* r = proj_row(p, b, sb + i);
                unpack8(*(const uint4*)(r + cch), b8); unpack8(*(const uint4*)(r + 512 + cch), c8); unpack8(*(const uint4*)(r + 1024 + cch), v8);
                float raw[8]; float ss = 0.f;
#pragma unroll
                for (int j = 0; j < 8; ++j) { const float u0 = c8[j] * v8[j]; raw[j] = b8[j] * (w0[j] * u2[j] + w1[j] * u1[j] + w2[j] * u0); ss += raw[j] * raw[j]; u2[j] = u1[j]; u1[j] = u0; }
                ss = wave_sum(ss); const float rs = rsqrtf(ss * (1.0f / 512) + EPS);
                *(uint4*)(y + (size_t)(R0 + wid * 8 + i) * D + cch) = make_uint4(pack2(raw[0] * rs, raw[1] * rs), pack2(raw[2] * rs, raw[3] * rs), pack2(raw[4] * rs, raw[5] * rs), pack2(raw[6] * rs, raw[7] * rs)); }
        }
        __syncthreads();
        f32x4 acc[4][4];
#pragma unroll
        for (int m = 0; m < 4; ++m)
#pragma unroll
            for (int n = 0; n < 4; ++n) acc[m][n] = (f32x4){0.f, 0.f, 0.f, 0.f};
#pragma unroll
        for (int ks = 0; ks < 4; ++ks) {
            bf16x8 af[4], bfr[4];
#pragma unroll
            for (int n = 0; n < 4; ++n) bfr[n] = *(const bf16x8*)(pw + (size_t)(g * 128 + nh * 64 + n * 16 + fr) * 128 + ks * 32 + fq * 8);
#pragma unroll
            for (int m = 0; m < 4; ++m) af[m] = *(const LAS bf16x8*)(lds + g * 16384 + (ks >> 1) * 8192 + (m * 16 + fr) * 128 + swz_slot<64>(fr, (ks & 1) * 4 + fq) * 16);
#pragma unroll
            for (int m = 0; m < 4; ++m)
#pragma unroll
                for (int n = 0; n < 4; ++n) acc[m][n] = __builtin_amdgcn_mfma_f32_16x16x32_bf16(bfr[n], af[m], acc[m][n], 0, 0, 0);
        }
#pragma unroll
        for (int m = 0; m < 4; ++m) { float ss = 0.f;
#pragma unroll
            for (int n = 0; n < 4; ++n) { acc[m][n] *= *(const f32x4*)(p.pool_scale + g * 128 + nh * 64 + n * 16 + fq * 4); ss += acc[m][n][0] * acc[m][n][0] + acc[m][n][1] * acc[m][n][1] + acc[m][n][2] * acc[m][n][2] + acc[m][n][3] * acc[m][n][3]; }
            ss += __shfl_xor(ss, 16); ss += __shfl_xor(ss, 32);
            if (fq == 0) red[(m * 16 + fr) * 8 + wid] = ss; }
        __syncthreads();
#pragma unroll
        for (int m = 0; m < 4; ++m) { float ss = 0.f;
#pragma unroll
            for (int w8 = 0; w8 < 8; ++w8) ss += red[(m * 16 + fr) * 8 + w8];
            const float rs = rsqrtf(ss * (1.0f / 512) + EPS);
#pragma unroll
            for (int n = 0; n < 4; ++n) { const f32x4 v = acc[m][n] * rs;
                *(uint2*)(y + (size_t)(R0 + m * 16 + fr) * D + 512 + g * 128 + nh * 64 + n * 16 + fq * 4) = make_uint2(pack2(v[0], v[1]), pack2(v[2], v[3])); } }
    }
}

#define XB_TMO      128
#define XB_XCNT(j)  (256  + 64 * (j))
#define XB_XSUB(j)  (1280 + 64 * (j))
#define XB_XGEN(j)  (2304 + 64 * (j))
#define XB_TOP      3328
#define XB_TOPGEN   3392
#define XCD_BAR_WORDS 3456
#define XB_SPIN_CAP (1u << 18)
__device__ __forceinline__ unsigned xb_ld(unsigned* p)              { return __hip_atomic_load(p, __ATOMIC_RELAXED, __HIP_MEMORY_SCOPE_AGENT); }
__device__ __forceinline__ unsigned xb_add(unsigned* p, unsigned v) { return __hip_atomic_fetch_add(p, v, __ATOMIC_RELAXED, __HIP_MEMORY_SCOPE_AGENT); }
__device__ __forceinline__ unsigned xb_xcc_id() { return (unsigned)__builtin_amdgcn_s_getreg((3 << 11) | 20) & 0xFu; }
#define XB_SPIN(cond, bar) do { unsigned _sp = 0; while (cond) { __builtin_amdgcn_s_sleep(1); \
    if ((++_sp & 255u) == 0u) { if (xb_ld(&(bar)[XB_TMO])) break; if (_sp > XB_SPIN_CAP) { atomicAdd(&(bar)[XB_TMO], 1u); break; } } } } while (0)
struct XcdBarrier { unsigned* bar; unsigned x; volatile __attribute__((address_space(3))) unsigned* st; };
__device__ __forceinline__ XcdBarrier xcd_barrier_post(unsigned* bar, volatile __attribute__((address_space(3))) unsigned* st) {
    XcdBarrier b; b.bar = bar; b.x = xb_xcc_id(); b.st = st;
    if (threadIdx.x == 0) (void)xb_add(&bar[XB_XCNT(b.x)], 1u);
    return b;
}
__device__ __forceinline__ void xcd_barrier_complete(unsigned* bar, unsigned x, unsigned& nloc, unsigned& nx) {
    const unsigned G = gridDim.x * gridDim.y * gridDim.z;
    unsigned sum, cnt, mine, sp = 0u;
    for (;;) {
        sum = 0u; cnt = 0u; mine = 0u;
#pragma unroll
        for (unsigned j = 0; j < 16; ++j) { const unsigned c = xb_ld(&bar[XB_XCNT(j)]); sum += c; cnt += (c > 0u) ? 1u : 0u; mine = (j == x) ? c : mine; }
        if (sum == G) break;
        __builtin_amdgcn_s_sleep(1);
        if ((++sp & 255u) == 0u) { if (xb_ld(&bar[XB_TMO])) break; if (sp > XB_SPIN_CAP) { atomicAdd(&bar[XB_TMO], 1u); break; } }
    }
    nloc = mine > 0u ? mine : 1u; nx = cnt > 0u ? cnt : 1u;
}
__device__ __forceinline__ void xcd_barrier(const XcdBarrier& b) {
    asm volatile("s_waitcnt vmcnt(0)" ::: "memory");
    __syncthreads();
    if (threadIdx.x == 0) {
        unsigned* bar = b.bar;
        __builtin_amdgcn_s_waitcnt(0);
        unsigned nloc = b.st[0], nx = b.st[1];
        if (nloc == 0u) { xcd_barrier_complete(bar, b.x, nloc, nx); b.st[0] = nloc; b.st[1] = nx; }
        const unsigned old = xb_add(&bar[XB_XSUB(b.x)], 1u);
        const unsigned gen = old / nloc;
        if (old + 1u == (gen + 1u) * nloc) {
            __builtin_amdgcn_fence(__ATOMIC_RELEASE, "agent");
            asm volatile("s_waitcnt vmcnt(0)" ::: "memory");
            const unsigned og = xb_add(&bar[XB_TOP], 1u);
            const unsigned tg = og / nx;
            if (og + 1u == (tg + 1u) * nx) xb_add(&bar[XB_TOPGEN], 1u);
            else XB_SPIN(xb_ld(&bar[XB_TOPGEN]) == tg, bar);
            __builtin_amdgcn_fence(__ATOMIC_ACQUIRE, "agent");
            xb_add(&bar[XB_XGEN(b.x)], 1u);
            asm volatile("s_waitcnt vmcnt(0)" ::: "memory");
        } else {
            XB_SPIN(xb_ld(&bar[XB_XGEN(b.x)]) == gen, bar);
            __builtin_amdgcn_fence(__ATOMIC_ACQUIRE, "agent");
            asm volatile("s_waitcnt vmcnt(0)" ::: "memory");
        }
    }
    __syncthreads();
}

__global__ void __launch_bounds__(512, 2) mega_kernel(Params p) {
    extern __shared__ __attribute__((aligned(16))) unsigned char lds_raw[];
    LAS unsigned char* lds = (LAS unsigned char*)lds_raw;
    cg::grid_group grid = cg::this_grid();
    const int bid = blockIdx.x, nb = gridDim.x;
    volatile LAS unsigned* st = (volatile LAS unsigned*)(lds + LDS_MISC + 3072);
    if (threadIdx.x == 0) { st[0] = 0u; st[1] = 0u; }
    __syncthreads();
    XcdBarrier xb = xcd_barrier_post((unsigned*)(p.ws + OFF_BAR), st);
    if (p.ws == nullptr) grid.sync();
#define SEAM() xcd_barrier(xb)
    phase0(p, lds_raw, bid, nb); SEAM();
#if PROBE_DUP == 0
    phase0(p, lds_raw, bid, nb); SEAM();
#endif
    phase1(p, lds, bid, nb); SEAM();
#if PROBE_DUP == 1
    phase1<PROBE_MODE>(p, lds, bid, nb); SEAM();
#endif
    phase2(p, lds, bid, nb); SEAM();
#if PROBE_DUP == 2
    phase2(p, lds, bid, nb); SEAM();
#endif
    phase3(p, lds, bid, nb); SEAM();
#if PROBE_DUP == 3
    phase3(p, lds, bid, nb); SEAM();
#endif
    phase4(p, lds, bid, nb); SEAM();
#if PROBE_DUP == 4
    { int* cnt = (int*)(p.ws + OFF_CNT); if (bid == 0 && threadIdx.x < 256) cnt[threadIdx.x] = 0; } SEAM();
    phase4(p, lds, bid, nb); SEAM();
#endif
    phase5a(p, lds, bid, nb); SEAM();
#if PROBE_DUP == 5
    phase5a(p, lds, bid, nb); SEAM();
#endif
#if PROBE_DUP == 6
    phase5b<PROBE_MODE>(p, lds, bid, nb, (float*)(p.ws + OFF_B + 32 * MiB)); SEAM();
#endif
    phase5b(p, lds, bid, nb, p.out);
}

extern "C" void kernel_launch(void* const* d_in, const int* in_sizes, int n_in, void* d_out, int out_size, void* d_ws, size_t ws_size, hipStream_t stream) {
    static int init = 0;
    static int grid_blocks = 0;
    if (!init) {
        if (ws_size < WS_END) { fprintf(stderr, "workspace too small: %zu < %zu\n", ws_size, (size_t)WS_END); init = -1; return; }
        (void)hipFuncSetAttribute((const void*)mega_kernel, hipFuncAttributeMaxDynamicSharedMemorySize, LDS_BYTES);
        int dev = 0, cus = 0, per_cu = 0;
        (void)hipGetDevice(&dev);
        (void)hipDeviceGetAttribute(&cus, hipDeviceAttributeMultiprocessorCount, dev);
        (void)hipOccupancyMaxActiveBlocksPerMultiprocessor(&per_cu, (const void*)mega_kernel, 512, LDS_BYTES);
        if (per_cu < 1) { fprintf(stderr, "occupancy query says %d blocks/CU\n", per_cu); per_cu = 1; }
        if (per_cu > 1) per_cu = 1;
        grid_blocks = cus * per_cu;
        init = 1;
    }
    if (init < 0) return;
    Params p{};
    const float** f = (const float**)&p;
    for (int i = 0; i < 17; ++i) f[i] = (const float*)d_in[i];
    p.out = (float*)d_out; p.ws = (unsigned char*)d_ws;
    (void)hipMemsetAsync((unsigned char*)d_ws + OFF_BAR, 0, 16384, stream);
    void* args[] = {&p};
    hipError_t e = hipLaunchCooperativeKernel((const void*)mega_kernel, dim3(grid_blocks), dim3(512), args, LDS_BYTES, stream);
    if (e != hipSuccess) fprintf(stderr, "cooperative launch failed: %s (grid %d)\n", hipGetErrorString(e), grid_blocks);
}
```

```cpp
#include <hip/hip_runtime.h>
#include <hip/hip_cooperative_groups.h>
#include <cstdio>
#include <cstdint>
namespace cg = cooperative_groups;
#define PROBE_DUP -1
#define PROBE_MODE 0

typedef unsigned short bf16_t;
typedef short bf16x8 __attribute__((ext_vector_type(8)));
typedef float f32x4 __attribute__((ext_vector_type(4)));
typedef unsigned u32x4 __attribute__((ext_vector_type(4)));
typedef long l64x2 __attribute__((ext_vector_type(2)));

constexpr int T = 32768, SEQ = 8192, D = 1024, NP = 2048, DC = 512, NE = 32, DE = 256, NBUCK = 112;
constexpr float EPS = 1e-6f;
constexpr size_t MiB = 1024 * 1024;
constexpr size_t OFF_A = 0;
constexpr size_t OFF_B = 64 * MiB;
constexpr size_t OFF_C = 192 * MiB;
constexpr size_t OFF_WIN = 256 * MiB;
constexpr size_t OFF_WOUT = 260 * MiB;
constexpr size_t OFF_WGU = 262 * MiB;
constexpr size_t OFF_WD = 294 * MiB;
constexpr size_t OFF_POOL = 310 * MiB;
constexpr size_t OFF_WR = OFF_POOL + 128 * 1024;
constexpr size_t OFF_PM = OFF_WR + 128 * 1024;
constexpr size_t OFF_RSTD1 = OFF_PM + 64 * 1024;
constexpr size_t OFF_SSQ2 = OFF_RSTD1 + 128 * 1024;
constexpr size_t OFF_RT = OFF_SSQ2 + 2 * MiB;
constexpr size_t OFF_EL = OFF_RT + 512 * 1024;
constexpr size_t OFF_PL = OFF_EL + 4 * MiB;
constexpr size_t OFF_H = 336 * MiB;
constexpr size_t OFF_BAR = OFF_H + 64 * MiB;
constexpr size_t OFF_H8 = OFF_BAR + 1 * MiB;
constexpr size_t WS_END = OFF_H8 + 32 * MiB;
constexpr size_t OFF_CNT = OFF_BAR + 14336;

struct Params {
    const float *x, *meta, *norm_mix, *w_in, *conv_w, *norm_conv_out, *pool_w, *pool_scale, *norm_pool_out, *w_out, *norm_ffn,
        *w_rg, *w_re, *w_gate, *w_up, *w_down, *final_norm;
    float* out;
    unsigned char* ws;
};

__device__ __forceinline__ float bf2f(bf16_t v) { return __uint_as_float(((unsigned)v) << 16); }
__device__ __forceinline__ bf16_t f2bf(float f) { unsigned u = __float_as_uint(f); u += 0x7fffu + ((u >> 16) & 1u); return (bf16_t)(u >> 16); }
__device__ __forceinline__ unsigned pack2(float lo, float hi) { return (unsigned)f2bf(lo) | ((unsigned)f2bf(hi) << 16); }
__device__ __forceinline__ unsigned pack4_fp8(float a, float b, float c, float d) {
    a = __builtin_amdgcn_fmed3f(a, -448.f, 448.f); b = __builtin_amdgcn_fmed3f(b, -448.f, 448.f); c = __builtin_amdgcn_fmed3f(c, -448.f, 448.f); d = __builtin_amdgcn_fmed3f(d, -448.f, 448.f);
    int w = __builtin_amdgcn_cvt_pk_fp8_f32(a, b, 0, false); w = __builtin_amdgcn_cvt_pk_fp8_f32(c, d, w, true); return (unsigned)w; }
constexpr float SC_H8 = 16.f, SC_WGU = 512.f, SC_ACT = 8.f, SC_WD = 256.f;
__device__ __forceinline__ float wave_sum(float v) {
#pragma unroll
    for (int o = 32; o > 0; o >>= 1) v += __shfl_xor(v, o);
    return v;
}
__device__ __forceinline__ int pair_off(int a) { return a * 8 - (a * (a + 1)) / 2; }

struct TrItem { const float* src; bf16_t* dst; const float* kscale; int ld_src, ld_dst, k0, n0, mapmode; float f8scale; };
__device__ __forceinline__ int tr_map(int mode, int h) { return mode == 0 ? h : ((h >> 5) << 6) + (h & 31) + (mode == 2 ? 32 : 0); }

constexpr int P0_PM = 128, P0_XR = 1024  , P0_WIN = 16 * 8, P0_WOUT = 16 * 4, P0_GATE = 32 * 16, P0_UP = P0_GATE, P0_DOWN = 32 * 4 * 4, P0_WR = 16, P0_POOL = 8;
constexpr int P0_TR0 = P0_PM + P0_XR, P0_TR = P0_WIN + P0_WOUT + P0_GATE + P0_UP + P0_DOWN, P0_ITEMS = P0_TR0 + P0_TR + P0_WR + P0_POOL;

__device__ __forceinline__ bool p0_tr_decode(const Params& p, int it, TrItem& t) {
    int i = it - P0_TR0; if (i < 0 || i >= P0_TR) return false;
    if (i < P0_WIN) { t.src = p.w_in; t.ld_src = NP; t.dst = (bf16_t*)(p.ws + OFF_WIN); t.ld_dst = D; t.k0 = (i & 15) * 64; t.n0 = (i >> 4) * 256; t.kscale = p.norm_mix; t.mapmode = 0; t.f8scale = 0.f; return true; }
    i -= P0_WIN;
    if (i < P0_WOUT) { t.src = p.w_out; t.ld_src = D; t.dst = (bf16_t*)(p.ws + OFF_WOUT); t.ld_dst = D; t.k0 = (i & 15) * 64; t.n0 = (i >> 4) * 256;
        t.kscale = (t.k0 < DC) ? p.norm_conv_out : (p.norm_pool_out - DC); t.mapmode = 0; t.f8scale = 0.f; return true; }
    i -= P0_WOUT;
    if (i < P0_GATE + P0_UP) { const int up = i >= P0_GATE; if (up) i -= P0_GATE; const int ex = i >> 4;
        t.src = (up ? p.w_up : p.w_gate) + (size_t)ex * D * DE; t.ld_src = DE; t.dst = (bf16_t*)(p.ws + OFF_WGU + (size_t)ex * 512 * D); t.ld_dst = D; t.k0 = (i & 15) * 64; t.n0 = 0;
        t.kscale = p.norm_ffn; t.mapmode = up ? 2 : 1; t.f8scale = SC_WGU; return true; }
    i -= P0_GATE + P0_UP;
    { const int ex = i >> 4; t.src = p.w_down + (size_t)ex * DE * D; t.ld_src = D; t.dst = (bf16_t*)(p.ws + OFF_WD + (size_t)ex * D * DE); t.ld_dst = DE; t.k0 = ((i >> 2) & 3) * 64; t.n0 = (i & 3) * 256;
      t.kscale = nullptr; t.mapmode = 0; t.f8scale = SC_WD; return true; }
}
__device__ __forceinline__ void p0_tr_load(const TrItem& t, float4 (&v)[8]) {
    const int tid = threadIdx.x;
#pragma unroll
    for (int i = 0; i < 8; ++i) { const int idx = tid + 512 * i, k = idx >> 6, n4 = idx & 63;
        v[i] = *(const float4*)(t.src + (size_t)(t.k0 + k) * t.ld_src + t.n0 + n4 * 4);
        if (t.kscale) { const float s = t.kscale[t.k0 + k]; v[i].x *= s; v[i].y *= s; v[i].z *= s; v[i].w *= s; } }
}

template <int MODE = 0> __device__ __forceinline__ void phase0(const Params& p, unsigned char* lds, int bid, int nb) {
    float* tile = (float*)lds;
    const int t = threadIdx.x, wid = t >> 6, lane = t & 63;
    bf16_t* xb = (bf16_t*)(p.ws + OFF_A);
    float* rstd1 = (float*)(p.ws + OFF_RSTD1);
    float4 v[8];
    TrItem cur, nxt;
    int first = bid; while (first < P0_TR0) first += nb;
    bool have = p0_tr_decode(p, first, cur);
    if (have) p0_tr_load(cur, v);
    for (int it = bid; it < P0_ITEMS; it += nb) {
        if (it < P0_PM) {
            const int col = it * 16 + (t & 15), ks = t >> 4;
            float wv[32];
#pragma unroll
            for (int j = 0; j < 32; ++j) wv[j] = p.w_in[(size_t)(ks * 32 + j) * NP + col];
            float* metan = (float*)lds;
            float* red = (float*)(lds + 65536);
            for (int rr = 0; rr < 2; ++rr) { const int r = wid * 2 + rr; const float* mr = p.meta + (size_t)r * D;
                float mv[16]; float ss = 0.f;
#pragma unroll
                for (int j = 0; j < 16; ++j) { mv[j] = mr[j * 64 + lane]; ss += mv[j] * mv[j]; }
                ss = wave_sum(ss); const float rs = rsqrtf(ss * (1.0f / D) + EPS);
#pragma unroll
                for (int j = 0; j < 16; ++j) metan[r * D + j * 64 + lane] = mv[j] * rs * p.norm_mix[j * 64 + lane]; }
            __syncthreads();
            float acc[16];
#pragma unroll
            for (int r = 0; r < 16; ++r) acc[r] = 0.f;
#pragma unroll
            for (int j = 0; j < 32; ++j) {
#pragma unroll
                for (int r = 0; r < 16; ++r) acc[r] += metan[r * D + ks * 32 + j] * wv[j]; }
#pragma unroll
            for (int r = 0; r < 16; ++r) red[(ks * 16 + r) * 16 + (t & 15)] = acc[r];
            __syncthreads();
            bf16_t* pm = (bf16_t*)(p.ws + OFF_PM);
            if (t < 256) { const int r = t >> 4, c = t & 15; float s = 0.f;
#pragma unroll
                for (int k8 = 0; k8 < 32; ++k8) s += red[(k8 * 16 + r) * 16 + c];
                pm[(size_t)r * NP + it * 16 + c] = f2bf(s); }
            __syncthreads();
        } else if (it < P0_TR0) {
            if (MODE & 1) continue;
            const int r0 = (it - P0_PM) * 32 + wid * 4;
            float4 a[4][4];
#pragma unroll
            for (int q = 0; q < 4; ++q)
#pragma unroll
                for (int j = 0; j < 2; ++j) { const float* xr = p.x + (size_t)(r0 + q) * D + j * 512 + lane * 8; a[q][2 * j] = *(const float4*)xr; a[q][2 * j + 1] = *(const float4*)(xr + 4); }
#pragma unroll
            for (int q = 0; q < 4; ++q) { float ss = 0.f;
#pragma unroll
                for (int j = 0; j < 2; ++j) { const float4 u0 = a[q][2 * j], u1 = a[q][2 * j + 1];
                    ss += u0.x * u0.x + u0.y * u0.y + u0.z * u0.z + u0.w * u0.w + u1.x * u1.x + u1.y * u1.y + u1.z * u1.z + u1.w * u1.w;
                    *(uint4*)(xb + (size_t)(r0 + q) * D + j * 512 + lane * 8) = make_uint4(pack2(u0.x, u0.y), pack2(u0.z, u0.w), pack2(u1.x, u1.y), pack2(u1.z, u1.w)); }
                ss = wave_sum(ss);
                if (lane == 0) rstd1[r0 + q] = rsqrtf(ss * (1.0f / D) + EPS); }
        } else if (it < P0_TR0 + P0_TR) {
            if (MODE & 2) continue;
            __syncthreads();
#pragma unroll
            for (int i = 0; i < 8; ++i) { const int idx = t + 512 * i, k = idx >> 6, n4 = idx & 63; float* d = tile + (n4 >> 4) * (64 * 65) + k * 65 + (n4 & 15) * 4;
                d[0] = v[i].x; d[1] = v[i].y; d[2] = v[i].z; d[3] = v[i].w; }
            const bool hn = p0_tr_decode(p, it + nb, nxt);
            if (hn) p0_tr_load(nxt, v);
            __syncthreads();
            { const int n = t >> 3, ko = t & 7;
#pragma unroll
              for (int sub = 0; sub < 4; ++sub) { const float* s = tile + sub * (64 * 65) + (ko * 8) * 65 + n;
                  const size_t o = (size_t)tr_map(cur.mapmode, cur.n0 + sub * 64 + n) * cur.ld_dst + cur.k0 + ko * 8;
                  if (cur.f8scale != 0.f) { const float f = cur.f8scale;
                      *(uint2*)((unsigned char*)cur.dst + o) = make_uint2(pack4_fp8(s[0] * f, s[65] * f, s[130] * f, s[195] * f), pack4_fp8(s[260] * f, s[325] * f, s[390] * f, s[455] * f)); }
                  else *(uint4*)(cur.dst + o) = make_uint4(pack2(s[0], s[65]), pack2(s[130], s[195]), pack2(s[260], s[325]), pack2(s[390], s[455])); } }
            cur = nxt; have = hn;
        } else if (it < P0_TR0 + P0_TR + P0_WR) {
            const int i = it - (P0_TR0 + P0_TR);
            bf16_t* wr = (bf16_t*)(p.ws + OFF_WR);
            for (int q = t; q < 4096; q += 512) { const int j = q >> 6, k = i * 64 + (q & 63);
                float val = 0.f; if (j < 4) val = p.w_rg[k * 4 + j]; else if (j < 36) val = p.w_re[k * 32 + (j - 4)];
                wr[(size_t)j * D + k] = f2bf(val * p.norm_ffn[k]); }
        } else {
            const int i = it - (P0_TR0 + P0_TR + P0_WR);
            bf16_t* pt = (bf16_t*)(p.ws + OFF_POOL);
            for (int q = t; q < 8192; q += 512) { const int o = i * 8192 + q, g = o >> 14, dd = (o >> 7) & 127, c = o & 127;
                pt[o] = f2bf(p.pool_w[(size_t)g * 16384 + c * 128 + dd]); }
        }
    }
    (void)have;
}
__device__ __forceinline__ const bf16_t* proj_row(const Params& p, int b, int s) {
    return s >= 0 ? (const bf16_t*)(p.ws + OFF_B) + ((size_t)b * SEQ + s) * NP : (const bf16_t*)(p.ws + OFF_PM) + (size_t)(16 + s) * NP;
}
#define LAS __attribute__((address_space(3)))
constexpr int LDS_STAGE = 147456, LDS_MISC = LDS_STAGE, LDS_BYTES = LDS_STAGE + 8192;

template <int WM_, int WN_, int TM_, int TN_, int BK_, int NST_>
struct GemmCfg {
    static constexpr int WM = WM_, WN = WN_, TM = TM_, TN = TN_, BK = BK_, NST = NST_;
    static constexpr int BM = WM * TM * 16, BN = WN * TN * 16;
    static constexpr int SL = BK / 8, RPC = 64 / SL;
    static constexpr int A_CH = BM / RPC, B_CH = BN / RPC, NA = (A_CH + 7) / 8, NB = (B_CH + 7) / 8;
    static constexpr int ROWB = BK * 2, A_BYTES = BM * ROWB, B_BYTES = BN * ROWB, ST_BYTES = A_BYTES + B_BYTES, KS = BK / 32;
    static constexpr bool UNIFORM = (A_CH % 8 == 0) && (B_CH % 8 == 0);
    static_assert(WM * WN == 8, "8 waves");
    static_assert(NST * ST_BYTES <= LDS_STAGE, "LDS");
    static_assert(NST == 2 || UNIFORM, "counted waits need uniform piece counts");
};
template <int BK> __device__ __forceinline__ int swz_slot(int row, int slot) {
    if (BK == 64) return slot ^ ((row >> 1) & 7);
    return slot ^ ((0 - (row >> 2)) & 3);
}
template <int TN> __device__ __forceinline__ int perm_row(int rho) {
    const int g = rho / (TN * 16), w = rho % (TN * 16), n = w >> 4, q = (w >> 2) & 3, j = w & 3;
    return g * (TN * 16) + q * (TN * 4) + n * 4 + j;
}
template <int N> __device__ __forceinline__ void wait_vm() {
    static_assert(N == 0 || N == 3 || N == 6 || N == 9 || N == 12 || N == 15, "add the count");
    if (N == 0) asm volatile("s_waitcnt vmcnt(0)" ::: "memory");
    else if (N == 3) asm volatile("s_waitcnt vmcnt(3)" ::: "memory");
    else if (N == 6) asm volatile("s_waitcnt vmcnt(6)" ::: "memory");
    else if (N == 9) asm volatile("s_waitcnt vmcnt(9)" ::: "memory");
    else if (N == 12) asm volatile("s_waitcnt vmcnt(12)" ::: "memory");
    else asm volatile("s_waitcnt vmcnt(15)" ::: "memory");
}

template <class C, class D, int MODE = 0>
__device__ __forceinline__ void gemm_stream(LAS unsigned char* lds, const D& d) {
    typedef typename D::U U;
    const int tid = threadIdx.x, wid = __builtin_amdgcn_readfirstlane(tid >> 6), lane = tid & 63, wr = wid / C::WN, wc = wid % C::WN, fr = lane & 15, fq = lane >> 4;
    const int nk = d.nk();
    U us, uc;
    int is = 0, kts = 0;
    bool more = d.get(0, us);
    unsigned offA[C::NA], offB[C::NB];
    auto set_offsets = [&](const U& u) {
#pragma unroll
        for (int i = 0; i < C::NA; ++i) { const int c = wid + 8 * i, row = c * C::RPC + lane / C::SL, sp = lane % C::SL;
            offA[i] = (c < C::A_CH) ? d.aoff(u, row) + (unsigned)swz_slot<C::BK>(row, sp) * 16u : 0u; }
#pragma unroll
        for (int i = 0; i < C::NB; ++i) { const int c = wid + 8 * i, row = c * C::RPC + lane / C::SL, sp = lane % C::SL;
            offB[i] = (c < C::B_CH) ? d.boff(u, row) + (unsigned)swz_slot<C::BK>(row, sp) * 16u : 0u; }
    };
    if (more) set_offsets(us);
    int aread[C::KS], bread[C::KS];
#pragma unroll
    for (int ks = 0; ks < C::KS; ++ks) {
        aread[ks] = (wr * C::TM * 16 + fr) * C::ROWB + swz_slot<C::BK>(fr, ks * 4 + fq) * 16;
        bread[ks] = C::A_BYTES + (wc * C::TN * 16 + fr) * C::ROWB + swz_slot<C::BK>(fr, ks * 4 + fq) * 16;
    }
    f32x4 acc[C::TM][C::TN];
    typename D::R rs;
    int issued = 0, sbuf = 0;
    auto stage_next = [&]() {
        if (!more) return;
        const char* ab = d.abase(us, kts); const char* bb = d.bbase(us, kts);
        LAS unsigned char* sa = lds + sbuf;
        if (!(MODE & 4)) {
#pragma unroll
        for (int i = 0; i < C::NA; ++i) { const int c = wid + 8 * i;
            if (c < C::A_CH) __builtin_amdgcn_global_load_lds((const unsigned*)(ab + offA[i]), (LAS unsigned*)(sa + c * 1024), 16, 0, 0); }
#pragma unroll
        for (int i = 0; i < C::NB; ++i) { const int c = wid + 8 * i;
            if (c < C::B_CH) __builtin_amdgcn_global_load_lds((const unsigned*)(bb + offB[i]), (LAS unsigned*)(sa + C::A_BYTES + c * 1024), 16, 0, 0); }
        }
        ++issued; sbuf += C::ST_BYTES; if (sbuf == C::NST * C::ST_BYTES) sbuf = 0;
        if (++kts == nk) { kts = 0; ++is; more = d.get(is, us); if (more) set_offsets(us); }
    };
    __syncthreads();
    stage_next();
    if (C::NST == 3) stage_next();
    int g = 0, cbuf = 0;
    for (int ic = 0; d.get(ic, uc); ++ic) {
        d.init(uc, acc, rs, wr, wc, fr, fq);
        for (int kt = 0; kt < nk; ++kt, ++g) {
            if (C::NST == 3 && issued > g + 1) wait_vm<C::UNIFORM ? C::NA + C::NB : 0>(); else wait_vm<0>();
            __builtin_amdgcn_s_barrier();
            asm volatile("" ::: "memory");
            stage_next();
            const LAS unsigned char* sa = lds + cbuf;
            if (!(MODE & 2)) {
#pragma unroll
            for (int ks = 0; ks < C::KS; ++ks) {
                bf16x8 af[C::TM], bfr[C::TN];
#pragma unroll
                for (int m = 0; m < C::TM; ++m) af[m] = *(const LAS bf16x8*)(sa + aread[ks] + m * 16 * C::ROWB);
#pragma unroll
                for (int n = 0; n < C::TN; ++n) bfr[n] = *(const LAS bf16x8*)(sa + bread[ks] + n * 16 * C::ROWB);
#pragma unroll
                for (int m = 0; m < C::TM; ++m)
#pragma unroll
                    for (int n = 0; n < C::TN; ++n) acc[m][n] = __builtin_amdgcn_mfma_f32_16x16x32_bf16(bfr[n], af[m], acc[m][n], 0, 0, 0);
            }
            }
            cbuf += C::ST_BYTES; if (cbuf == C::NST * C::ST_BYTES) cbuf = 0;
        }
        if (!(MODE & 1)) d.epi(uc, acc, rs, wr, wc, fr, fq);
        else { float s = 0.f;
#pragma unroll
            for (int m = 0; m < C::TM; ++m)
#pragma unroll
                for (int n = 0; n < C::TN; ++n) s += acc[m][n][0] + acc[m][n][1] + acc[m][n][2] + acc[m][n][3];
            if (s == 123.456f) *(float*)d.sink() = s; }
    }
}

template <class C, class D, int MODE = 0>
__device__ __forceinline__ void gemm_stream3(LAS unsigned char* lds, const D& d) {
    static_assert(C::KS == 2 && C::UNIFORM && C::NST == 3, "BK = 64, 3 buffers, uniform pieces");
    constexpr int P = C::NA + C::NB;
    typedef typename D::U U;
    const int tid = threadIdx.x, wid = __builtin_amdgcn_readfirstlane(tid >> 6), lane = tid & 63, wr = wid / C::WN, wc = wid % C::WN, fr = lane & 15, fq = lane >> 4;
    const int half = wid >> 2;
    const int nk = d.nk();
    U us, uc;
    int is = 0, kts = 0;
    bool more = d.get(0, us);
    if (!more) return;
    unsigned offA[C::NA], offB[C::NB];
    auto set_offsets = [&](const U& u) {
#pragma unroll
        for (int i = 0; i < C::NA; ++i) { const int c = wid + 8 * i, row = c * C::RPC + lane / C::SL, sp = lane % C::SL;
            offA[i] = d.aoff(u, row) + (unsigned)swz_slot<C::BK>(row, sp) * 16u; }
#pragma unroll
        for (int i = 0; i < C::NB; ++i) { const int c = wid + 8 * i, row = c * C::RPC + lane / C::SL, sp = lane % C::SL;
            offB[i] = d.boff(u, row) + (unsigned)swz_slot<C::BK>(row, sp) * 16u; }
    };
    set_offsets(us);
    int aread[2], bread[2];
#pragma unroll
    for (int ks = 0; ks < 2; ++ks) {
        aread[ks] = (wr * C::TM * 16 + fr) * C::ROWB + swz_slot<C::BK>(fr, ks * 4 + fq) * 16;
        bread[ks] = C::A_BYTES + (wc * C::TN * 16 + fr) * C::ROWB + swz_slot<C::BK>(fr, ks * 4 + fq) * 16;
    }
    f32x4 acc[C::TM][C::TN];
    typename D::R rs;
    int sbuf = 0;
    auto stage_next = [&]() -> bool {
        if (!more) return false;
        const char* ab = d.abase(us, kts); const char* bb = d.bbase(us, kts);
        LAS unsigned char* sa = lds + sbuf;
        if (!(MODE & 4)) {
#pragma unroll
        for (int i = 0; i < C::NA; ++i) __builtin_amdgcn_global_load_lds((const unsigned*)(ab + offA[i]), (LAS unsigned*)(sa + (wid + 8 * i) * 1024), 16, 0, 0);
#pragma unroll
        for (int i = 0; i < C::NB; ++i) __builtin_amdgcn_global_load_lds((const unsigned*)(bb + offB[i]), (LAS unsigned*)(sa + C::A_BYTES + (wid + 8 * i) * 1024), 16, 0, 0);
        }
        sbuf += C::ST_BYTES; if (sbuf == C::NST * C::ST_BYTES) sbuf = 0;
        if (++kts == nk) { kts = 0; ++is; more = d.get(is, us); if (more) set_offsets(us); }
        return true;
    };
    bf16x8 fa[C::TM], fb[C::TN];
    int cbuf = 0;
    auto read_frags = [&](int ks) {
        const LAS unsigned char* sa = lds + cbuf;
        if (!(MODE & 2)) {
#pragma unroll
        for (int m = 0; m < C::TM; ++m) fa[m] = *(const LAS bf16x8*)(sa + aread[ks] + m * 16 * C::ROWB);
#pragma unroll
        for (int n = 0; n < C::TN; ++n) fb[n] = *(const LAS bf16x8*)(sa + bread[ks] + n * 16 * C::ROWB);
        }
    };
    auto mma = [&]() {
        asm volatile("s_waitcnt lgkmcnt(0)" ::: "memory");
        if (!(MODE & 2)) {
        __builtin_amdgcn_s_setprio(1);
#pragma unroll
        for (int m = 0; m < C::TM; ++m)
#pragma unroll
            for (int n = 0; n < C::TN; ++n) {
                if (D::FP8) { const l64x2 a2 = __builtin_bit_cast(l64x2, fa[m]), b2 = __builtin_bit_cast(l64x2, fb[n]);
                    acc[m][n] = __builtin_amdgcn_mfma_f32_16x16x32_fp8_fp8(b2[0], a2[0], acc[m][n], 0, 0, 0);
                    acc[m][n] = __builtin_amdgcn_mfma_f32_16x16x32_fp8_fp8(b2[1], a2[1], acc[m][n], 0, 0, 0); }
                else acc[m][n] = __builtin_amdgcn_mfma_f32_16x16x32_bf16(fb[n], fa[m], acc[m][n], 0, 0, 0); }
        __builtin_amdgcn_s_setprio(0);
        }
    };
#define GS3_BAR() do { asm volatile("" ::: "memory"); __builtin_amdgcn_s_barrier(); asm volatile("" ::: "memory"); } while (0)
    __syncthreads();
    stage_next();
    const bool two = stage_next();
    if (two) wait_vm<P>(); else wait_vm<0>();
    GS3_BAR();
    if (half) GS3_BAR();
    for (int ic = 0; d.get(ic, uc); ++ic) {
        d.init(uc, acc, rs, wr, wc, fr, fq);
        for (int kt = 0; kt < nk; ++kt) {
            read_frags(0);
            GS3_BAR();
            mma();
            GS3_BAR();
            read_frags(1);
            if (stage_next()) wait_vm<P>(); else wait_vm<0>();
            GS3_BAR();
            mma();
            GS3_BAR();
            cbuf += C::ST_BYTES; if (cbuf == C::NST * C::ST_BYTES) cbuf = 0;
        }
        if (!(MODE & 1)) d.epi(uc, acc, rs, wr, wc, fr, fq);
        else { float s = 0.f;
#pragma unroll
            for (int m = 0; m < C::TM; ++m)
#pragma unroll
                for (int n = 0; n < C::TN; ++n) s += acc[m][n][0] + acc[m][n][1] + acc[m][n][2] + acc[m][n][3];
            if (s == 123.456f) *(float*)d.sink() = s; }
    }
    if (!half) GS3_BAR();
    asm volatile("s_waitcnt vmcnt(0) lgkmcnt(0)" ::: "memory");
#undef GS3_BAR
}

typedef GemmCfg<4, 2, 4, 4, 64, 3> CfgA;
typedef GemmCfg<8, 1, 1, 4, 64, 2> CfgR;

__device__ __forceinline__ float lo_bf(unsigned w) { return __uint_as_float(w << 16); }
__device__ __forceinline__ float hi_bf(unsigned w) { return __uint_as_float(w & 0xffff0000u); }

struct P1Desc {
    static constexpr bool FP8 = false;
    struct U { int mt, nt; };
    struct R { float rs[4]; };
    const char* xb; const char* w; bf16_t* proj; const float* rstd1; int bid, nb;
    __device__ __forceinline__ bool get(int i, U& u) const { const int uu = i * nb + bid; if (uu >= 2048) return false;
        const int g = uu >> 8, b = uu & 255, xcd = b & 7, j = b >> 3; u.mt = g * 16 + (xcd >> 1) * 4 + (j >> 3); u.nt = (xcd & 1) * 8 + (j & 7); return true; }
    __device__ __forceinline__ int nk() const { return 16; }
    __device__ __forceinline__ unsigned aoff(const U& u, int row) const { return (unsigned)(u.mt * 256 + row) * 2048u; }
    __device__ __forceinline__ unsigned boff(const U& u, int rho) const { return (unsigned)(u.nt * 128 + perm_row<4>(rho)) * 2048u; }
    __device__ __forceinline__ const char* abase(const U&, int kt) const { return xb + kt * 128; }
    __device__ __forceinline__ const char* bbase(const U&, int kt) const { return w + kt * 128; }
    __device__ __forceinline__ void* sink() const { return (void*)proj; }
    template <class Acc> __device__ __forceinline__ void init(const U& u, Acc& acc, R& r, int wr, int wc, int fr, int fq) const {
#pragma unroll
        for (int m = 0; m < 4; ++m) { r.rs[m] = rstd1[u.mt * 256 + wr * 64 + m * 16 + fr];
#pragma unroll
            for (int n = 0; n < 4; ++n) acc[m][n] = (f32x4){0.f, 0.f, 0.f, 0.f}; }
    }
    template <class Acc> __device__ __forceinline__ void epi(const U& u, Acc& acc, const R& r, int wr, int wc, int fr, int fq) const {
        const int col = u.nt * 128 + wc * 64 + fq * 16;
#pragma unroll
        for (int m = 0; m < 4; ++m) { const int row = u.mt * 256 + wr * 64 + m * 16 + fr; const float rs = r.rs[m];
            bf16_t* dst = proj + (size_t)row * NP + col;
#pragma unroll
            for (int h = 0; h < 2; ++h) { const f32x4 a = acc[m][2 * h] * rs, b = acc[m][2 * h + 1] * rs;
                *(uint4*)(dst + 8 * h) = make_uint4(pack2(a[0], a[1]), pack2(a[2], a[3]), pack2(b[0], b[1]), pack2(b[2], b[3])); } }
    }
};
template <int MODE = 0> __device__ __forceinline__ void phase1(const Params& p, LAS unsigned char* lds, int bid, int nb) {
    P1Desc d; d.xb = (const char*)(p.ws + OFF_A); d.w = (const char*)(p.ws + OFF_WIN); d.proj = (bf16_t*)(p.ws + OFF_B); d.rstd1 = (const float*)(p.ws + OFF_RSTD1); d.bid = bid; d.nb = nb;
    gemm_stream3<CfgA, P1Desc, MODE>(lds, d);
}
struct P3Desc {
    static constexpr bool FP8 = false;
    __device__ __forceinline__ void* sink() const { return (void*)hb; }
    struct U { int mt, nt; };
    struct R { int dummy; };
    const char* y; const char* w; const bf16_t* xb; bf16_t* hb; unsigned char* hb8; float* ssq2; int bid, nb;
    __device__ __forceinline__ bool get(int i, U& u) const { const int uu = i * nb + bid; if (uu >= 1024) return false;
        const int g = uu >> 8, b = uu & 255, xcd = b & 7, j = b >> 3; u.mt = g * 32 + xcd * 4 + (j >> 3); u.nt = j & 7; return true; }
    __device__ __forceinline__ int nk() const { return 16; }
    __device__ __forceinline__ unsigned aoff(const U& u, int row) const { return (unsigned)(u.mt * 256 + row) * 2048u; }
    __device__ __forceinline__ unsigned boff(const U& u, int rho) const { return (unsigned)(u.nt * 128 + perm_row<4>(rho)) * 2048u; }
    __device__ __forceinline__ const char* abase(const U&, int kt) const { return y + kt * 128; }
    __device__ __forceinline__ const char* bbase(const U&, int kt) const { return w + kt * 128; }
    template <class Acc> __device__ __forceinline__ void init(const U& u, Acc& acc, R& r, int wr, int wc, int fr, int fq) const {
        const int col = u.nt * 128 + wc * 64 + fq * 16;
#pragma unroll
        for (int m = 0; m < 4; ++m) { const size_t o = (size_t)(u.mt * 256 + wr * 64 + m * 16 + fr) * D + col;
#pragma unroll
            for (int h = 0; h < 2; ++h) { const uint4 xr = *(const uint4*)(xb + o + 8 * h);
                acc[m][2 * h] = (f32x4){lo_bf(xr.x), hi_bf(xr.x), lo_bf(xr.y), hi_bf(xr.y)}; acc[m][2 * h + 1] = (f32x4){lo_bf(xr.z), hi_bf(xr.z), lo_bf(xr.w), hi_bf(xr.w)}; } }
    }
    template <class Acc> __device__ __forceinline__ void epi(const U& u, Acc& acc, const R& r, int wr, int wc, int fr, int fq) const {
        const int col = u.nt * 128 + wc * 64 + fq * 16;
#pragma unroll
        for (int m = 0; m < 4; ++m) { const int row = u.mt * 256 + wr * 64 + m * 16 + fr; const size_t o = (size_t)row * D + col; float ss = 0.f;
            *(uint4*)(hb8 + o) = make_uint4(pack4_fp8(acc[m][0][0] * SC_H8, acc[m][0][1] * SC_H8, acc[m][0][2] * SC_H8, acc[m][0][3] * SC_H8), pack4_fp8(acc[m][1][0] * SC_H8, acc[m][1][1] * SC_H8, acc[m][1][2] * SC_H8, acc[m][1][3] * SC_H8),
                                            pack4_fp8(acc[m][2][0] * SC_H8, acc[m][2][1] * SC_H8, acc[m][2][2] * SC_H8, acc[m][2][3] * SC_H8), pack4_fp8(acc[m][3][0] * SC_H8, acc[m][3][1] * SC_H8, acc[m][3][2] * SC_H8, acc[m][3][3] * SC_H8));
#pragma unroll
            for (int h = 0; h < 2; ++h) { const f32x4 a = acc[m][2 * h], b = acc[m][2 * h + 1];
                *(uint4*)(hb + o + 8 * h) = make_uint4(pack2(a[0], a[1]), pack2(a[2], a[3]), pack2(b[0], b[1]), pack2(b[2], b[3]));
                ss += a[0] * a[0] + a[1] * a[1] + a[2] * a[2] + a[3] * a[3] + b[0] * b[0] + b[1] * b[1] + b[2] * b[2] + b[3] * b[3]; }
            ss += __shfl_xor(ss, 16); ss += __shfl_xor(ss, 32);
            if (fq == 0) ssq2[(size_t)row * 16 + u.nt * 2 + wc] = ss; }
    }
};
__device__ __forceinline__ void phase3(const Params& p, LAS unsigned char* lds, int bid, int nb) {
    P3Desc d; d.y = (const char*)(p.ws + OFF_C); d.w = (const char*)(p.ws + OFF_WOUT); d.xb = (const bf16_t*)(p.ws + OFF_A); d.hb = (bf16_t*)(p.ws + OFF_H); d.hb8 = p.ws + OFF_H8;
    d.ssq2 = (float*)(p.ws + OFF_SSQ2); d.bid = bid; d.nb = nb;
    gemm_stream3<CfgA>(lds, d);
}
struct P4Desc {
    static constexpr bool FP8 = false;
    __device__ __forceinline__ void* sink() const { return (void*)ws; }
    struct U { int u; };
    struct R { int dummy; };
    template <class Acc> __device__ __forceinline__ void init(const U&, Acc& acc, R&, int, int, int, int) const {
#pragma unroll
        for (int n = 0; n < 4; ++n) acc[0][n] = (f32x4){0.f, 0.f, 0.f, 0.f}; }
    const char* hb; const char* w; const float* ssq2; unsigned char* ws; LAS unsigned char* lds; int bid, nb;
    __device__ __forceinline__ bool get(int i, U& u) const { u.u = i * nb + bid; return u.u < 256; }
    __device__ __forceinline__ int nk() const { return 16; }
    __device__ __forceinline__ unsigned aoff(const U& u, int row) const { return (unsigned)(u.u * 128 + row) * 2048u; }
    __device__ __forceinline__ unsigned boff(const U&, int rho) const { return (unsigned)rho * 2048u; }
    __device__ __forceinline__ const char* abase(const U&, int kt) const { return hb + kt * 128; }
    __device__ __forceinline__ const char* bbase(const U&, int kt) const { return w + kt * 128; }
    template <class Acc> __device__ __forceinline__ void epi(const U& uu, Acc& acc, const R&, int wr, int wc, int fr, int fq) const {
        LAS int* hist = (LAS int*)(lds + LDS_MISC);
        LAS int* base = (LAS int*)(lds + LDS_MISC + 1024);
        LAS float* lg = (LAS float*)(lds + 65536);
        int* cnt = (int*)(ws + OFF_CNT); int* el = (int*)(ws + OFF_EL); int* pl = (int*)(ws + OFF_PL);
        __syncthreads();
#pragma unroll
        for (int n = 0; n < 4; ++n)
#pragma unroll
            for (int j = 0; j < 4; ++j) { const int col = n * 16 + fq * 4 + j; if (col < 36) lg[(wr * 16 + fr) * 37 + col] = acc[0][n][j]; }
        if (threadIdx.x < 144) hist[threadIdx.x] = 0;
        __syncthreads();
        const int t = threadIdx.x, r = uu.u * 128 + t;
        int e0 = 0, e1 = 0, bucket = 0, r0 = 0, r1 = 0, rb = 0; float ga = 0.f, gb = 0.f, rstd2 = 0.f;
        if (t < 128) { const float* q = ssq2 + (size_t)r * 16; float ss = 0.f;
#pragma unroll
            for (int j = 0; j < 16; ++j) ss += q[j];
            rstd2 = rsqrtf(ss * (1.0f / D) + EPS);
            const LAS float* mine = lg + t * 37;
            int gs = 0; float gm = mine[0];
#pragma unroll
            for (int j = 1; j < 4; ++j) { const float v = mine[j]; if (v > gm) { gm = v; gs = j; } }
            float den = 0.f;
#pragma unroll
            for (int j = 0; j < 4; ++j) den += __expf((mine[j] - gm) * rstd2);
            const float g1 = 1.0f / den;
            const LAS float* le = mine + 4 + gs * 8;
            int i0 = 0; float l0 = le[0];
#pragma unroll
            for (int j = 1; j < 8; ++j) { const float v = le[j]; if (v > l0) { l0 = v; i0 = j; } }
            int i1 = -1; float l1 = -3.0e38f;
#pragma unroll
            for (int j = 0; j < 8; ++j) { const float v = le[j]; if (j != i0 && v > l1) { l1 = v; i1 = j; } }
            const float w0 = 1.0f / (1.0f + __expf((l1 - l0) * rstd2)), w1 = 1.0f - w0;
            int a = i0, bb = i1; ga = g1 * w0; gb = g1 * w1;
            if (a > bb) { const int ti = a; a = bb; bb = ti; const float tf = ga; ga = gb; gb = tf; }
            e0 = gs * 8 + a; e1 = gs * 8 + bb; bucket = gs * 28 + pair_off(a) + (bb - a - 1);
            r0 = __hip_atomic_fetch_add(&hist[e0], 1, __ATOMIC_RELAXED, __HIP_MEMORY_SCOPE_WORKGROUP); r1 = __hip_atomic_fetch_add(&hist[e1], 1, __ATOMIC_RELAXED, __HIP_MEMORY_SCOPE_WORKGROUP);
            rb = __hip_atomic_fetch_add(&hist[32 + bucket], 1, __ATOMIC_RELAXED, __HIP_MEMORY_SCOPE_WORKGROUP); }
        __syncthreads();
        if (t < 144) { const int c = hist[t]; base[t] = c ? atomicAdd(&cnt[t], c) : 0; }
        __syncthreads();
        if (t < 128) { int4 rec; rec.x = e0 | (e1 << 8) | (bucket << 16); rec.y = __float_as_int(ga); rec.z = __float_as_int(gb); rec.w = __float_as_int(rstd2);
            ((int4*)(ws + OFF_RT))[r] = rec;
            el[(size_t)e0 * T + base[e0] + r0] = r * 2; el[(size_t)e1 * T + base[e1] + r1] = r * 2 + 1; pl[(size_t)bucket * T + base[32 + bucket] + rb] = r; }
    }
};
__device__ __forceinline__ void phase4(const Params& p, LAS unsigned char* lds, int bid, int nb) {
    P4Desc d; d.hb = (const char*)(p.ws + OFF_H); d.w = (const char*)(p.ws + OFF_WR); d.ssq2 = (const float*)(p.ws + OFF_SSQ2); d.ws = p.ws; d.lds = lds; d.bid = bid; d.nb = nb;
    gemm_stream<CfgR>(lds, d);
}
struct P5aDesc {
    static constexpr bool FP8 = true;
    __device__ __forceinline__ void* sink() const { return (void*)act; }
    struct U { int e, mtile, ntile, ce; };
    struct R { int ent[4]; float gate[4], rs[4]; };
    const char* hb8; const char* wgu; unsigned char* act; const int* cnt; const int* el; const int4* rt; LAS int* pre; int bid, nb;
    __device__ __forceinline__ bool get(int i, U& u) const { const int uu = i * nb + bid; if (uu >= pre[NE]) return false;
        int e = 0; while (pre[e + 1] <= uu) ++e;
        const int local = uu - pre[e]; u.e = e; u.mtile = local >> 2; u.ntile = local & 3; u.ce = cnt[e]; return true; }
    __device__ __forceinline__ int nk() const { return 8; }
    __device__ __forceinline__ unsigned aoff(const U& u, int row) const { const int li = min(u.mtile * 256 + row, u.ce - 1); return (unsigned)(el[(size_t)u.e * T + li] >> 1) * 1024u; }
    __device__ __forceinline__ unsigned boff(const U& u, int rho) const {
        const int w = rho & 31, n2 = w >> 4, q = (w >> 2) & 3, j = w & 3;
        return (unsigned)(u.e * 512 + u.ntile * 128 + (rho & ~31) + q * 8 + n2 * 4 + j) * 1024u; }
    __device__ __forceinline__ const char* abase(const U&, int kt) const { return hb8 + kt * 128; }
    __device__ __forceinline__ const char* bbase(const U&, int kt) const { return wgu + kt * 128; }
    template <class Acc> __device__ __forceinline__ void init(const U& u, Acc& acc, R& r, int wr, int wc, int fr, int fq) const {
        const int* list = el + (size_t)u.e * T;
#pragma unroll
        for (int m = 0; m < 4; ++m) { const int li = u.mtile * 256 + wr * 64 + m * 16 + fr; r.ent[m] = list[min(li, u.ce - 1)]; }
#pragma unroll
        for (int m = 0; m < 4; ++m) { const int4 rec = rt[r.ent[m] >> 1]; r.gate[m] = __int_as_float((r.ent[m] & 1) ? rec.z : rec.y) * SC_ACT; r.rs[m] = __int_as_float(rec.w) * (1.0f / (SC_H8 * SC_WGU));
#pragma unroll
            for (int n = 0; n < 4; ++n) acc[m][n] = (f32x4){0.f, 0.f, 0.f, 0.f}; }
    }
    template <class Acc> __device__ __forceinline__ void epi(const U& u, Acc& acc, const R& r, int wr, int wc, int fr, int fq) const {
#pragma unroll
        for (int m = 0; m < 4; ++m) { const int li = u.mtile * 256 + wr * 64 + m * 16 + fr;
            if (li < u.ce) { const int tok = r.ent[m] >> 1, slot = r.ent[m] & 1; const float gate = r.gate[m], rs = r.rs[m];
                float a[8];
#pragma unroll
                for (int n = 0; n < 2; ++n)
#pragma unroll
                    for (int j = 0; j < 4; ++j) { const float G = acc[m][n][j] * rs, Uv = acc[m][n + 2][j] * rs; a[n * 4 + j] = G / (1.0f + __expf(-G)) * Uv * gate; }
                *(uint2*)(act + (size_t)tok * 512 + slot * 256 + u.ntile * 64 + wc * 32 + fq * 8) = make_uint2(pack4_fp8(a[0], a[1], a[2], a[3]), pack4_fp8(a[4], a[5], a[6], a[7])); } }
    }
};
__device__ __forceinline__ void phase5a(const Params& p, LAS unsigned char* lds, int bid, int nb) {
    P5aDesc d; d.hb8 = (const char*)(p.ws + OFF_H8); d.wgu = (const char*)(p.ws + OFF_WGU); d.act = p.ws + OFF_B; d.cnt = (const int*)(p.ws + OFF_CNT);
    d.el = (const int*)(p.ws + OFF_EL); d.rt = (const int4*)(p.ws + OFF_RT); d.pre = (LAS int*)(lds + LDS_MISC); d.bid = bid; d.nb = nb;
    __syncthreads();
    if (threadIdx.x == 0) { int s = 0; for (int e = 0; e < NE; ++e) { d.pre[e] = s; s += ((d.cnt[e] + 255) >> 8) * 4; } d.pre[NE] = s; }
    __syncthreads();
    gemm_stream3<CfgA>(lds, d);
}
template <int MODE = 0>
__device__ __forceinline__ void phase5b(const Params& p, LAS unsigned char* lds, int bid, int nb, float* dst) {
    constexpr int A_BYTES = 64 * 128, B_BYTES = 512 * 128, ST = A_BYTES + B_BYTES;
    const char* act = (const char*)(p.ws + OFF_B); const char* wd = (const char*)(p.ws + OFF_WD);
    const int* cnt = (const int*)(p.ws + OFF_CNT) + 32; const int* pl = (const int*)(p.ws + OFF_PL); const bf16_t* hb = (const bf16_t*)(p.ws + OFF_H);
    LAS int* pre = (LAS int*)(lds + LDS_MISC); LAS float* red = (LAS float*)(lds + LDS_MISC + 1024); LAS float* fn = (LAS float*)(lds + LDS_MISC + 4096);
    const int tid = threadIdx.x, wid = __builtin_amdgcn_readfirstlane(tid >> 6), lane = tid & 63, wc = wid, fr = lane & 15, fq = lane >> 4;
    __syncthreads();
    fn[tid] = p.final_norm[tid]; fn[tid + 512] = p.final_norm[tid + 512];
    if (tid == 0) { int s = 0; for (int b = 0; b < NBUCK; ++b) { pre[b] = s; s += (cnt[b] + 63) >> 6; } pre[NBUCK] = s; }
    __syncthreads();
    const int total = pre[NBUCK];
    struct U { int b, mtile, cb, e0, e1; };
    auto get = [&](int i, U& u) -> bool { const int uu = i * nb + bid; if (uu >= total) return false;
        int b = 0; while (pre[b + 1] <= uu) ++b;
        u.b = b; u.mtile = uu - pre[b]; u.cb = cnt[b]; const int g = b / 28, pi = b % 28;
        int a = 0; while (a < 6 && pair_off(a + 1) <= pi) ++a;
        u.e0 = g * 8 + a; u.e1 = g * 8 + a + 1 + (pi - pair_off(a)); return true; };
    U us, uc; int is = 0, ts = 0;
    bool more = get(0, us);
    if (!more) return;
    unsigned offA, offB[8];
    {
#pragma unroll
        for (int i = 0; i < 8; ++i) { const int rho = (wid + 8 * i) * 8 + (lane >> 3); offB[i] = (unsigned)perm_row<4>(rho) * 256u + (unsigned)swz_slot<64>(rho, lane & 7) * 16u; }
    }
    auto set_a = [&](const U& u) { const int row = wid * 8 + (lane >> 3), li = min(u.mtile * 64 + row, u.cb - 1);
        offA = (unsigned)pl[(size_t)u.b * T + li] * 512u + (unsigned)swz_slot<64>(row, lane & 7) * 16u; };
    set_a(us);
    int sbuf = 0;
    auto stage_next = [&]() {
        if (!more) return;
        const int nh = ts >> 2, kt = ts & 3;
        const char* ab = act + kt * 128;
        const char* bb = wd + (size_t)(kt < 2 ? us.e0 : us.e1) * (D * DE) + (kt & 1) * 128 + (size_t)nh * (512 * 256);
        LAS unsigned char* sa = lds + sbuf;
        if (!(MODE & 4)) {
        __builtin_amdgcn_global_load_lds((const unsigned*)(ab + offA), (LAS unsigned*)(sa + wid * 1024), 16, 0, 0);
#pragma unroll
        for (int i = 0; i < 8; ++i) __builtin_amdgcn_global_load_lds((const unsigned*)(bb + offB[i]), (LAS unsigned*)(sa + A_BYTES + (wid + 8 * i) * 1024), 16, 0, 0);
        }
        sbuf ^= ST;
        if (++ts == 8) { ts = 0; ++is; more = get(is, us); if (more) set_a(us); }
    };
    int aread[2], bread[2];
#pragma unroll
    for (int ks = 0; ks < 2; ++ks) { aread[ks] = fr * 128 + swz_slot<64>(fr, ks * 4 + fq) * 16; bread[ks] = A_BYTES + (wc * 64 + fr) * 128 + swz_slot<64>(fr, ks * 4 + fq) * 16; }
    f32x4 acc[2][4][4];
    int tok[4];
    __syncthreads();
    stage_next();
    int cbuf = 0;
    for (int ic = 0; get(ic, uc); ++ic) {
        {
            const int* list = pl + (size_t)uc.b * T;
#pragma unroll
            for (int m = 0; m < 4; ++m) tok[m] = list[min(uc.mtile * 64 + m * 16 + fr, uc.cb - 1)];
#pragma unroll
            for (int nh = 0; nh < 2; ++nh)
#pragma unroll
                for (int m = 0; m < 4; ++m) { const bf16_t* hr = hb + (size_t)tok[m] * D + nh * 512 + wc * 64 + fq * 16;
#pragma unroll
                    for (int h = 0; h < 2; ++h) { const uint4 xr = *(const uint4*)(hr + 8 * h);
                        acc[nh][m][2 * h] = (f32x4){lo_bf(xr.x), hi_bf(xr.x), lo_bf(xr.y), hi_bf(xr.y)} * (SC_ACT * SC_WD); acc[nh][m][2 * h + 1] = (f32x4){lo_bf(xr.z), hi_bf(xr.z), lo_bf(xr.w), hi_bf(xr.w)} * (SC_ACT * SC_WD); } }
        }
#pragma unroll
        for (int t = 0; t < 8; ++t) {
            constexpr int dummy = 0; (void)dummy;
            const int nh = t >> 2;
            asm volatile("s_waitcnt vmcnt(0)" ::: "memory");
            __builtin_amdgcn_s_barrier();
            asm volatile("" ::: "memory");
            stage_next();
            if (!(MODE & 2)) {
            const LAS unsigned char* sa = lds + cbuf;
#pragma unroll
            for (int ks = 0; ks < 2; ++ks) {
                bf16x8 af[4], bfr[4];
#pragma unroll
                for (int m = 0; m < 4; ++m) af[m] = *(const LAS bf16x8*)(sa + aread[ks] + m * 16 * 128);
#pragma unroll
                for (int n = 0; n < 4; ++n) bfr[n] = *(const LAS bf16x8*)(sa + bread[ks] + n * 16 * 128);
#pragma unroll
                for (int m = 0; m < 4; ++m)
#pragma unroll
                    for (int n = 0; n < 4; ++n) { const l64x2 a2 = __builtin_bit_cast(l64x2, af[m]), b2 = __builtin_bit_cast(l64x2, bfr[n]);
                        acc[nh][m][n] = __builtin_amdgcn_mfma_f32_16x16x32_fp8_fp8(b2[0], a2[0], acc[nh][m][n], 0, 0, 0);
                        acc[nh][m][n] = __builtin_amdgcn_mfma_f32_16x16x32_fp8_fp8(b2[1], a2[1], acc[nh][m][n], 0, 0, 0); }
            }
            }
            cbuf ^= ST;
        }
        if (!(MODE & 1)) {
            constexpr float inv = 1.0f / (SC_ACT * SC_WD);
#pragma unroll
            for (int m = 0; m < 4; ++m) { float ss = 0.f;
#pragma unroll
                for (int nh = 0; nh < 2; ++nh)
#pragma unroll
                    for (int n = 0; n < 4; ++n) { acc[nh][m][n] *= inv; ss += acc[nh][m][n][0] * acc[nh][m][n][0] + acc[nh][m][n][1] * acc[nh][m][n][1] + acc[nh][m][n][2] * acc[nh][m][n][2] + acc[nh][m][n][3] * acc[nh][m][n][3]; }
                ss += __shfl_xor(ss, 16); ss += __shfl_xor(ss, 32);
                if (fq == 0) red[(m * 16 + fr) * 8 + wc] = ss; }
            __syncthreads();
#pragma unroll
            for (int m = 0; m < 4; ++m) { float ss = 0.f;
#pragma unroll
                for (int w8 = 0; w8 < 8; ++w8) ss += red[(m * 16 + fr) * 8 + w8];
                const float rs = rsqrtf(ss * (1.0f / D) + EPS);
                if (uc.mtile * 64 + m * 16 + fr < uc.cb) {
#pragma unroll
                    for (int nh = 0; nh < 2; ++nh) { const int col = nh * 512 + wc * 64 + fq * 16; float* o = dst + (size_t)tok[m] * D + col;
#pragma unroll
                        for (int n = 0; n < 4; ++n) { const f32x4 gf = *(const LAS f32x4*)(fn + col + n * 4);
                            *(float4*)(o + n * 4) = make_float4(acc[nh][m][n][0] * rs * gf[0], acc[nh][m][n][1] * rs * gf[1], acc[nh][m][n][2] * rs * gf[2], acc[nh][m][n][3] * rs * gf[3]); } } } }
            __syncthreads();
        } else { float s = 0.f;
#pragma unroll
            for (int nh = 0; nh < 2; ++nh)
#pragma unroll
                for (int m = 0; m < 4; ++m)
#pragma unroll
                    for (int n = 0; n < 4; ++n) s += acc[nh][m][n][0] + acc[nh][m][n][1] + acc[nh][m][n][2] + acc[nh][m][n][3];
            if (s == 123.456f) *dst = s; }
    }
    asm volatile("s_waitcnt vmcnt(0)" ::: "memory");
}
__device__ __forceinline__ void unpack8(const uint4 v, float* f) {
    f[0] = __uint_as_float(v.x << 16); f[1] = __uint_as_float(v.x & 0xffff0000u); f[2] = __uint_as_float(v.y << 16); f[3] = __uint_as_float(v.y & 0xffff0000u);
    f[4] = __uint_as_float(v.z << 16); f[5] = __uint_as_float(v.z & 0xffff0000u); f[6] = __uint_as_float(v.w << 16); f[7] = __uint_as_float(v.w & 0xffff0000u);
}
__device__ __forceinline__ void phase2(const Params& p, LAS unsigned char* lds, int bid, int nb) {
    const int tid = threadIdx.x, wid = __builtin_amdgcn_readfirstlane(tid >> 6), lane = tid & 63, fr = lane & 15, fq = lane >> 4;
    bf16_t* y = (bf16_t*)(p.ws + OFF_C);
    LAS float* red = (LAS float*)(lds + LDS_MISC + 1024);
    const int cch = lane * 8;
    const int g = wid >> 1, nh = wid & 1;
    const bf16_t* pw = (const bf16_t*)(p.ws + OFF_POOL);
    for (int unit = bid; unit < T / 64; unit += nb) {
        const int R0 = unit * 64, b = R0 >> 13, s0 = R0 & 8191;
        __syncthreads();
        {
            const int cvl = lane & 15, rq = lane >> 4, rbase = (wid & 1) * 32 + rq * 8, col = 1536 + g * 128 + cvl * 8, w = 2 << g;
            const float invw = 1.0f / (float)w;
            float run[8], f[8];
#pragma unroll
            for (int j = 0; j < 8; ++j) run[j] = 0.f;
            for (int q = 1; q < w; ++q) { unpack8(*(const uint4*)(proj_row(p, b, s0 + rbase - q) + col), f);
#pragma unroll
                for (int j = 0; j < 8; ++j) run[j] += f[j]; }
#pragma unroll
            for (int i = 0; i < 8; ++i) { const int row = rbase + i, s = s0 + row;
                unpack8(*(const uint4*)(proj_row(p, b, s) + col), f);
                float pv[8];
#pragma unroll
                for (int j = 0; j < 8; ++j) { run[j] += f[j]; pv[j] = run[j] * invw - f[j]; }
                *(LAS u32x4*)(lds + g * 16384 + (cvl >> 3) * 8192 + row * 128 + swz_slot<64>(row, cvl & 7) * 16) = (u32x4){pack2(pv[0], pv[1]), pack2(pv[2], pv[3]), pack2(pv[4], pv[5]), pack2(pv[6], pv[7])};
                unpack8(*(const uint4*)(proj_row(p, b, s - w + 1) + col), f);
#pragma unroll
                for (int j = 0; j < 8; ++j) run[j] -= f[j]; }
        }
        {
            float u2[8], u1[8], c8[8], v8[8], b8[8];
            float w0[8], w1[8], w2[8];
#pragma unroll
            for (int j = 0; j < 8; ++j) { w0[j] = p.conv_w[cch + j]; w1[j] = p.conv_w[512 + cch + j]; w2[j] = p.conv_w[1024 + cch + j]; }
            const int sb = s0 + wid * 8;
            { const bf16_t* r = proj_row(p, b, sb - 2); unpack8(*(const uint4*)(r + 512 + cch), c8); unpack8(*(const uint4*)(r + 1024 + cch), v8);
#pragma unroll
              for (int j = 0; j < 8; ++j) u2[j] = c8[j] * v8[j]; }
            { const bf16_t* r = proj_row(p, b, sb - 1); unpack8(*(const uint4*)(r + 512 + cch), c8); unpack8(*(const uint4*)(r + 1024 + cch), v8);
#pragma unroll
              for (int j = 0; j < 8; ++j) u1[j] = c8[j] * v8[j]; }
#pragma unroll
            for (int i = 0; i < 8; ++i) { const bf16_t* r = proj_row(p, b, sb + i);
                unpack8(*(const uint4*)(r + cch), b8); unpack8(*(const uint4*)(r + 512 + cch), c8); unpack8(*(const uint4*)(r + 1024 + cch), v8);
                float raw[8]; float ss = 0.f;
#pragma unroll
                for (int j = 0; j < 8; ++j) { const float u0 = c8[j] * v8[j]; raw[j] = b8[j] * (w0[j] * u2[j] + w1[j] * u1[j] + w2[j] * u0); ss += raw[j] * raw[j]; u2[j] = u1[j]; u1[j] = u0; }
                ss = wave_sum(ss); const float rs = rsqrtf(ss * (1.0f / 512) + EPS);
                *(uint4*)(y + (size_t)(R0 + wid * 8 + i) * D + cch) = make_uint4(pack2(raw[0] * rs, raw[1] * rs), pack2(raw[2] * rs, raw[3] * rs), pack2(raw[4] * rs, raw[5] * rs), pack2(raw[6] * rs, raw[7] * rs)); }
        }
        __syncthreads();
        f32x4 acc[4][4];
#pragma unroll
        for (int m = 0; m < 4; ++m)
#pragma unroll
            for (int n = 0; n < 4; ++n) acc[m][n] = (f32x4){0.f, 0.f, 0.f, 0.f};
#pragma unroll
        for (int ks = 0; ks < 4; ++ks) {
            bf16x8 af[4], bfr[4];
#pragma unroll
            for (int n = 0; n < 4; ++n) bfr[n] = *(const bf16x8*)(pw + (size_t)(g * 128 + nh * 64 + n * 16 + fr) * 128 + ks * 32 + fq * 8);
#pragma unroll
            for (int m = 0; m < 4; ++m) af[m] = *(const LAS bf16x8*)(lds + g * 16384 + (ks >> 1) * 8192 + (m * 16 + fr) * 128 + swz_slot<64>(fr, (ks & 1) * 4 + fq) * 16);
#pragma unroll
            for (int m = 0; m < 4; ++m)
#pragma unroll
                for (int n = 0; n < 4; ++n) acc[m][n] = __builtin_amdgcn_mfma_f32_16x16x32_bf16(bfr[n], af[m], acc[m][n], 0, 0, 0);
        }
#pragma unroll
        for (int m = 0; m < 4; ++m) { float ss = 0.f;
#pragma unroll
            for (int n = 0; n < 4; ++n) { acc[m][n] *= *(const f32x4*)(p.pool_scale + g * 128 + nh * 64 + n * 16 + fq * 4); ss += acc[m][n][0] * acc[m][n][0] + acc[m][n][1] * acc[m][n][1] + acc[m][n][2] * acc[m][n][2] + acc[m][n][3] * acc[m][n][3]; }
            ss += __shfl_xor(ss, 16); ss += __shfl_xor(ss, 32);
            if (fq == 0) red[(m * 16 + fr) * 8 + wid] = ss; }
        __syncthreads();
#pragma unroll
        for (int m = 0; m < 4; ++m) { float ss = 0.f;
#pragma unroll
            for (int w8 = 0; w8 < 8; ++w8) ss += red[(m * 16 + fr) * 8 + w8];
            const float rs = rsqrtf(ss * (1.0f / 512) + EPS);
#pragma unroll
            for (int n = 0; n < 4; ++n) { const f32x4 v = acc[m][n] * rs;
                *(uint2*)(y + (size_t)(R0 + m * 16 + fr) * D + 512 + g * 128 + nh * 64 + n * 16 + fq * 4) = make_uint2(pack2(v[0], v[1]), pack2(v[2], v[3])); } }
    }
}

#define XB_TMO      128
#define XB_XCNT(j)  (256  + 64 * (j))
#define XB_XSUB(j)  (1280 + 64 * (j))
#define XB_XGEN(j)  (2304 + 64 * (j))
#define XB_TOP      3328
#define XB_TOPGEN   3392
#define XCD_BAR_WORDS 3456
#define XB_SPIN_CAP (1u << 18)
__device__ __forceinline__ unsigned xb_ld(unsigned* p)              { return __hip_atomic_load(p, __ATOMIC_RELAXED, __HIP_MEMORY_SCOPE_AGENT); }
__device__ __forceinline__ unsigned xb_add(unsigned* p, unsigned v) { return __hip_atomic_fetch_add(p, v, __ATOMIC_RELAXED, __HIP_MEMORY_SCOPE_AGENT); }
__device__ __forceinline__ unsigned xb_xcc_id() { return (unsigned)__builtin_amdgcn_s_getreg((3 << 11) | 20) & 0xFu; }
#define XB_SPIN(cond, bar) do { unsigned _sp = 0; while (cond) { __builtin_amdgcn_s_sleep(1); \
    if ((++_sp & 255u) == 0u) { if (xb_ld(&(bar)[XB_TMO])) break; if (_sp > XB_SPIN_CAP) { atomicAdd(&(bar)[XB_TMO], 1u); break; } } } } while (0)
struct XcdBarrier { unsigned* bar; unsigned x; volatile __attribute__((address_space(3))) unsigned* st; };
__device__ __forceinline__ XcdBarrier xcd_barrier_post(unsigned* bar, volatile __attribute__((address_space(3))) unsigned* st) {
    XcdBarrier b; b.bar = bar; b.x = xb_xcc_id(); b.st = st;
    if (threadIdx.x == 0) (void)xb_add(&bar[XB_XCNT(b.x)], 1u);
    return b;
}
__device__ __forceinline__ void xcd_barrier_complete(unsigned* bar, unsigned x, unsigned& nloc, unsigned& nx) {
    const unsigned G = gridDim.x * gridDim.y * gridDim.z;
    unsigned sum, cnt, mine, sp = 0u;
    for (;;) {
        sum = 0u; cnt = 0u; mine = 0u;
#pragma unroll
        for (unsigned j = 0; j < 16; ++j) { const unsigned c = xb_ld(&bar[XB_XCNT(j)]); sum += c; cnt += (c > 0u) ? 1u : 0u; mine = (j == x) ? c : mine; }
        if (sum == G) break;
        __builtin_amdgcn_s_sleep(1);
        if ((++sp & 255u) == 0u) { if (xb_ld(&bar[XB_TMO])) break; if (sp > XB_SPIN_CAP) { atomicAdd(&bar[XB_TMO], 1u); break; } }
    }
    nloc = mine > 0u ? mine : 1u; nx = cnt > 0u ? cnt : 1u;
}
__device__ __forceinline__ void xcd_barrier(const XcdBarrier& b) {
    asm volatile("s_waitcnt vmcnt(0)" ::: "memory");
    __syncthreads();
    if (threadIdx.x == 0) {
        unsigned* bar = b.bar;
        __builtin_amdgcn_s_waitcnt(0);
        unsigned nloc = b.st[0], nx = b.st[1];
        if (nloc == 0u) { xcd_barrier_complete(bar, b.x, nloc, nx); b.st[0] = nloc; b.st[1] = nx; }
        const unsigned old = xb_add(&bar[XB_XSUB(b.x)], 1u);
        const unsigned gen = old / nloc;
        if (old + 1u == (gen + 1u) * nloc) {
            __builtin_amdgcn_fence(__ATOMIC_RELEASE, "agent");
            asm volatile("s_waitcnt vmcnt(0)" ::: "memory");
            const unsigned og = xb_add(&bar[XB_TOP], 1u);
            const unsigned tg = og / nx;
            if (og + 1u == (tg + 1u) * nx) xb_add(&bar[XB_TOPGEN], 1u);
            else XB_SPIN(xb_ld(&bar[XB_TOPGEN]) == tg, bar);
            __builtin_amdgcn_fence(__ATOMIC_ACQUIRE, "agent");
            xb_add(&bar[XB_XGEN(b.x)], 1u);
            asm volatile("s_waitcnt vmcnt(0)" ::: "memory");
        } else {
            XB_SPIN(xb_ld(&bar[XB_XGEN(b.x)]) == gen, bar);
            __builtin_amdgcn_fence(__ATOMIC_ACQUIRE, "agent");
            asm volatile("s_waitcnt vmcnt(0)" ::: "memory");
        }
    }
    __syncthreads();
}

__global__ void __launch_bounds__(512, 2) mega_kernel(Params p) {
    extern __shared__ __attribute__((aligned(16))) unsigned char lds_raw[];
    LAS unsigned char* lds = (LAS unsigned char*)lds_raw;
    cg::grid_group grid = cg::this_grid();
    const int bid = blockIdx.x, nb = gridDim.x;
    volatile LAS unsigned* st = (volatile LAS unsigned*)(lds + LDS_MISC + 3072);
    if (threadIdx.x == 0) { st[0] = 0u; st[1] = 0u; }
    __syncthreads();
    XcdBarrier xb = xcd_barrier_post((unsigned*)(p.ws + OFF_BAR), st);
    if (p.ws == nullptr) grid.sync();
#define SEAM() xcd_barrier(xb)
    phase0(p, lds_raw, bid, nb); SEAM();
#if PROBE_DUP == 0
    phase0<PROBE_MODE>(p, lds_raw, bid, nb); SEAM();
#endif
    phase1(p, lds, bid, nb); SEAM();
#if PROBE_DUP == 1
    phase1<PROBE_MODE>(p, lds, bid, nb); SEAM();
#endif
    phase2(p, lds, bid, nb); SEAM();
#if PROBE_DUP == 2
    phase2(p, lds, bid, nb); SEAM();
#endif
    phase3(p, lds, bid, nb); SEAM();
#if PROBE_DUP == 3
    phase3(p, lds, bid, nb); SEAM();
#endif
    phase4(p, lds, bid, nb); SEAM();
#if PROBE_DUP == 4
    { int* cnt = (int*)(p.ws + OFF_CNT); if (bid == 0 && threadIdx.x < 256) cnt[threadIdx.x] = 0; } SEAM();
    phase4(p, lds, bid, nb); SEAM();
#endif
    phase5a(p, lds, bid, nb); SEAM();
#if PROBE_DUP == 5
    phase5a(p, lds, bid, nb); SEAM();
#endif
#if PROBE_DUP == 6
    phase5b<PROBE_MODE>(p, lds, bid, nb, (float*)(p.ws + OFF_B + 32 * MiB)); SEAM();
#endif
    phase5b(p, lds, bid, nb, p.out);
}

extern "C" void kernel_launch(void* const* d_in, const int* in_sizes, int n_in, void* d_out, int out_size, void* d_ws, size_t ws_size, hipStream_t stream) {
    static int init = 0;
    static int grid_blocks = 0;
    if (!init) {
        if (ws_size < WS_END) { fprintf(stderr, "workspace too small: %zu < %zu\n", ws_size, (size_t)WS_END); init = -1; return; }
        (void)hipFuncSetAttribute((const void*)mega_kernel, hipFuncAttributeMaxDynamicSharedMemorySize, LDS_BYTES);
        int dev = 0, cus = 0, per_cu = 0;
        (void)hipGetDevice(&dev);
        (void)hipDeviceGetAttribute(&cus, hipDeviceAttributeMultiprocessorCount, dev);
        (void)hipOccupancyMaxActiveBlocksPerMultiprocessor(&per_cu, (const void*)mega_kernel, 512, LDS_BYTES);
        if (per_cu < 1) { fprintf(stderr, "occupancy query says %d blocks/CU\n", per_cu); per_cu = 1; }
        if (per_cu > 1) per_cu = 1;
        grid_blocks = cus * per_cu;
        init = 1;
    }
    if (init < 0) return;
    Params p{};
    const float** f = (const float**)&p;
    for (int i = 0; i < 17; ++i) f[i] = (const float*)d_in[i];
    p.out = (float*)d_out; p.ws = (unsigned char*)d_ws;
    (void)hipMemsetAsync((unsigned char*)d_ws + OFF_BAR, 0, 16384, stream);
    void* args[] = {&p};
    hipError_t e = hipLaunchCooperativeKernel((const void*)mega_kernel, dim3(grid_blocks), dim3(512), args, LDS_BYTES, stream);
    if (e != hipSuccess) fprintf(stderr, "cooperative launch failed: %s (grid %d)\n", hipGetErrorString(e), grid_blocks);
}
```

```cpp
#include <hip/hip_runtime.h>
#include <hip/hip_cooperative_groups.h>
#include <cstdio>
#include <cstdint>
#include <type_traits>
namespace cg = cooperative_groups;
#define PROBE_DUP -1
#define PROBE_MODE 0

typedef unsigned short bf16_t;
typedef short bf16x8 __attribute__((ext_vector_type(8)));
typedef float f32x4 __attribute__((ext_vector_type(4)));
typedef unsigned u32x4 __attribute__((ext_vector_type(4)));
typedef long l64x2 __attribute__((ext_vector_type(2)));
typedef int i32x8 __attribute__((ext_vector_type(8)));
typedef int i32x4 __attribute__((ext_vector_type(4)));
__device__ __forceinline__ i32x8 cat8(bf16x8 lo, bf16x8 hi) { const i32x4 a = __builtin_bit_cast(i32x4, lo), b = __builtin_bit_cast(i32x4, hi); return (i32x8){a[0], a[1], a[2], a[3], b[0], b[1], b[2], b[3]}; }
#define MFMA_F8_K128(A, B, C) __builtin_amdgcn_mfma_scale_f32_16x16x128_f8f6f4((A), (B), (C), 0, 0, 0, 0x7f7f7f7f, 0, 0x7f7f7f7f)

constexpr int T = 32768, SEQ = 8192, D = 1024, NG = 2048  , NP = 1536  , DC = 512, NE = 32, DE = 256, NBUCK = 112;
constexpr float EPS = 1e-6f;
constexpr size_t MiB = 1024 * 1024;
constexpr size_t OFF_A = 0;
constexpr size_t OFF_B = 64 * MiB;
constexpr size_t OFF_C = 192 * MiB;
constexpr size_t OFF_WIN = 256 * MiB;
constexpr size_t OFF_WOUT = 260 * MiB;
constexpr size_t OFF_WGU = 262 * MiB;
constexpr size_t OFF_WD = 294 * MiB;
constexpr size_t OFF_POOL = 310 * MiB;
constexpr size_t OFF_WR = OFF_POOL + 128 * 1024;
constexpr size_t OFF_PM = OFF_WR + 128 * 1024;
constexpr size_t OFF_RSTD1 = OFF_PM + 64 * 1024;
constexpr size_t OFF_SSQ2 = OFF_RSTD1 + 128 * 1024;
constexpr size_t OFF_RT = OFF_SSQ2 + 2 * MiB;
constexpr size_t OFF_EL = OFF_RT + 512 * 1024;
constexpr size_t OFF_PL = OFF_EL + 4 * MiB;
constexpr size_t OFF_ERS = 332 * MiB;
constexpr size_t OFF_H = 336 * MiB;
constexpr size_t OFF_BAR = OFF_H + 64 * MiB;
constexpr size_t OFF_H8 = OFF_BAR + 1 * MiB;
constexpr size_t WS_END = OFF_H8 + 32 * MiB;
constexpr size_t OFF_CNT = OFF_BAR + 14336;

struct Params {
    const float *x, *meta, *norm_mix, *w_in, *conv_w, *norm_conv_out, *pool_w, *pool_scale, *norm_pool_out, *w_out, *norm_ffn,
        *w_rg, *w_re, *w_gate, *w_up, *w_down, *final_norm;
    float* out;
    unsigned char* ws;
};

__device__ __forceinline__ float bf2f(bf16_t v) { return __uint_as_float(((unsigned)v) << 16); }
__device__ __forceinline__ bf16_t f2bf(float f) { unsigned u = __float_as_uint(f); u += 0x7fffu + ((u >> 16) & 1u); return (bf16_t)(u >> 16); }
__device__ __forceinline__ unsigned pack2(float lo, float hi) { return (unsigned)f2bf(lo) | ((unsigned)f2bf(hi) << 16); }
__device__ __forceinline__ unsigned pack4_fp8(float a, float b, float c, float d) {
    a = __builtin_amdgcn_fmed3f(a, -448.f, 448.f); b = __builtin_amdgcn_fmed3f(b, -448.f, 448.f); c = __builtin_amdgcn_fmed3f(c, -448.f, 448.f); d = __builtin_amdgcn_fmed3f(d, -448.f, 448.f);
    int w = __builtin_amdgcn_cvt_pk_fp8_f32(a, b, 0, false); w = __builtin_amdgcn_cvt_pk_fp8_f32(c, d, w, true); return (unsigned)w; }
constexpr float SC_H8 = 16.f, SC_WGU = 512.f, SC_ACT = 8.f, SC_WD = 256.f;
__device__ __forceinline__ float wave_sum(float v) {
#pragma unroll
    for (int o = 32; o > 0; o >>= 1) v += __shfl_xor(v, o);
    return v;
}
__device__ __forceinline__ int pair_off(int a) { return a * 8 - (a * (a + 1)) / 2; }

struct TrItem { const float* src; bf16_t* dst; const float* kscale; int ld_src, ld_dst, k0, n0, mapmode; float f8scale; };
__device__ __forceinline__ int tr_map(int mode, int h) {
    if (mode == 0) return h;
    if (mode == 3) { if (h < 512 || h >= 1536) return h; const int isv = h >= 1024, ch = (h - 512) & 511;
        return 512 + (ch >> 7) * 256 + ((ch >> 6) & 1) * 128 + ((ch >> 4) & 3) * 32 + ((ch >> 2) & 3) * 8 + 4 * isv + (ch & 3); }
    return ((h >> 5) << 6) + (h & 31) + (mode == 2 ? 32 : 0); }

constexpr int P0_PM = 128, P0_XR = 1024  , P0_WIN = 16 * 8, P0_WOUT = 16 * 4, P0_GATE = 32 * 16, P0_UP = P0_GATE, P0_DOWN = 32 * 4 * 4, P0_WR = 16, P0_POOL = 8;
constexpr int P0_TR0 = P0_PM + P0_XR, P0_TR = P0_WIN + P0_WOUT + P0_GATE + P0_UP + P0_DOWN, P0_ITEMS = P0_TR0 + P0_TR + P0_WR + P0_POOL;

__device__ __forceinline__ bool p0_tr_decode(const Params& p, int it, TrItem& t) {
    int i = it - P0_TR0; if (i < 0 || i >= P0_TR) return false;
    if (i < P0_WIN) { t.src = p.w_in; t.ld_src = NG; t.dst = (bf16_t*)(p.ws + OFF_WIN); t.ld_dst = D; t.k0 = (i & 15) * 64; t.n0 = (i >> 4) * 256; t.kscale = p.norm_mix; t.mapmode = 3; t.f8scale = 0.f; return true; }
    i -= P0_WIN;
    if (i < P0_WOUT) { t.src = p.w_out; t.ld_src = D; t.dst = (bf16_t*)(p.ws + OFF_WOUT); t.ld_dst = D; t.k0 = (i & 15) * 64; t.n0 = (i >> 4) * 256;
        t.kscale = (t.k0 < DC) ? p.norm_conv_out : (p.norm_pool_out - DC); t.mapmode = 0; t.f8scale = 0.f; return true; }
    i -= P0_WOUT;
    if (i < P0_GATE + P0_UP) { const int up = i >= P0_GATE; if (up) i -= P0_GATE; const int ex = i >> 4;
        t.src = (up ? p.w_up : p.w_gate) + (size_t)ex * D * DE; t.ld_src = DE; t.dst = (bf16_t*)(p.ws + OFF_WGU + (size_t)ex * 512 * D); t.ld_dst = D; t.k0 = (i & 15) * 64; t.n0 = 0;
        t.kscale = p.norm_ffn; t.mapmode = up ? 2 : 1; t.f8scale = SC_WGU; return true; }
    i -= P0_GATE + P0_UP;
    { const int ex = i >> 4; t.src = p.w_down + (size_t)ex * DE * D; t.ld_src = D; t.dst = (bf16_t*)(p.ws + OFF_WD + (size_t)ex * D * DE); t.ld_dst = DE; t.k0 = ((i >> 2) & 3) * 64; t.n0 = (i & 3) * 256;
      t.kscale = nullptr; t.mapmode = 0; t.f8scale = SC_WD; return true; }
}
__device__ __forceinline__ void p0_tr_load(const TrItem& t, float4 (&v)[8]) {
    const int tid = threadIdx.x;
#pragma unroll
    for (int i = 0; i < 8; ++i) { const int idx = tid + 512 * i, k = idx >> 6, n4 = idx & 63;
        v[i] = *(const float4*)(t.src + (size_t)(t.k0 + k) * t.ld_src + t.n0 + n4 * 4);
        if (t.kscale) { const float s = t.kscale[t.k0 + k]; v[i].x *= s; v[i].y *= s; v[i].z *= s; v[i].w *= s; } }
}

template <int MODE = 0> __device__ __forceinline__ void phase0(const Params& p, unsigned char* lds, int bid, int nb) {
    float* tile = (float*)lds;
    const int t = threadIdx.x, wid = t >> 6, lane = t & 63;
    bf16_t* xb = (bf16_t*)(p.ws + OFF_A);
    float* rstd1 = (float*)(p.ws + OFF_RSTD1);
    float4 v[8];
    TrItem cur, nxt;
    int first = bid; while (first < P0_TR0) first += nb;
    bool have = p0_tr_decode(p, first, cur);
    if (have) p0_tr_load(cur, v);
    for (int it = bid; it < P0_ITEMS; it += nb) {
        if (it < P0_PM) {
            const int c16 = t & 15, col = (c16 >> 2) * 512 + it * 4 + (c16 & 3), ks = t >> 4;
            float wv[32];
#pragma unroll
            for (int j = 0; j < 32; ++j) wv[j] = p.w_in[(size_t)(ks * 32 + j) * NG + col];
            float* metan = (float*)lds;
            float* red = (float*)(lds + 65536);
            for (int rr = 0; rr < 2; ++rr) { const int r = wid * 2 + rr; const float* mr = p.meta + (size_t)r * D;
                float mv[16]; float ss = 0.f;
#pragma unroll
                for (int j = 0; j < 16; ++j) { mv[j] = mr[j * 64 + lane]; ss += mv[j] * mv[j]; }
                ss = wave_sum(ss); const float rs = rsqrtf(ss * (1.0f / D) + EPS);
#pragma unroll
                for (int j = 0; j < 16; ++j) metan[r * D + j * 64 + lane] = mv[j] * rs * p.norm_mix[j * 64 + lane]; }
            __syncthreads();
            float acc[16];
#pragma unroll
            for (int r = 0; r < 16; ++r) acc[r] = 0.f;
#pragma unroll
            for (int j = 0; j < 32; ++j) {
#pragma unroll
                for (int r = 0; r < 16; ++r) acc[r] += metan[r * D + ks * 32 + j] * wv[j]; }
#pragma unroll
            for (int r = 0; r < 16; ++r) red[(ks * 16 + r) * 16 + c16] = acc[r];
            __syncthreads();
            if (t < 256) { const int r = t >> 4, c = t & 15; float s = 0.f;
#pragma unroll
                for (int k8 = 0; k8 < 32; ++k8) s += red[(k8 * 16 + r) * 16 + c];
                metan[r * 16 + c] = s; }
            __syncthreads();
            bf16_t* pm = (bf16_t*)(p.ws + OFF_PM);
            if (t < 192) { const int r = t / 12, o = t % 12, q = o & 3; const float* vr = metan + r * 16;
                const float val = o < 4 ? vr[q] : (o < 8 ? vr[4 + q] * vr[8 + q] : vr[12 + q]);
                pm[(size_t)r * NP + (o >> 2) * 512 + it * 4 + q] = f2bf(val); }
            __syncthreads();
        } else if (it < P0_TR0) {
            if (MODE & 1) continue;
            const int r0 = (it - P0_PM) * 32 + wid * 4;
            float4 a[4][4];
#pragma unroll
            for (int q = 0; q < 4; ++q)
#pragma unroll
                for (int j = 0; j < 4; ++j) a[q][j] = *(const float4*)(p.x + (size_t)(r0 + q) * D + j * 256 + lane * 4);
#pragma unroll
            for (int q = 0; q < 4; ++q) { float ss = 0.f;
#pragma unroll
                for (int j = 0; j < 4; ++j) { const float4 u0 = a[q][j];
                    ss += u0.x * u0.x + u0.y * u0.y + u0.z * u0.z + u0.w * u0.w;
                    *(uint2*)(xb + (size_t)(r0 + q) * D + j * 256 + lane * 4) = make_uint2(pack2(u0.x, u0.y), pack2(u0.z, u0.w)); }
                ss = wave_sum(ss);
                if (lane == 0) rstd1[r0 + q] = rsqrtf(ss * (1.0f / D) + EPS); }
        } else if (it < P0_TR0 + P0_TR) {
            if (MODE & 2) continue;
            __syncthreads();
#pragma unroll
            for (int i = 0; i < 8; ++i) { const int idx = t + 512 * i, k = idx >> 6, n4 = idx & 63; float* d = tile + (n4 >> 4) * (64 * 65) + k * 65 + (n4 & 15) * 4;
                d[0] = v[i].x; d[1] = v[i].y; d[2] = v[i].z; d[3] = v[i].w; }
            const bool hn = p0_tr_decode(p, it + nb, nxt);
            if (hn) p0_tr_load(nxt, v);
            __syncthreads();
            { const int n = t >> 3, ko = t & 7;
#pragma unroll
              for (int sub = 0; sub < 4; ++sub) { const float* s = tile + sub * (64 * 65) + (ko * 8) * 65 + n;
                  const size_t o = (size_t)tr_map(cur.mapmode, cur.n0 + sub * 64 + n) * cur.ld_dst + cur.k0 + ko * 8;
                  if (cur.f8scale != 0.f) { const float f = cur.f8scale;
                      *(uint2*)((unsigned char*)cur.dst + o) = make_uint2(pack4_fp8(s[0] * f, s[65] * f, s[130] * f, s[195] * f), pack4_fp8(s[260] * f, s[325] * f, s[390] * f, s[455] * f)); }
                  else *(uint4*)(cur.dst + o) = make_uint4(pack2(s[0], s[65]), pack2(s[130], s[195]), pack2(s[260], s[325]), pack2(s[390], s[455])); } }
            cur = nxt; have = hn;
        } else if (it < P0_TR0 + P0_TR + P0_WR) {
            const int i = it - (P0_TR0 + P0_TR);
            bf16_t* wr = (bf16_t*)(p.ws + OFF_WR);
            for (int q = t; q < 4096; q += 512) { const int j = q >> 6, k = i * 64 + (q & 63);
                float val = 0.f; if (j < 4) val = p.w_rg[k * 4 + j]; else if (j < 36) val = p.w_re[k * 32 + (j - 4)];
                wr[(size_t)j * D + k] = f2bf(val * p.norm_ffn[k]); }
        } else {
            const int i = it - (P0_TR0 + P0_TR + P0_WR);
            bf16_t* pt = (bf16_t*)(p.ws + OFF_POOL);
            for (int q = t; q < 8192; q += 512) { const int o = i * 8192 + q, g = o >> 14, dd = (o >> 7) & 127, c = o & 127;
                pt[o] = f2bf(p.pool_w[(size_t)g * 16384 + c * 128 + dd]); }
        }
    }
    (void)have;
}
__device__ __forceinline__ const bf16_t* proj_row(const Params& p, int b, int s) {
    return s >= 0 ? (const bf16_t*)(p.ws + OFF_B) + ((size_t)b * SEQ + s) * NP : (const bf16_t*)(p.ws + OFF_PM) + (size_t)(16 + s) * NP;
}
#define LAS __attribute__((address_space(3)))
constexpr int LDS_STAGE = 147456, LDS_MISC = LDS_STAGE, LDS_BYTES = LDS_STAGE + 8192;

template <int WM_, int WN_, int TM_, int TN_, int BK_, int NST_>
struct GemmCfg {
    static constexpr int WM = WM_, WN = WN_, TM = TM_, TN = TN_, BK = BK_, NST = NST_;
    static constexpr int BM = WM * TM * 16, BN = WN * TN * 16;
    static constexpr int SL = BK / 8, RPC = 64 / SL;
    static constexpr int A_CH = BM / RPC, B_CH = BN / RPC, NA = (A_CH + 7) / 8, NB = (B_CH + 7) / 8;
    static constexpr int ROWB = BK * 2, A_BYTES = BM * ROWB, B_BYTES = BN * ROWB, ST_BYTES = A_BYTES + B_BYTES, KS = BK / 32;
    static constexpr bool UNIFORM = (A_CH % 8 == 0) && (B_CH % 8 == 0);
    static_assert(WM * WN == 8, "8 waves");
    static_assert(NST * ST_BYTES <= LDS_STAGE, "LDS");
    static_assert(NST == 2 || UNIFORM, "counted waits need uniform piece counts");
};
template <int BK> __device__ __forceinline__ int swz_slot(int row, int slot) {
    if (BK == 64) return slot ^ ((row >> 1) & 7);
    return slot ^ ((0 - (row >> 2)) & 3);
}
template <int TN> __device__ __forceinline__ int perm_row(int rho) {
    const int g = rho / (TN * 16), w = rho % (TN * 16), n = w >> 4, q = (w >> 2) & 3, j = w & 3;
    return g * (TN * 16) + q * (TN * 4) + n * 4 + j;
}
template <int N> __device__ __forceinline__ void wait_vm() {
    static_assert(N == 0 || N == 3 || N == 4 || N == 6 || N == 9 || N == 12 || N == 15, "add the count");
    if (N == 0) asm volatile("s_waitcnt vmcnt(0)" ::: "memory");
    else if (N == 4) asm volatile("s_waitcnt vmcnt(4)" ::: "memory");
    else if (N == 3) asm volatile("s_waitcnt vmcnt(3)" ::: "memory");
    else if (N == 6) asm volatile("s_waitcnt vmcnt(6)" ::: "memory");
    else if (N == 9) asm volatile("s_waitcnt vmcnt(9)" ::: "memory");
    else if (N == 12) asm volatile("s_waitcnt vmcnt(12)" ::: "memory");
    else asm volatile("s_waitcnt vmcnt(15)" ::: "memory");
}

template <class C, class D, int MODE = 0>
__device__ __forceinline__ void gemm_stream(LAS unsigned char* lds, const D& d) {
    typedef typename D::U U;
    const int tid = threadIdx.x, wid = __builtin_amdgcn_readfirstlane(tid >> 6), lane = tid & 63, wr = wid / C::WN, wc = wid % C::WN, fr = lane & 15, fq = lane >> 4;
    const int nk = d.nk();
    U us, uc;
    int is = 0, kts = 0;
    bool more = d.get(0, us);
    unsigned offA[C::NA], offB[C::NB];
    auto set_offsets = [&](const U& u) {
#pragma unroll
        for (int i = 0; i < C::NA; ++i) { const int c = wid + 8 * i, row = c * C::RPC + lane / C::SL, sp = lane % C::SL;
            offA[i] = (c < C::A_CH) ? d.aoff(u, row) + (unsigned)swz_slot<C::BK>(row, sp) * 16u : 0u; }
#pragma unroll
        for (int i = 0; i < C::NB; ++i) { const int c = wid + 8 * i, row = c * C::RPC + lane / C::SL, sp = lane % C::SL;
            offB[i] = (c < C::B_CH) ? d.boff(u, row) + (unsigned)swz_slot<C::BK>(row, sp) * 16u : 0u; }
    };
    if (more) set_offsets(us);
    int aread[C::KS], bread[C::KS];
#pragma unroll
    for (int ks = 0; ks < C::KS; ++ks) {
        aread[ks] = (wr * C::TM * 16 + fr) * C::ROWB + swz_slot<C::BK>(fr, ks * 4 + fq) * 16;
        bread[ks] = C::A_BYTES + (wc * C::TN * 16 + fr) * C::ROWB + swz_slot<C::BK>(fr, ks * 4 + fq) * 16;
    }
    f32x4 acc[C::TM][C::TN];
    typename D::R rs;
    int issued = 0, sbuf = 0;
    auto stage_next = [&]() {
        if (!more) return;
        const char* ab = d.abase(us, kts); const char* bb = d.bbase(us, kts);
        LAS unsigned char* sa = lds + sbuf;
        if (!(MODE & 4)) {
#pragma unroll
        for (int i = 0; i < C::NA; ++i) { const int c = wid + 8 * i;
            if (c < C::A_CH) __builtin_amdgcn_global_load_lds((const unsigned*)(ab + offA[i]), (LAS unsigned*)(sa + c * 1024), 16, 0, 0); }
#pragma unroll
        for (int i = 0; i < C::NB; ++i) { const int c = wid + 8 * i;
            if (c < C::B_CH) __builtin_amdgcn_global_load_lds((const unsigned*)(bb + offB[i]), (LAS unsigned*)(sa + C::A_BYTES + c * 1024), 16, 0, 0); }
        }
        ++issued; sbuf += C::ST_BYTES; if (sbuf == C::NST * C::ST_BYTES) sbuf = 0;
        if (++kts == nk) { kts = 0; ++is; more = d.get(is, us); if (more) set_offsets(us); }
    };
    __syncthreads();
    stage_next();
    if (C::NST == 3) stage_next();
    int g = 0, cbuf = 0;
    for (int ic = 0; d.get(ic, uc); ++ic) {
        d.init(uc, acc, rs, wr, wc, fr, fq);
        for (int kt = 0; kt < nk; ++kt, ++g) {
            if (C::NST == 3 && issued > g + 1) wait_vm<C::UNIFORM ? C::NA + C::NB : 0>(); else wait_vm<0>();
            __builtin_amdgcn_s_barrier();
            asm volatile("" ::: "memory");
            stage_next();
            const LAS unsigned char* sa = lds + cbuf;
            if (!(MODE & 2)) {
#pragma unroll
            for (int ks = 0; ks < C::KS; ++ks) {
                bf16x8 af[C::TM], bfr[C::TN];
#pragma unroll
                for (int m = 0; m < C::TM; ++m) af[m] = *(const LAS bf16x8*)(sa + aread[ks] + m * 16 * C::ROWB);
#pragma unroll
                for (int n = 0; n < C::TN; ++n) bfr[n] = *(const LAS bf16x8*)(sa + bread[ks] + n * 16 * C::ROWB);
#pragma unroll
                for (int m = 0; m < C::TM; ++m)
#pragma unroll
                    for (int n = 0; n < C::TN; ++n) acc[m][n] = __builtin_amdgcn_mfma_f32_16x16x32_bf16(bfr[n], af[m], acc[m][n], 0, 0, 0);
            }
            }
            cbuf += C::ST_BYTES; if (cbuf == C::NST * C::ST_BYTES) cbuf = 0;
        }
        if (!(MODE & 1)) d.epi(uc, acc, rs, wr, wc, fr, fq);
        else { float s = 0.f;
#pragma unroll
            for (int m = 0; m < C::TM; ++m)
#pragma unroll
                for (int n = 0; n < C::TN; ++n) s += acc[m][n][0] + acc[m][n][1] + acc[m][n][2] + acc[m][n][3];
            if (s == 123.456f) *(float*)d.sink() = s; }
    }
}

template <class C, class D, int MODE = 0>
__device__ __forceinline__ void gemm_stream3(LAS unsigned char* lds, const D& d) {
    static_assert(C::KS == 2 && C::UNIFORM && C::NST == 3, "BK = 64, 3 buffers, uniform pieces");
    constexpr int P = C::NA + C::NB;
    typedef typename D::U U;
    const int tid = threadIdx.x, wid = __builtin_amdgcn_readfirstlane(tid >> 6), lane = tid & 63, wr = wid / C::WN, wc = wid % C::WN, fr = lane & 15, fq = lane >> 4;
    const int half = wid >> 2;
    const int nk = d.nk();
    U us, uc;
    int is = 0, kts = 0;
    bool more = d.get(0, us);
    if (!more) return;
    unsigned offA[C::NA], offB[C::NB];
    auto set_offsets = [&](const U& u) {
#pragma unroll
        for (int i = 0; i < C::NA; ++i) { const int c = wid + 8 * i, row = c * C::RPC + lane / C::SL, sp = lane % C::SL;
            offA[i] = d.aoff(u, row) + (unsigned)swz_slot<C::BK>(row, sp) * 16u; }
#pragma unroll
        for (int i = 0; i < C::NB; ++i) { const int c = wid + 8 * i, row = c * C::RPC + lane / C::SL, sp = lane % C::SL;
            offB[i] = d.boff(u, row) + (unsigned)swz_slot<C::BK>(row, sp) * 16u; }
    };
    set_offsets(us);
    int aread[2], bread[2];
#pragma unroll
    for (int ks = 0; ks < 2; ++ks) {
        aread[ks] = (wr * C::TM * 16 + fr) * C::ROWB + swz_slot<C::BK>(fr, ks * 4 + fq) * 16;
        bread[ks] = C::A_BYTES + (wc * C::TN * 16 + fr) * C::ROWB + swz_slot<C::BK>(fr, ks * 4 + fq) * 16;
    }
    f32x4 acc[C::TM][C::TN];
    typename D::R rs;
    int sbuf = 0;
    auto stage_next = [&]() -> bool {
        if (!more) return false;
        const char* ab = d.abase(us, kts); const char* bb = d.bbase(us, kts);
        LAS unsigned char* sa = lds + sbuf;
        if (!(MODE & 4)) {
#pragma unroll
        for (int i = 0; i < C::NA; ++i) __builtin_amdgcn_global_load_lds((const unsigned*)(ab + offA[i]), (LAS unsigned*)(sa + (wid + 8 * i) * 1024), 16, 0, 0);
#pragma unroll
        for (int i = 0; i < C::NB; ++i) __builtin_amdgcn_global_load_lds((const unsigned*)(bb + offB[i]), (LAS unsigned*)(sa + C::A_BYTES + (wid + 8 * i) * 1024), 16, 0, 0);
        }
        sbuf += C::ST_BYTES; if (sbuf == C::NST * C::ST_BYTES) sbuf = 0;
        if (++kts == nk) { kts = 0; ++is; more = d.get(is, us); if (more) set_offsets(us); }
        return true;
    };
    bf16x8 fa[C::TM], fb[C::TN], fa1[D::FP8 ? C::TM : 1], fb1[D::FP8 ? C::TN : 1];
    int cbuf = 0;
    auto read_frags = [&](int ks) {
        const LAS unsigned char* sa = lds + cbuf;
        if (!(MODE & 2)) {
        if (D::FP8) {
            if (ks == 0) {
#pragma unroll
                for (int m = 0; m < C::TM; ++m) { fa[m] = *(const LAS bf16x8*)(sa + aread[0] + m * 16 * C::ROWB); fa1[m] = *(const LAS bf16x8*)(sa + aread[1] + m * 16 * C::ROWB); }
#pragma unroll
                for (int n = 0; n < C::TN; ++n) { fb[n] = *(const LAS bf16x8*)(sa + bread[0] + n * 16 * C::ROWB); fb1[n] = *(const LAS bf16x8*)(sa + bread[1] + n * 16 * C::ROWB); }
            }
        } else {
#pragma unroll
        for (int m = 0; m < C::TM; ++m) fa[m] = *(const LAS bf16x8*)(sa + aread[ks] + m * 16 * C::ROWB);
#pragma unroll
        for (int n = 0; n < C::TN; ++n) fb[n] = *(const LAS bf16x8*)(sa + bread[ks] + n * 16 * C::ROWB);
        }
        }
    };
    auto mma = [&](auto ksc) {
        constexpr int ks = decltype(ksc)::value;
        asm volatile("s_waitcnt lgkmcnt(0)" ::: "memory");
        if (!(MODE & 2)) {
        __builtin_amdgcn_s_setprio(1);
        if (D::FP8) {
#pragma unroll
            for (int mm = 0; mm < C::TM / 2; ++mm) { const int m = ks * (C::TM / 2) + mm;
#pragma unroll
                for (int n = 0; n < C::TN; ++n) acc[m][n] = MFMA_F8_K128(cat8(fb[n], fb1[n]), cat8(fa[m], fa1[m]), acc[m][n]); }
        } else {
#pragma unroll
        for (int m = 0; m < C::TM; ++m)
#pragma unroll
            for (int n = 0; n < C::TN; ++n) acc[m][n] = __builtin_amdgcn_mfma_f32_16x16x32_bf16(fb[n], fa[m], acc[m][n], 0, 0, 0);
        }
        __builtin_amdgcn_s_setprio(0);
        }
    };
#define GS3_BAR() do { asm volatile("" ::: "memory"); __builtin_amdgcn_s_barrier(); asm volatile("" ::: "memory"); } while (0)
    __syncthreads();
    stage_next();
    const bool two = stage_next();
    if (two) wait_vm<P>(); else wait_vm<0>();
    GS3_BAR();
    if (half) GS3_BAR();
    for (int ic = 0; d.get(ic, uc); ++ic) {
        d.init(uc, acc, rs, wr, wc, fr, fq);
#pragma nounroll
        for (int kt = 0; kt < nk; ++kt) {
            bool staged = false;
            if (D::FP8) staged = stage_next();
            read_frags(0);
            GS3_BAR();
            mma(std::integral_constant<int, 0>{});
            GS3_BAR();
            read_frags(1);
            if (!D::FP8) staged = stage_next();
            if (staged) wait_vm<P>(); else wait_vm<0>();
            GS3_BAR();
            mma(std::integral_constant<int, 1>{});
            GS3_BAR();
            cbuf += C::ST_BYTES; if (cbuf == C::NST * C::ST_BYTES) cbuf = 0;
        }
        if (!(MODE & 1)) d.epi(uc, acc, rs, wr, wc, fr, fq);
        else { float s = 0.f;
#pragma unroll
            for (int m = 0; m < C::TM; ++m)
#pragma unroll
                for (int n = 0; n < C::TN; ++n) s += acc[m][n][0] + acc[m][n][1] + acc[m][n][2] + acc[m][n][3];
            if (s == 123.456f) *(float*)d.sink() = s; }
    }
    if (!half) GS3_BAR();
    asm volatile("s_waitcnt vmcnt(0) lgkmcnt(0)" ::: "memory");
#undef GS3_BAR
}

typedef GemmCfg<4, 2, 4, 4, 64, 3> CfgA;
typedef GemmCfg<8, 1, 1, 4, 64, 2> CfgR;

__device__ __forceinline__ float lo_bf(unsigned w) { return __uint_as_float(w << 16); }
__device__ __forceinline__ float hi_bf(unsigned w) { return __uint_as_float(w & 0xffff0000u); }

namespace pg8 {
#define PG8_LAS __attribute__((address_space(3)))
typedef unsigned short bf16_t;
typedef short bf16x8 __attribute__((ext_vector_type(8)));
typedef float f32x4 __attribute__((ext_vector_type(4)));
typedef unsigned u32x4 __attribute__((ext_vector_type(4)));
constexpr int BM = 256, BK = 64, HALF = 128, HTB = HALF * BK * 2  , STAGE_BYTES = 8 * HTB, NXCD = 8, WGM = 8;

__host__ __device__ __forceinline__ int lds_byte(int r, int c) { const int st = (r >> 4) * 2 + (c >> 5), rr = r & 15, cc = c & 31, ob = rr * 64 + cc * 2; return st * 1024 + (ob ^ (((ob >> 9) & 1) << 5)); }
__host__ __device__ __forceinline__ void stage_rc(int b, int& R, int& C) { const int st = b / 1024, sb = b % 1024, swz = sb ^ (((sb >> 9) & 1) << 5); R = (st >> 1) * 16 + swz / 64; C = (st & 1) * 32 + (swz % 64) / 2; }
__host__ __device__ __forceinline__ int perm32(int rho) { const int n = rho >> 4, i = rho & 15; return 8 * (i >> 2) + 4 * n + (i & 3); }

struct Unit { int pm, pn; };
struct Gemm { const bf16_t* A; const bf16_t* Bt; int M, N, K; };

struct StaticOrder {
    int nM, nN, nwg, G, c;
    __host__ __device__ void init(int M, int N, int G_, int c_) { nM = M / BM; nN = N / BM; nwg = nM * nN; G = G_; c = c_; }
    __host__ __device__ bool next(int i, Unit& u) const {
        const long L = (long)i * G + c; if (L >= nwg) return false;
        int wgid = (int)L; { const int q = nwg / NXCD, r = nwg % NXCD, xcd = wgid % NXCD, off = wgid / NXCD; wgid = (xcd < r ? xcd * (q + 1) : r * (q + 1) + (xcd - r) * q) + off; }
        const int nig = WGM * nN, gid = wgid / nig, fm = gid * WGM, gsz = (nM - fm) < WGM ? (nM - fm) : WGM;
        u.pm = fm + ((wgid % nig) % gsz); u.pn = (wgid % nig) / gsz; return true;
    }
    __device__ __forceinline__ void a_ready(const Unit&) const {}
    __device__ __forceinline__ void done(const Unit&) const {}
};
__device__ __forceinline__ unsigned cvt_pk_bf16(float lo, float hi) { unsigned r; asm volatile("v_cvt_pk_bf16_f32 %0, %1, %2" : "=v"(r) : "v"(lo), "v"(hi)); return r; }

struct EpiProj {
    static constexpr bool PERM = true, AFTER_DRAIN = false;
    unsigned short* proj; const float* rstd;
    __device__ __forceinline__ void operator()(const f32x4 (&acc)[2][2][4][2], const Unit& u, int wr, int wc, int fr, int fq) const {
        const int row0 = u.pm * BM + wr * 64 + fr;
        if (u.pn >= 2 && u.pn < 6) {
            const int col0 = 512 + (u.pn - 2) * 128 + wc * 16 + 4 * fq;
#pragma unroll
            for (int ai = 0; ai < 2; ++ai)
#pragma unroll
                for (int m = 0; m < 4; ++m) { const int row = row0 + ai * HALF + m * 16; const float rs = rstd[row], rs2 = rs * rs; unsigned short* rowp = proj + (size_t)row * 1536 + col0;
#pragma unroll
                    for (int bj = 0; bj < 2; ++bj) { const f32x4 uu = acc[ai][bj][m][0] * acc[ai][bj][m][1] * rs2;
                        *(uint2*)(rowp + bj * 64) = make_uint2(cvt_pk_bf16(uu[0], uu[1]), cvt_pk_bf16(uu[2], uu[3])); } }
        } else {
            const int col0 = (u.pn < 2 ? u.pn * BM : 1024 + (u.pn - 6) * BM) + wc * 32 + 8 * fq;
#pragma unroll
            for (int ai = 0; ai < 2; ++ai)
#pragma unroll
                for (int m = 0; m < 4; ++m) { const int row = row0 + ai * HALF + m * 16; const float rs = rstd[row]; unsigned short* rowp = proj + (size_t)row * 1536 + col0;
#pragma unroll
                    for (int bj = 0; bj < 2; ++bj) { const f32x4 v0 = acc[ai][bj][m][0] * rs, v1 = acc[ai][bj][m][1] * rs;
                        u32x4 w; w.x = cvt_pk_bf16(v0[0], v0[1]); w.y = cvt_pk_bf16(v0[2], v0[3]); w.z = cvt_pk_bf16(v1[0], v1[1]); w.w = cvt_pk_bf16(v1[2], v1[3]);
                        *(u32x4*)(rowp + bj * HALF) = w; } }
        }
    }
};
struct EpiOut {
    static constexpr bool PERM = true, AFTER_DRAIN = false;
    const unsigned short* xb; unsigned short* hb; unsigned char* hb8; float* ssq2;
    __device__ __forceinline__ void operator()(const f32x4 (&acc)[2][2][4][2], const Unit& u, int wr, int wc, int fr, int fq) const {
        const int row0 = u.pm * BM + wr * 64 + fr, col0 = u.pn * BM + wc * 32 + 8 * fq;
#pragma unroll
        for (int ai = 0; ai < 2; ++ai) {
            u32x4 xr[4][2];
#pragma unroll
            for (int m = 0; m < 4; ++m)
#pragma unroll
                for (int bj = 0; bj < 2; ++bj) xr[m][bj] = *(const u32x4*)(xb + (size_t)(row0 + ai * HALF + m * 16) * 1024 + col0 + bj * HALF);
#pragma unroll
            for (int m = 0; m < 4; ++m) { const int row = row0 + ai * HALF + m * 16; const size_t o = (size_t)row * 1024 + col0; float ss = 0.f;
#pragma unroll
                for (int bj = 0; bj < 2; ++bj) { f32x4 a = acc[ai][bj][m][0], b = acc[ai][bj][m][1]; const u32x4 x = xr[m][bj];
                    a[0] += lo_bf(x.x); a[1] += hi_bf(x.x); a[2] += lo_bf(x.y); a[3] += hi_bf(x.y);
                    b[0] += lo_bf(x.z); b[1] += hi_bf(x.z); b[2] += lo_bf(x.w); b[3] += hi_bf(x.w);
                    u32x4 w; w.x = cvt_pk_bf16(a[0], a[1]); w.y = cvt_pk_bf16(a[2], a[3]); w.z = cvt_pk_bf16(b[0], b[1]); w.w = cvt_pk_bf16(b[2], b[3]);
                    *(u32x4*)(hb + o + bj * HALF) = w;
                    *(uint2*)(hb8 + o + bj * HALF) = make_uint2(pack4_fp8(a[0] * SC_H8, a[1] * SC_H8, a[2] * SC_H8, a[3] * SC_H8), pack4_fp8(b[0] * SC_H8, b[1] * SC_H8, b[2] * SC_H8, b[3] * SC_H8));
                    ss += a[0] * a[0] + a[1] * a[1] + a[2] * a[2] + a[3] * a[3] + b[0] * b[0] + b[1] * b[1] + b[2] * b[2] + b[3] * b[3]; }
                ss += __shfl_xor(ss, 16); ss += __shfl_xor(ss, 32);
                if (fq == 0) ssq2[(size_t)row * 16 + u.pn * 4 + wc] = ss; }
        }
    }
};
template <class Epi, class Sched, bool STAMP = false>
__device__ __forceinline__ void gemm_phase(PG8_LAS unsigned char* lds, const Gemm g, const Sched& S, const Epi& E, unsigned long long* stamps) {
    const int tid = threadIdx.x, wid = __builtin_amdgcn_readfirstlane(tid >> 6), lane = tid & 63, wr = wid >> 2, wc = wid & 3, fr = lane & 15, fq = lane >> 4;
    const int K = g.K, nt = K / BK;
    int ts_lo = 0, ts_hi = 0, nts = 0; const unsigned long long rt_entry = STAMP ? (unsigned long long)wall_clock64() : 0ull;
#define PG8_STAMP() do { if (STAMP && wid == 0 && nts < 64) { const unsigned long long _c = (unsigned long long)clock64(); \
        ts_lo = (lane == nts) ? (int)(unsigned)_c : ts_lo; ts_hi = (lane == nts) ? (int)(unsigned)(_c >> 32) : ts_hi; ++nts; } } while (0)
    PG8_STAMP();
    unsigned voffA[2], voffB[2];
#pragma unroll
    for (int i = 0; i < 2; ++i) { int R, C; stage_rc(tid * 16 + i * 8192, R, C); const int Rb = Epi::PERM ? ((R & ~31) + perm32(R & 31)) : R;
        voffA[i] = (unsigned)(R * K + C) * 2u; voffB[i] = (unsigned)(Rb * K + C) * 2u; }
    const size_t kstep = (size_t)(BK * 2);
    const size_t hstep = (size_t)HALF * K * 2;
    const size_t tstep = 2 * hstep;
    const unsigned ldsw = (unsigned)wid * 1024u;
    const int aoff = lds_byte(wr * 64 + fr, fq * 8), boff = lds_byte(wc * 32 + fr, fq * 8);
#define PG8_SA(b, h) (((b) * 2 + (h)) * HTB)
#define PG8_SB(b, h) ((4 + (b) * 2 + (h)) * HTB)
#define PG8_STAGE(bufoff, gbase, voff) do { _Pragma("unroll") for (int _i = 0; _i < 2; ++_i) \
        __builtin_amdgcn_global_load_lds((const unsigned*)((const char*)(gbase) + (voff)[_i]), (PG8_LAS unsigned*)(lds + (bufoff) + ldsw + _i * 8192), 16, 0, 0); } while (0)
#define PG8_LDA(dst, b, h) do { _Pragma("unroll") for (int m = 0; m < 4; ++m) _Pragma("unroll") for (int k = 0; k < 2; ++k) dst[m][k] = *(const PG8_LAS bf16x8*)(lds + PG8_SA(b, h) + aoff + m * 2048 + k * 1024); } while (0)
#define PG8_LDB(dst, b, h) do { _Pragma("unroll") for (int n = 0; n < 2; ++n) _Pragma("unroll") for (int k = 0; k < 2; ++k) dst[n][k] = *(const PG8_LAS bf16x8*)(lds + PG8_SB(b, h) + boff + n * 2048 + k * 1024); } while (0)
#define PG8_MMA(ai, bj, At, Bt) do { __builtin_amdgcn_s_setprio(1); _Pragma("unroll") for (int m = 0; m < 4; ++m) _Pragma("unroll") for (int n = 0; n < 2; ++n) _Pragma("unroll") for (int k = 0; k < 2; ++k) \
        acc[ai][bj][m][n] = __builtin_amdgcn_mfma_f32_16x16x32_bf16(Bt[n][k], At[m][k], acc[ai][bj][m][n], 0, 0, 0); __builtin_amdgcn_s_setprio(0); } while (0)
#define PG8_WAIT_V(n) asm volatile("s_waitcnt vmcnt(" #n ")" ::: "memory")
#define PG8_WAIT_L(n) asm volatile("s_waitcnt lgkmcnt(" #n ")" ::: "memory")
#define PG8_BAR __builtin_amdgcn_s_barrier()
#define PG8_SCHED __builtin_amdgcn_sched_barrier(0)
    Unit cur, nxt; int ui = 0;
    if (!S.next(0, cur)) return;
    f32x4 acc[2][2][4][2];
#pragma unroll
    for (int a = 0; a < 2; ++a)
#pragma unroll
        for (int b = 0; b < 2; ++b)
#pragma unroll
            for (int m = 0; m < 4; ++m)
#pragma unroll
                for (int n = 0; n < 2; ++n) acc[a][b][m][n] = (f32x4){0.f, 0.f, 0.f, 0.f};
    bf16x8 At[4][2], B0[2][2], B1[2][2];
    const char* cA = (const char*)g.A + (size_t)cur.pm * tstep; const char* cB = (const char*)g.Bt + (size_t)cur.pn * tstep;
    S.a_ready(cur);
    PG8_STAGE(PG8_SB(0, 0), cB, voffB); PG8_STAGE(PG8_SA(0, 0), cA, voffA); PG8_STAGE(PG8_SB(0, 1), cB + hstep, voffB); PG8_STAGE(PG8_SA(0, 1), cA + hstep, voffA);
    if (wr == 1) PG8_BAR;
    PG8_WAIT_V(4); PG8_BAR;
    PG8_STAGE(PG8_SB(1, 0), cB + kstep, voffB); PG8_STAGE(PG8_SA(1, 0), cA + kstep, voffA); PG8_STAGE(PG8_SB(1, 1), cB + hstep + kstep, voffB);
    PG8_WAIT_V(6); PG8_BAR;
    PG8_STAMP();
    for (;;) {
        const bool has_next = S.next(ui + 1, nxt);
        const char* nA = has_next ? (const char*)g.A + (size_t)nxt.pm * tstep : cA; const char* nB = has_next ? (const char*)g.Bt + (size_t)nxt.pn * tstep : cB;
        for (int t = 0; t < nt; t += 2) {
            const bool last = (t == nt - 2);
            const char* a1 = cA + (size_t)(t + 1) * kstep;
            const char* a2 = last ? nA : cA + (size_t)(t + 2) * kstep; const char* b2 = last ? nB : cB + (size_t)(t + 2) * kstep;
            const char* a3 = a2 + kstep; const char* b3 = b2 + kstep;
            if (last && has_next) S.a_ready(nxt);
            PG8_LDB(B0, 0, 0); PG8_SCHED; PG8_LDA(At, 0, 0); PG8_STAGE(PG8_SA(1, 1), a1 + hstep, voffA);
            PG8_WAIT_L(8); PG8_BAR; PG8_WAIT_L(0); PG8_MMA(0, 0, At, B0); PG8_BAR; PG8_SCHED;
            PG8_LDB(B1, 0, 1); PG8_STAGE(PG8_SB(0, 0), b2, voffB);
            PG8_BAR; PG8_WAIT_L(0); PG8_MMA(0, 1, At, B1); PG8_BAR;
            PG8_LDA(At, 0, 1); PG8_STAGE(PG8_SA(0, 0), a2, voffA);
            PG8_BAR; PG8_WAIT_L(0); PG8_MMA(1, 0, At, B0); PG8_BAR; PG8_SCHED;
            PG8_STAGE(PG8_SB(0, 1), b2 + hstep, voffB);
            PG8_WAIT_V(6); PG8_BAR; PG8_MMA(1, 1, At, B1); PG8_BAR;
            PG8_LDB(B0, 1, 0); PG8_SCHED; PG8_LDA(At, 1, 0); PG8_STAGE(PG8_SA(0, 1), a2 + hstep, voffA);
            PG8_WAIT_L(8); PG8_BAR; PG8_WAIT_L(0); PG8_MMA(0, 0, At, B0); PG8_BAR; PG8_SCHED;
            PG8_LDB(B1, 1, 1); PG8_STAGE(PG8_SB(1, 0), b3, voffB);
            PG8_BAR; PG8_WAIT_L(0); PG8_MMA(0, 1, At, B1); PG8_BAR;
            PG8_LDA(At, 1, 1); PG8_STAGE(PG8_SA(1, 0), a3, voffA);
            PG8_BAR; PG8_WAIT_L(0); PG8_MMA(1, 0, At, B0); PG8_BAR; PG8_SCHED;
            PG8_STAGE(PG8_SB(1, 1), b3 + hstep, voffB);
            PG8_WAIT_V(6); PG8_BAR; PG8_MMA(1, 1, At, B1); PG8_BAR;
        }
        PG8_STAMP();
        if constexpr (!Epi::AFTER_DRAIN) { E(acc, cur, wr, wc, fr, fq); S.done(cur); }
        PG8_STAMP();
        if (!has_next) break;
#pragma unroll
        for (int a = 0; a < 2; ++a)
#pragma unroll
            for (int b = 0; b < 2; ++b)
#pragma unroll
                for (int m = 0; m < 4; ++m)
#pragma unroll
                    for (int n = 0; n < 2; ++n) acc[a][b][m][n] = (f32x4){0.f, 0.f, 0.f, 0.f};
        cur = nxt; cA = nA; cB = nB; ++ui;
    }
    PG8_WAIT_V(0);
    if (wr == 0) PG8_BAR;
    PG8_BAR;
    if constexpr (Epi::AFTER_DRAIN) { E.fused(acc, cur, wr, wc, fr, fq, lds, wid, lane); S.done(cur); }
    PG8_STAMP();
    if (STAMP && wid == 0) { stamps[lane] = lane < nts ? (((unsigned long long)(unsigned)ts_hi << 32) | (unsigned)ts_lo) : 0ull;
        if (lane == 62) stamps[62] = rt_entry; if (lane == 63) stamps[63] = (unsigned long long)wall_clock64(); }
#undef PG8_STAMP
#undef PG8_SA
#undef PG8_SB
#undef PG8_STAGE
#undef PG8_LDA
#undef PG8_LDB
#undef PG8_MMA
#undef PG8_WAIT_V
#undef PG8_WAIT_L
#undef PG8_BAR
#undef PG8_SCHED
}
}

struct P1Desc {
    static constexpr bool FP8 = false;
    struct U { int mt, nt; };
    struct R { float rs[4]; };
    const char* xb; const char* w; bf16_t* proj; const float* rstd1; int bid, nb;
    __device__ __forceinline__ bool get(int i, U& u) const { const int uu = i * nb + bid; if (uu >= 2048) return false;
        const int g = uu >> 8, b = uu & 255, xcd = b & 7, j = b >> 3; u.mt = g * 16 + (xcd >> 1) * 4 + (j >> 3); u.nt = (xcd & 1) * 8 + (j & 7); return true; }
    __device__ __forceinline__ int nk() const { return 16; }
    __device__ __forceinline__ unsigned aoff(const U& u, int row) const { return (unsigned)(u.mt * 256 + row) * 2048u; }
    __device__ __forceinline__ unsigned boff(const U& u, int rho) const { return (unsigned)(u.nt * 128 + perm_row<4>(rho)) * 2048u; }
    __device__ __forceinline__ const char* abase(const U&, int kt) const { return xb + kt * 128; }
    __device__ __forceinline__ const char* bbase(const U&, int kt) const { return w + kt * 128; }
    __device__ __forceinline__ void* sink() const { return (void*)proj; }
    template <class Acc> __device__ __forceinline__ void init(const U& u, Acc& acc, R& r, int wr, int wc, int fr, int fq) const {
#pragma unroll
        for (int m = 0; m < 4; ++m) { r.rs[m] = rstd1[u.mt * 256 + wr * 64 + m * 16 + fr];
#pragma unroll
            for (int n = 0; n < 4; ++n) acc[m][n] = (f32x4){0.f, 0.f, 0.f, 0.f}; }
    }
    template <class Acc> __device__ __forceinline__ void epi(const U& u, Acc& acc, const R& r, int wr, int wc, int fr, int fq) const {
        const int col = u.nt * 128 + wc * 64 + fq * 16;
#pragma unroll
        for (int m = 0; m < 4; ++m) { const int row = u.mt * 256 + wr * 64 + m * 16 + fr; const float rs = r.rs[m];
            bf16_t* dst = proj + (size_t)row * NP + col;
#pragma unroll
            for (int h = 0; h < 2; ++h) { const f32x4 a = acc[m][2 * h] * rs, b = acc[m][2 * h + 1] * rs;
                *(uint4*)(dst + 8 * h) = make_uint4(pack2(a[0], a[1]), pack2(a[2], a[3]), pack2(b[0], b[1]), pack2(b[2], b[3])); } }
    }
};
template <int MODE = 0> __device__ __forceinline__ void phase1(const Params& p, LAS unsigned char* lds, int bid, int nb) {
    pg8::Gemm g; g.A = (const pg8::bf16_t*)(p.ws + OFF_A); g.Bt = (const pg8::bf16_t*)(p.ws + OFF_WIN); g.M = T; g.N = NG; g.K = D;
    pg8::StaticOrder S; S.init(T, NG, nb, bid);
    pg8::EpiProj E; E.proj = (unsigned short*)(p.ws + OFF_B); E.rstd = (const float*)(p.ws + OFF_RSTD1);
    pg8::gemm_phase<pg8::EpiProj, pg8::StaticOrder>(lds, g, S, E, nullptr);
}
struct P3Desc {
    static constexpr bool FP8 = false;
    __device__ __forceinline__ void* sink() const { return (void*)hb; }
    struct U { int mt, nt; };
    struct R { int dummy; };
    const char* y; const char* w; const bf16_t* xb; bf16_t* hb; unsigned char* hb8; float* ssq2; int bid, nb;
    __device__ __forceinline__ bool get(int i, U& u) const { const int uu = i * nb + bid; if (uu >= 1024) return false;
        const int g = uu >> 8, b = uu & 255, xcd = b & 7, j = b >> 3; u.mt = g * 32 + xcd * 4 + (j >> 3); u.nt = j & 7; return true; }
    __device__ __forceinline__ int nk() const { return 16; }
    __device__ __forceinline__ unsigned aoff(const U& u, int row) const { return (unsigned)(u.mt * 256 + row) * 2048u; }
    __device__ __forceinline__ unsigned boff(const U& u, int rho) const { return (unsigned)(u.nt * 128 + perm_row<4>(rho)) * 2048u; }
    __device__ __forceinline__ const char* abase(const U&, int kt) const { return y + kt * 128; }
    __device__ __forceinline__ const char* bbase(const U&, int kt) const { return w + kt * 128; }
    template <class Acc> __device__ __forceinline__ void init(const U& u, Acc& acc, R& r, int wr, int wc, int fr, int fq) const {
        const int col = u.nt * 128 + wc * 64 + fq * 16;
#pragma unroll
        for (int m = 0; m < 4; ++m) { const size_t o = (size_t)(u.mt * 256 + wr * 64 + m * 16 + fr) * D + col;
#pragma unroll
            for (int h = 0; h < 2; ++h) { const uint4 xr = *(const uint4*)(xb + o + 8 * h);
                acc[m][2 * h] = (f32x4){lo_bf(xr.x), hi_bf(xr.x), lo_bf(xr.y), hi_bf(xr.y)}; acc[m][2 * h + 1] = (f32x4){lo_bf(xr.z), hi_bf(xr.z), lo_bf(xr.w), hi_bf(xr.w)}; } }
    }
    template <class Acc> __device__ __forceinline__ void epi(const U& u, Acc& acc, const R& r, int wr, int wc, int fr, int fq) const {
        const int col = u.nt * 128 + wc * 64 + fq * 16;
#pragma unroll
        for (int m = 0; m < 4; ++m) { const int row = u.mt * 256 + wr * 64 + m * 16 + fr; const size_t o = (size_t)row * D + col; float ss = 0.f;
            *(uint4*)(hb8 + o) = make_uint4(pack4_fp8(acc[m][0][0] * SC_H8, acc[m][0][1] * SC_H8, acc[m][0][2] * SC_H8, acc[m][0][3] * SC_H8), pack4_fp8(acc[m][1][0] * SC_H8, acc[m][1][1] * SC_H8, acc[m][1][2] * SC_H8, acc[m][1][3] * SC_H8),
                                            pack4_fp8(acc[m][2][0] * SC_H8, acc[m][2][1] * SC_H8, acc[m][2][2] * SC_H8, acc[m][2][3] * SC_H8), pack4_fp8(acc[m][3][0] * SC_H8, acc[m][3][1] * SC_H8, acc[m][3][2] * SC_H8, acc[m][3][3] * SC_H8));
#pragma unroll
            for (int h = 0; h < 2; ++h) { const f32x4 a = acc[m][2 * h], b = acc[m][2 * h + 1];
                *(uint4*)(hb + o + 8 * h) = make_uint4(pack2(a[0], a[1]), pack2(a[2], a[3]), pack2(b[0], b[1]), pack2(b[2], b[3]));
                ss += a[0] * a[0] + a[1] * a[1] + a[2] * a[2] + a[3] * a[3] + b[0] * b[0] + b[1] * b[1] + b[2] * b[2] + b[3] * b[3]; }
            ss += __shfl_xor(ss, 16); ss += __shfl_xor(ss, 32);
            if (fq == 0) ssq2[(size_t)row * 16 + u.nt * 2 + wc] = ss; }
    }
};
__device__ __forceinline__ void phase3(const Params& p, LAS unsigned char* lds, int bid, int nb) {
    pg8::Gemm g; g.A = (const pg8::bf16_t*)(p.ws + OFF_C); g.Bt = (const pg8::bf16_t*)(p.ws + OFF_WOUT); g.M = T; g.N = D; g.K = D;
    pg8::StaticOrder S; S.init(T, D, nb, bid);
    pg8::EpiOut E; E.xb = (const unsigned short*)(p.ws + OFF_A); E.hb = (unsigned short*)(p.ws + OFF_H); E.hb8 = p.ws + OFF_H8; E.ssq2 = (float*)(p.ws + OFF_SSQ2);
    pg8::gemm_phase<pg8::EpiOut, pg8::StaticOrder>(lds, g, S, E, nullptr);
}
struct P4Desc {
    static constexpr bool FP8 = false;
    __device__ __forceinline__ void* sink() const { return (void*)ws; }
    struct U { int u; };
    struct R { int dummy; };
    template <class Acc> __device__ __forceinline__ void init(const U&, Acc& acc, R&, int, int, int, int) const {
#pragma unroll
        for (int n = 0; n < 4; ++n) acc[0][n] = (f32x4){0.f, 0.f, 0.f, 0.f}; }
    const char* hb; const char* w; const float* ssq2; unsigned char* ws; LAS unsigned char* lds; int bid, nb;
    __device__ __forceinline__ bool get(int i, U& u) const { u.u = i * nb + bid; return u.u < 256; }
    __device__ __forceinline__ int nk() const { return 16; }
    __device__ __forceinline__ unsigned aoff(const U& u, int row) const { return (unsigned)(u.u * 128 + row) * 2048u; }
    __device__ __forceinline__ unsigned boff(const U&, int rho) const { return (unsigned)rho * 2048u; }
    __device__ __forceinline__ const char* abase(const U&, int kt) const { return hb + kt * 128; }
    __device__ __forceinline__ const char* bbase(const U&, int kt) const { return w + kt * 128; }
    template <class Acc> __device__ __forceinline__ void epi(const U& uu, Acc& acc, const R&, int wr, int wc, int fr, int fq) const {
        LAS int* hist = (LAS int*)(lds + LDS_MISC);
        LAS int* base = (LAS int*)(lds + LDS_MISC + 1024);
        LAS float* lg = (LAS float*)(lds + 65536);
        int* cnt = (int*)(ws + OFF_CNT); int* el = (int*)(ws + OFF_EL); int* pl = (int*)(ws + OFF_PL);
        __syncthreads();
#pragma unroll
        for (int n = 0; n < 4; ++n)
#pragma unroll
            for (int j = 0; j < 4; ++j) { const int col = n * 16 + fq * 4 + j; if (col < 36) lg[(wr * 16 + fr) * 37 + col] = acc[0][n][j]; }
        if (threadIdx.x < 144) hist[threadIdx.x] = 0;
        __syncthreads();
        const int t = threadIdx.x, r = uu.u * 128 + t;
        int e0 = 0, e1 = 0, bucket = 0, r0 = 0, r1 = 0, rb = 0; float ga = 0.f, gb = 0.f, rstd2 = 0.f;
        if (t < 128) { const float* q = ssq2 + (size_t)r * 16; float ss = 0.f;
#pragma unroll
            for (int j = 0; j < 16; ++j) ss += q[j];
            rstd2 = rsqrtf(ss * (1.0f / D) + EPS);
            const LAS float* mine = lg + t * 37;
            int gs = 0; float gm = mine[0];
#pragma unroll
            for (int j = 1; j < 4; ++j) { const float v = mine[j]; if (v > gm) { gm = v; gs = j; } }
            float den = 0.f;
#pragma unroll
            for (int j = 0; j < 4; ++j) den += __expf((mine[j] - gm) * rstd2);
            const float g1 = 1.0f / den;
            const LAS float* le = mine + 4 + gs * 8;
            int i0 = 0; float l0 = le[0];
#pragma unroll
            for (int j = 1; j < 8; ++j) { const float v = le[j]; if (v > l0) { l0 = v; i0 = j; } }
            int i1 = -1; float l1 = -3.0e38f;
#pragma unroll
            for (int j = 0; j < 8; ++j) { const float v = le[j]; if (j != i0 && v > l1) { l1 = v; i1 = j; } }
            const float w0 = 1.0f / (1.0f + __expf((l1 - l0) * rstd2)), w1 = 1.0f - w0;
            int a = i0, bb = i1; ga = g1 * w0; gb = g1 * w1;
            if (a > bb) { const int ti = a; a = bb; bb = ti; const float tf = ga; ga = gb; gb = tf; }
            e0 = gs * 8 + a; e1 = gs * 8 + bb; bucket = gs * 28 + pair_off(a) + (bb - a - 1);
            r0 = __hip_atomic_fetch_add(&hist[e0], 1, __ATOMIC_RELAXED, __HIP_MEMORY_SCOPE_WORKGROUP); r1 = __hip_atomic_fetch_add(&hist[e1], 1, __ATOMIC_RELAXED, __HIP_MEMORY_SCOPE_WORKGROUP);
            rb = __hip_atomic_fetch_add(&hist[32 + bucket], 1, __ATOMIC_RELAXED, __HIP_MEMORY_SCOPE_WORKGROUP); }
        __syncthreads();
        if (t < 144) { const int c = hist[t]; base[t] = c ? atomicAdd(&cnt[t], c) : 0; }
        __syncthreads();
        if (t < 128) { int4 rec; rec.x = e0 | (e1 << 8) | (bucket << 16); rec.y = __float_as_int(ga); rec.z = __float_as_int(gb); rec.w = __float_as_int(rstd2);
            float* ers = (float*)(ws + OFF_ERS);
            const size_t p0 = (size_t)e0 * T + base[e0] + r0, p1 = (size_t)e1 * T + base[e1] + r1;
            el[p0] = (r << 17) | (int)f2bf(ga); el[p1] = (r << 17) | (1 << 16) | (int)f2bf(gb); ers[p0] = rstd2; ers[p1] = rstd2;
            pl[(size_t)bucket * T + base[32 + bucket] + rb] = r; }
    }
};
__device__ __forceinline__ void phase4(const Params& p, LAS unsigned char* lds, int bid, int nb) {
    P4Desc d; d.hb = (const char*)(p.ws + OFF_H); d.w = (const char*)(p.ws + OFF_WR); d.ssq2 = (const float*)(p.ws + OFF_SSQ2); d.ws = p.ws; d.lds = lds; d.bid = bid; d.nb = nb;
    gemm_stream<CfgR>(lds, d);
}
__device__ __forceinline__ int wave_prefix128(int v0, int v1, int& ex0, int& ex1) {
    const int lane = threadIdx.x & 63; int s0 = v0, s1 = v1;
#pragma unroll
    for (int o = 1; o < 64; o <<= 1) { const int t0 = __shfl_up(s0, o), t1 = __shfl_up(s1, o); if (lane >= o) { s0 += t0; s1 += t1; } }
    const int tot0 = __shfl(s0, 63), tot1 = __shfl(s1, 63);
    ex0 = s0 - v0; ex1 = tot0 + s1 - v1; return tot0 + tot1;
}
template <int TMV>
struct P5aDescT {
    static constexpr bool FP8 = true;
    __device__ __forceinline__ void* sink() const { return (void*)act; }
    struct U { int e, row0, ntile, ce; };
    struct R { int ent[TMV]; float rs[TMV]; };
    const char* hb8; const char* wgu; unsigned char* act; const int* cnt; const int* el; const float* ers; LAS int* pre; int bid, nb;
    __device__ __forceinline__ bool get(int i, U& u) const {
        const int total = pre[NE], nfull = total / nb, rem = total - nfull * nb; const bool split = rem > 0 && 2 * rem <= nb;
        int uu, half = 0;
        if (TMV == 4) { if (i > nfull || (i == nfull && split)) return false; uu = i * nb + bid; if (uu >= total) return false; }
        else { if (i != 0 || !split || bid >= 2 * rem) return false; uu = nfull * nb + (bid >> 1); half = bid & 1; }
        const int ln = threadIdx.x & 63; const int e = __builtin_popcountll(__ballot(ln < NE && pre[ln + 1] <= uu));
        const int local = uu - pre[e]; u.e = e; u.row0 = (local >> 2) * 256 + half * 128; u.ntile = local & 3; u.ce = pre[40 + e]; return true; }
    __device__ __forceinline__ int nk() const { return 8; }
    __device__ __forceinline__ unsigned aoff(const U& u, int row) const { const int li = min(u.row0 + row, u.ce - 1); return ((unsigned)el[(size_t)u.e * T + li] >> 17) * 1024u; }
    __device__ __forceinline__ unsigned boff(const U& u, int rho) const {
        const int w = rho & 31, n2 = w >> 4, q = (w >> 2) & 3, j = w & 3;
        return (unsigned)(u.e * 512 + u.ntile * 128 + (rho & ~31) + q * 8 + n2 * 4 + j) * 1024u; }
    __device__ __forceinline__ const char* abase(const U&, int kt) const { return hb8 + kt * 128; }
    __device__ __forceinline__ const char* bbase(const U&, int kt) const { return wgu + kt * 128; }
    template <class Acc> __device__ __forceinline__ void init(const U& u, Acc& acc, R& r, int wr, int wc, int fr, int fq) const {
        const size_t lb = (size_t)u.e * T;
#pragma unroll
        for (int m = 0; m < TMV; ++m) { const int li = min(u.row0 + wr * (TMV * 16) + m * 16 + fr, u.ce - 1); r.ent[m] = el[lb + li]; r.rs[m] = ers[lb + li];
#pragma unroll
            for (int n = 0; n < 4; ++n) acc[m][n] = (f32x4){0.f, 0.f, 0.f, 0.f}; }
    }
    template <class Acc> __device__ __forceinline__ void epi(const U& u, Acc& acc, const R& r, int wr, int wc, int fr, int fq) const {
#pragma unroll
        for (int m = 0; m < TMV; ++m) { const unsigned ent = (unsigned)r.ent[m]; const int tok = ent >> 17, slot = (ent >> 16) & 1;
            const float gate = __uint_as_float(ent << 16) * SC_ACT, rs = r.rs[m] * (1.0f / (SC_H8 * SC_WGU));
            float a[8];
#pragma unroll
            for (int n = 0; n < 2; ++n)
#pragma unroll
                for (int j = 0; j < 4; ++j) { const float G = acc[m][n][j] * rs, Uv = acc[m][n + 2][j] * rs; a[n * 4 + j] = G * __builtin_amdgcn_rcpf(1.0f + __expf(-G)) * Uv * gate; }
            *(uint2*)(act + (size_t)tok * 512 + slot * 256 + u.ntile * 64 + wc * 32 + fq * 8) = make_uint2(pack4_fp8(a[0], a[1], a[2], a[3]), pack4_fp8(a[4], a[5], a[6], a[7])); }
    }
};
typedef P5aDescT<4> P5aDesc;
typedef GemmCfg<4, 2, 2, 4, 64, 3> CfgA2;
template <int MODE = 0> __device__ __forceinline__ void phase5a(const Params& p, LAS unsigned char* lds, int bid, int nb) {
    P5aDesc d; d.hb8 = (const char*)(p.ws + OFF_H8); d.wgu = (const char*)(p.ws + OFF_WGU); d.act = p.ws + OFF_B; d.cnt = (const int*)(p.ws + OFF_CNT);
    d.el = (const int*)(p.ws + OFF_EL); d.ers = (const float*)(p.ws + OFF_ERS); d.pre = (LAS int*)(lds + LDS_MISC); d.bid = bid; d.nb = nb;
    __syncthreads();
    if (threadIdx.x < 64) { const int ln = threadIdx.x; const int c = ln < NE ? d.cnt[ln] : 0; int ex0, ex1; const int tot = wave_prefix128(((c + 255) >> 8) * 4, 0, ex0, ex1);
        if (ln < NE) { d.pre[ln] = ex0; d.pre[40 + ln] = c; } if (ln == 0) d.pre[NE] = tot; }
    __syncthreads();
    gemm_stream3<CfgA, P5aDesc, MODE>(lds, d);
    { P5aDescT<2> d2; d2.hb8 = d.hb8; d2.wgu = d.wgu; d2.act = d.act; d2.cnt = d.cnt; d2.el = d.el; d2.ers = d.ers; d2.pre = d.pre; d2.bid = bid; d2.nb = nb;
      gemm_stream3<CfgA2, P5aDescT<2>, MODE>(lds, d2); }
}
template <int MODE = 0>
__device__ __forceinline__ void phase5b(const Params& p, LAS unsigned char* lds, int bid, int nb, float* dst) {
    constexpr int A_BYTES = 64 * 128, B_BYTES = 512 * 128, ST = A_BYTES + B_BYTES;
    const char* act = (const char*)(p.ws + OFF_B); const char* wd = (const char*)(p.ws + OFF_WD);
    const int* cnt = (const int*)(p.ws + OFF_CNT) + 32; const int* pl = (const int*)(p.ws + OFF_PL); const bf16_t* hb = (const bf16_t*)(p.ws + OFF_H);
    LAS int* pre = (LAS int*)(lds + LDS_MISC); LAS float* red = (LAS float*)(lds + LDS_MISC + 1024); LAS float* fn = (LAS float*)(lds + LDS_MISC + 4096);
    const int tid = threadIdx.x, wid = __builtin_amdgcn_readfirstlane(tid >> 6), lane = tid & 63, wc = wid, fr = lane & 15, fq = lane >> 4;
    __syncthreads();
    fn[tid] = p.final_norm[tid]; fn[tid + 512] = p.final_norm[tid + 512];
    if (tid < 64) { const int c0 = cnt[tid], c1 = (tid + 64 < NBUCK) ? cnt[tid + 64] : 0; int ex0, ex1; const int tot = wave_prefix128((c0 + 63) >> 6, (c1 + 63) >> 6, ex0, ex1);
        pre[tid] = ex0; pre[128 + tid] = c0; if (tid + 64 < NBUCK) { pre[tid + 64] = ex1; pre[128 + tid + 64] = c1; } if (tid == 0) pre[NBUCK] = tot; }
    __syncthreads();
    const int total = pre[NBUCK];
    struct U { int b, mtile, cb, e0, e1, hm, j; };
    const int nfull = total / nb, rem = total - nfull * nb; const bool split = rem > 0 && 2 * rem <= nb;
    auto get = [&](int i, U& u) -> bool {
        int uu;
        if (i < nfull) { uu = i * nb + bid; u.hm = 3; u.j = 0; }
        else if (i == nfull && split) { if (bid >= 2 * rem) return false; uu = nfull * nb + (bid >> 1); u.hm = 1 << (bid & 1); u.j = bid >> 1; }
        else if (i == nfull) { uu = i * nb + bid; if (uu >= total) return false; u.hm = 3; u.j = 0; }
        else return false;
        const int ln = threadIdx.x & 63; const int b = __builtin_popcountll(__ballot(pre[ln + 1] <= uu)) + __builtin_popcountll(__ballot(ln + 64 < NBUCK && pre[ln + 65] <= uu));
        u.b = b; u.mtile = uu - pre[b]; u.cb = pre[128 + b]; const int g = b / 28, pi = b % 28;
        int a = 0;
#pragma unroll
        for (int q = 1; q < 7; ++q) a += (pair_off(q) <= pi) ? 1 : 0;
        u.e0 = g * 8 + a; u.e1 = g * 8 + a + 1 + (pi - pair_off(a)); return true; };
    U us, uc; int is = 0, ts = 0;
    bool more = get(0, us);
    if (!more) return;
    ts = (us.hm == 2) ? 4 : 0;
    unsigned offA, offB[8];
    {
#pragma unroll
        for (int i = 0; i < 8; ++i) { const int rho = (wid + 8 * i) * 8 + (lane >> 3); offB[i] = (unsigned)rho * 256u + (unsigned)swz_slot<64>(rho, lane & 7) * 16u; }
    }
    auto set_a = [&](const U& u) { const int row = wid * 8 + (lane >> 3), li = min(u.mtile * 64 + row, u.cb - 1);
        offA = (unsigned)pl[(size_t)u.b * T + li] * 512u + (unsigned)swz_slot<64>(row, lane & 7) * 16u; };
    set_a(us);
    int sbuf = 0;
    auto stage_next = [&]() {
        if (!more) return;
        const int nh = ts >> 2, kt = ts & 3;
        const char* ab = act + kt * 128;
        const char* bb = wd + (size_t)(kt < 2 ? us.e0 : us.e1) * (D * DE) + (kt & 1) * 128 + (size_t)nh * (512 * 256);
        LAS unsigned char* sa = lds + sbuf;
        if (!(MODE & 4)) {
        __builtin_amdgcn_global_load_lds((const unsigned*)(ab + offA), (LAS unsigned*)(sa + wid * 1024), 16, 0, 0);
#pragma unroll
        for (int i = 0; i < 8; ++i) __builtin_amdgcn_global_load_lds((const unsigned*)(bb + offB[i]), (LAS unsigned*)(sa + A_BYTES + (wid + 8 * i) * 1024), 16, 0, 0);
        }
        sbuf ^= ST;
        if (++ts == ((us.hm == 1) ? 4 : 8)) { ++is; more = get(is, us); if (more) { set_a(us); ts = (us.hm == 2) ? 4 : 0; } }
    };
    int aread[2], bread[2];
#pragma unroll
    for (int ks = 0; ks < 2; ++ks) { aread[ks] = fr * 128 + swz_slot<64>(fr, ks * 4 + fq) * 16; bread[ks] = A_BYTES + (wc * 64 + fr) * 128 + swz_slot<64>(fr, ks * 4 + fq) * 16; }
    f32x4 acc[2][4][4];
    int tok[4];
    __syncthreads();
    stage_next();
    int cbuf = 0;
    for (int ic = 0; get(ic, uc); ++ic) {
        {
            const int* list = pl + (size_t)uc.b * T;
#pragma unroll
            for (int m = 0; m < 4; ++m) tok[m] = list[min(uc.mtile * 64 + m * 16 + fr, uc.cb - 1)];
#pragma unroll
            for (int nh = 0; nh < 2; ++nh) {
                if (uc.hm & (1 << nh)) {
#pragma unroll
                    for (int m = 0; m < 4; ++m) { const bf16_t* hr = hb + (size_t)tok[m] * D + nh * 512 + wc * 64 + fq * 4;
#pragma unroll
                        for (int n = 0; n < 4; ++n) { const uint2 xr = *(const uint2*)(hr + n * 16);
                            acc[nh][m][n] = (f32x4){lo_bf(xr.x), hi_bf(xr.x), lo_bf(xr.y), hi_bf(xr.y)} * (SC_ACT * SC_WD); } }
                } else {
#pragma unroll
                    for (int m = 0; m < 4; ++m)
#pragma unroll
                        for (int n = 0; n < 4; ++n) acc[nh][m][n] = (f32x4){0.f, 0.f, 0.f, 0.f};
                }
            }
        }
#pragma unroll
        for (int nh = 0; nh < 2; ++nh)
        if (uc.hm & (1 << nh))
#pragma nounroll
        for (int kt4 = 0; kt4 < 4; ++kt4) {
            asm volatile("s_waitcnt vmcnt(0)" ::: "memory");
            __builtin_amdgcn_s_barrier();
            asm volatile("" ::: "memory");
            stage_next();
            if (!(MODE & 2)) {
            const LAS unsigned char* sa = lds + cbuf;
            {
                i32x8 af[4];
#pragma unroll
                for (int m = 0; m < 4; ++m) af[m] = cat8(*(const LAS bf16x8*)(sa + aread[0] + m * 16 * 128), *(const LAS bf16x8*)(sa + aread[1] + m * 16 * 128));
#pragma unroll
                for (int np = 0; np < 2; ++np) {
                    i32x8 bfr[2];
#pragma unroll
                    for (int n = 0; n < 2; ++n) bfr[n] = cat8(*(const LAS bf16x8*)(sa + bread[0] + (np * 2 + n) * 16 * 128), *(const LAS bf16x8*)(sa + bread[1] + (np * 2 + n) * 16 * 128));
#pragma unroll
                    for (int m = 0; m < 4; ++m)
#pragma unroll
                        for (int n = 0; n < 2; ++n) acc[nh][m][np * 2 + n] = MFMA_F8_K128(bfr[n], af[m], acc[nh][m][np * 2 + n]);
                }
            }
            }
            cbuf ^= ST;
        }
        if (!(MODE & 1)) {
            constexpr float inv = 1.0f / (SC_ACT * SC_WD);
#pragma unroll
            for (int m = 0; m < 4; ++m) { float ss = 0.f;
#pragma unroll
                for (int nh = 0; nh < 2; ++nh)
#pragma unroll
                    for (int n = 0; n < 4; ++n) { acc[nh][m][n] *= inv; ss += acc[nh][m][n][0] * acc[nh][m][n][0] + acc[nh][m][n][1] * acc[nh][m][n][1] + acc[nh][m][n][2] * acc[nh][m][n][2] + acc[nh][m][n][3] * acc[nh][m][n][3]; }
                ss += __shfl_xor(ss, 16); ss += __shfl_xor(ss, 32);
                if (fq == 0) red[(m * 16 + fr) * 8 + wc] = ss; }
            __syncthreads();
            float ssr[4];
#pragma unroll
            for (int m = 0; m < 4; ++m) { float ss = 0.f;
#pragma unroll
                for (int w8 = 0; w8 < 8; ++w8) ss += red[(m * 16 + fr) * 8 + w8];
                ssr[m] = ss; }
            if (uc.hm != 3) {
                float* xch = (float*)(p.ws + OFF_RT) + (size_t)uc.j * 128; unsigned* flag = (unsigned*)(p.ws + OFF_BAR + 15360) + uc.j; const int hf = uc.hm >> 1;
                if (wid == 0 && fq == 0) {
#pragma unroll
                    for (int m = 0; m < 4; ++m) __hip_atomic_store(xch + hf * 64 + m * 16 + fr, ssr[m], __ATOMIC_RELAXED, __HIP_MEMORY_SCOPE_AGENT);
                }
                asm volatile("s_waitcnt vmcnt(0)" ::: "memory");
                __syncthreads();
                if (tid == 0) __hip_atomic_fetch_add(flag, 1u, __ATOMIC_RELAXED, __HIP_MEMORY_SCOPE_AGENT);
                if (wid == 0) { unsigned sp = 0;
                    while ((unsigned)__builtin_amdgcn_readfirstlane(__hip_atomic_load(flag, __ATOMIC_RELAXED, __HIP_MEMORY_SCOPE_AGENT)) < 2u && ++sp < (1u << 22)) __builtin_amdgcn_s_sleep(2);
                    __builtin_amdgcn_fence(__ATOMIC_ACQUIRE, "agent");
                    asm volatile("s_waitcnt vmcnt(0)" ::: "memory"); }
                __syncthreads();
#pragma unroll
                for (int m = 0; m < 4; ++m) ssr[m] += __hip_atomic_load(xch + (hf ^ 1) * 64 + m * 16 + fr, __ATOMIC_RELAXED, __HIP_MEMORY_SCOPE_AGENT);
            }
#pragma unroll
            for (int m = 0; m < 4; ++m) {
                const float rs = rsqrtf(ssr[m] * (1.0f / D) + EPS);
                if (uc.mtile * 64 + m * 16 + fr < uc.cb) {
#pragma unroll
                    for (int nh = 0; nh < 2; ++nh) if (uc.hm & (1 << nh)) { const int col = nh * 512 + wc * 64 + fq * 4; float* o = dst + (size_t)tok[m] * D + col;
#pragma unroll
                        for (int n = 0; n < 4; ++n) { const f32x4 gf = *(const LAS f32x4*)(fn + col + n * 16);
                            *(float4*)(o + n * 16) = make_float4(acc[nh][m][n][0] * rs * gf[0], acc[nh][m][n][1] * rs * gf[1], acc[nh][m][n][2] * rs * gf[2], acc[nh][m][n][3] * rs * gf[3]); } } } }
            __syncthreads();
        } else { float s = 0.f;
#pragma unroll
            for (int nh = 0; nh < 2; ++nh)
#pragma unroll
                for (int m = 0; m < 4; ++m)
#pragma unroll
                    for (int n = 0; n < 4; ++n) s += acc[nh][m][n][0] + acc[nh][m][n][1] + acc[nh][m][n][2] + acc[nh][m][n][3];
            if (s == 123.456f) *dst = s; }
    }
    asm volatile("s_waitcnt vmcnt(0)" ::: "memory");
}
__device__ __forceinline__ void unpack8(const uint4 v, float* f) {
    f[0] = __uint_as_float(v.x << 16); f[1] = __uint_as_float(v.x & 0xffff0000u); f[2] = __uint_as_float(v.y << 16); f[3] = __uint_as_float(v.y & 0xffff0000u);
    f[4] = __uint_as_float(v.z << 16); f[5] = __uint_as_float(v.z & 0xffff0000u); f[6] = __uint_as_float(v.w << 16); f[7] = __uint_as_float(v.w & 0xffff0000u);
}
__device__ __forceinline__ void phase2(const Params& p, LAS unsigned char* lds, int bid, int nb) {
    const int tid = threadIdx.x, wid = __builtin_amdgcn_readfirstlane(tid >> 6), lane = tid & 63, fr = lane & 15, fq = lane >> 4;
    bf16_t* y = (bf16_t*)(p.ws + OFF_C);
    LAS float* red = (LAS float*)(lds + LDS_MISC + 1024);
    const int cch = lane * 8;
    const int g = wid >> 1, nh = wid & 1;
    const bf16_t* pw = (const bf16_t*)(p.ws + OFF_POOL);
    for (int unit = bid; unit < T / 64; unit += nb) {
        const int R0 = unit * 64, b = R0 >> 13, s0 = R0 & 8191;
        __syncthreads();
        {
            const int cvl = lane & 15, rq = lane >> 4, rbase = (wid & 1) * 32 + rq * 8, col = 1024 + g * 128 + cvl * 8;
            auto pooled_rows = [&](auto wc_) {
                constexpr int W = decltype(wc_)::value;
                constexpr float invw = 1.0f / (float)W;
                uint4 raw[W + 7];
#pragma unroll
                for (int q = 0; q < W + 7; ++q) raw[q] = *(const uint4*)(proj_row(p, b, s0 + rbase - (W - 1) + q) + col);
                float run[8], f[8];
#pragma unroll
                for (int j = 0; j < 8; ++j) run[j] = 0.f;
#pragma unroll
                for (int q = 0; q < W - 1; ++q) { unpack8(raw[q], f);
#pragma unroll
                    for (int j = 0; j < 8; ++j) run[j] += f[j]; }
#pragma unroll
                for (int i = 0; i < 8; ++i) { const int row = rbase + i;
                    unpack8(raw[W - 1 + i], f);
                    float pv[8];
#pragma unroll
                    for (int j = 0; j < 8; ++j) { run[j] += f[j]; pv[j] = run[j] * invw - f[j]; }
                    *(LAS u32x4*)(lds + g * 16384 + (cvl >> 3) * 8192 + row * 128 + swz_slot<64>(row, cvl & 7) * 16) = (u32x4){pack2(pv[0], pv[1]), pack2(pv[2], pv[3]), pack2(pv[4], pv[5]), pack2(pv[6], pv[7])};
                    unpack8(raw[i], f);
#pragma unroll
                    for (int j = 0; j < 8; ++j) run[j] -= f[j]; }
            };
            if (g == 0) pooled_rows(std::integral_constant<int, 2>{});
            else if (g == 1) pooled_rows(std::integral_constant<int, 4>{});
            else if (g == 2) pooled_rows(std::integral_constant<int, 8>{});
            else pooled_rows(std::integral_constant<int, 16>{});
        }
        {
            const int sb = s0 + wid * 8;
            float w0[8], w1[8], w2[8];
#pragma unroll
            for (int j = 0; j < 8; ++j) { w0[j] = p.conv_w[cch + j]; w1[j] = p.conv_w[512 + cch + j]; w2[j] = p.conv_w[1024 + cch + j]; }
            float u2[8], u1[8], u0[8], b8[8];
            { const uint4 h2 = *(const uint4*)(proj_row(p, b, sb - 2) + 512 + cch), h1 = *(const uint4*)(proj_row(p, b, sb - 1) + 512 + cch); unpack8(h2, u2); unpack8(h1, u1); }
#pragma unroll
            for (int hb4 = 0; hb4 < 2; ++hb4) {
                uint4 uq[4], bq8[4];
#pragma unroll
                for (int i = 0; i < 4; ++i) { const bf16_t* r = proj_row(p, b, sb + hb4 * 4 + i); bq8[i] = *(const uint4*)(r + cch); uq[i] = *(const uint4*)(r + 512 + cch); }
#pragma unroll
                for (int i = 0; i < 4; ++i) {
                    unpack8(bq8[i], b8); unpack8(uq[i], u0);
                    float raw[8]; float ss = 0.f;
#pragma unroll
                    for (int j = 0; j < 8; ++j) { raw[j] = b8[j] * (w0[j] * u2[j] + w1[j] * u1[j] + w2[j] * u0[j]); ss += raw[j] * raw[j]; u2[j] = u1[j]; u1[j] = u0[j]; }
                    ss = wave_sum(ss); const float rs = rsqrtf(ss * (1.0f / 512) + EPS);
                    *(uint4*)(y + (size_t)(R0 + wid * 8 + hb4 * 4 + i) * D + cch) = make_uint4(pack2(raw[0] * rs, raw[1] * rs), pack2(raw[2] * rs, raw[3] * rs), pack2(raw[4] * rs, raw[5] * rs), pack2(raw[6] * rs, raw[7] * rs)); }
            }
        }
        bf16x8 bfr[4][4];
#pragma unroll
        for (int ks = 0; ks < 4; ++ks)
#pragma unroll
            for (int n = 0; n < 4; ++n) bfr[ks][n] = *(const bf16x8*)(pw + (size_t)(g * 128 + nh * 64 + n * 16 + fr) * 128 + ks * 32 + fq * 8);
        __syncthreads();
        f32x4 acc[4][4];
#pragma unroll
        for (int m = 0; m < 4; ++m)
#pragma unroll
            for (int n = 0; n < 4; ++n) acc[m][n] = (f32x4){0.f, 0.f, 0.f, 0.f};
#pragma unroll
        for (int ks = 0; ks < 4; ++ks) {
            bf16x8 af[4];
#pragma unroll
            for (int m = 0; m < 4; ++m) af[m] = *(const LAS bf16x8*)(lds + g * 16384 + (ks >> 1) * 8192 + (m * 16 + fr) * 128 + swz_slot<64>(fr, (ks & 1) * 4 + fq) * 16);
#pragma unroll
            for (int m = 0; m < 4; ++m)
#pragma unroll
                for (int n = 0; n < 4; ++n) acc[m][n] = __builtin_amdgcn_mfma_f32_16x16x32_bf16(bfr[ks][n], af[m], acc[m][n], 0, 0, 0);
        }
#pragma unroll
        for (int m = 0; m < 4; ++m) { float ss = 0.f;
#pragma unroll
            for (int n = 0; n < 4; ++n) { acc[m][n] *= *(const f32x4*)(p.pool_scale + g * 128 + nh * 64 + n * 16 + fq * 4); ss += acc[m][n][0] * acc[m][n][0] + acc[m][n][1] * acc[m][n][1] + acc[m][n][2] * acc[m][n][2] + acc[m][n][3] * acc[m][n][3]; }
            ss += __shfl_xor(ss, 16); ss += __shfl_xor(ss, 32);
            if (fq == 0) red[(m * 16 + fr) * 8 + wid] = ss; }
        __syncthreads();
#pragma unroll
        for (int m = 0; m < 4; ++m) { float ss = 0.f;
#pragma unroll
            for (int w8 = 0; w8 < 8; ++w8) ss += red[(m * 16 + fr) * 8 + w8];
            const float rs = rsqrtf(ss * (1.0f / 512) + EPS);
#pragma unroll
            for (int n = 0; n < 4; ++n) { const f32x4 v = acc[m][n] * rs;
                *(uint2*)(y + (size_t)(R0 + m * 16 + fr) * D + 512 + g * 128 + nh * 64 + n * 16 + fq * 4) = make_uint2(pack2(v[0], v[1]), pack2(v[2], v[3])); } }
    }
}

#define XB_TMO      128
#define XB_XCNT(j)  (256  + 64 * (j))
#define XB_XSUB(j)  (1280 + 64 * (j))
#define XB_XGEN(j)  (2304 + 64 * (j))
#define XB_TOP      3328
#define XB_TOPGEN   3392
#define XCD_BAR_WORDS 3456
#define XB_SPIN_CAP (1u << 18)
__device__ __forceinline__ unsigned xb_ld(unsigned* p)              { return __hip_atomic_load(p, __ATOMIC_RELAXED, __HIP_MEMORY_SCOPE_AGENT); }
__device__ __forceinline__ unsigned xb_add(unsigned* p, unsigned v) { return __hip_atomic_fetch_add(p, v, __ATOMIC_RELAXED, __HIP_MEMORY_SCOPE_AGENT); }
__device__ __forceinline__ unsigned xb_xcc_id() { return (unsigned)__builtin_amdgcn_s_getreg((3 << 11) | 20) & 0xFu; }
#define XB_SPIN(cond, bar) do { unsigned _sp = 0; while (cond) { __builtin_amdgcn_s_sleep(1); \
    if ((++_sp & 255u) == 0u) { if (xb_ld(&(bar)[XB_TMO])) break; if (_sp > XB_SPIN_CAP) { atomicAdd(&(bar)[XB_TMO], 1u); break; } } } } while (0)
struct XcdBarrier { unsigned* bar; unsigned x; volatile __attribute__((address_space(3))) unsigned* st; };
__device__ __forceinline__ XcdBarrier xcd_barrier_post(unsigned* bar, volatile __attribute__((address_space(3))) unsigned* st) {
    XcdBarrier b; b.bar = bar; b.x = xb_xcc_id(); b.st = st;
    if (threadIdx.x == 0) (void)xb_add(&bar[XB_XCNT(b.x)], 1u);
    return b;
}
__device__ __forceinline__ void xcd_barrier_complete(unsigned* bar, unsigned x, unsigned& nloc, unsigned& nx) {
    const unsigned G = gridDim.x * gridDim.y * gridDim.z;
    unsigned sum, cnt, mine, sp = 0u;
    for (;;) {
        sum = 0u; cnt = 0u; mine = 0u;
#pragma unroll
        for (unsigned j = 0; j < 16; ++j) { const unsigned c = xb_ld(&bar[XB_XCNT(j)]); sum += c; cnt += (c > 0u) ? 1u : 0u; mine = (j == x) ? c : mine; }
        if (sum == G) break;
        __builtin_amdgcn_s_sleep(1);
        if ((++sp & 255u) == 0u) { if (xb_ld(&bar[XB_TMO])) break; if (sp > XB_SPIN_CAP) { atomicAdd(&bar[XB_TMO], 1u); break; } }
    }
    nloc = mine > 0u ? mine : 1u; nx = cnt > 0u ? cnt : 1u;
}
__device__ __forceinline__ void xcd_barrier(const XcdBarrier& b) {
    asm volatile("s_waitcnt vmcnt(0)" ::: "memory");
    __syncthreads();
    if (threadIdx.x == 0) {
        unsigned* bar = b.bar;
        __builtin_amdgcn_s_waitcnt(0);
        unsigned nloc = b.st[0], nx = b.st[1];
        if (nloc == 0u) { xcd_barrier_complete(bar, b.x, nloc, nx); b.st[0] = nloc; b.st[1] = nx; }
        const unsigned old = xb_add(&bar[XB_XSUB(b.x)], 1u);
        const unsigned gen = old / nloc;
        if (old + 1u == (gen + 1u) * nloc) {
            __builtin_amdgcn_fence(__ATOMIC_RELEASE, "agent");
            asm volatile("s_waitcnt vmcnt(0)" ::: "memory");
            const unsigned og = xb_add(&bar[XB_TOP], 1u);
            const unsigned tg = og / nx;
            if (og + 1u == (tg + 1u) * nx) xb_add(&bar[XB_TOPGEN], 1u);
            else XB_SPIN(xb_ld(&bar[XB_TOPGEN]) == tg, bar);
            __builtin_amdgcn_fence(__ATOMIC_ACQUIRE, "agent");
            xb_add(&bar[XB_XGEN(b.x)], 1u);
            asm volatile("s_waitcnt vmcnt(0)" ::: "memory");
        } else {
            XB_SPIN(xb_ld(&bar[XB_XGEN(b.x)]) == gen, bar);
            __builtin_amdgcn_fence(__ATOMIC_ACQUIRE, "agent");
            asm volatile("s_waitcnt vmcnt(0)" ::: "memory");
        }
    }
    __syncthreads();
}

__global__ void __launch_bounds__(512, 2) mega_kernel(Params p) {
    extern __shared__ __attribute__((aligned(16))) unsigned char lds_raw[];
    LAS unsigned char* lds = (LAS unsigned char*)lds_raw;
    cg::grid_group grid = cg::this_grid();
    const int bid = blockIdx.x, nb = gridDim.x;
    volatile LAS unsigned* st = (volatile LAS unsigned*)(lds + LDS_MISC + 3072);
    if (threadIdx.x == 0) { st[0] = 0u; st[1] = 0u; }
    __syncthreads();
    XcdBarrier xb = xcd_barrier_post((unsigned*)(p.ws + OFF_BAR), st);
    if (p.ws == nullptr) grid.sync();
#define SEAM() xcd_barrier(xb)
    phase0(p, lds_raw, bid, nb); SEAM();
#if PROBE_DUP == 0
    phase0<PROBE_MODE>(p, lds_raw, bid, nb); SEAM();
#endif
    phase1(p, lds, bid, nb); SEAM();
#if PROBE_DUP == 1
    phase1<PROBE_MODE>(p, lds, bid, nb); SEAM();
#endif
    phase2(p, lds, bid, nb); SEAM();
#if PROBE_DUP == 2
    phase2(p, lds, bid, nb); SEAM();
#endif
    phase3(p, lds, bid, nb); SEAM();
#if PROBE_DUP == 3
    phase3(p, lds, bid, nb); SEAM();
#endif
    phase4(p, lds, bid, nb); SEAM();
#if PROBE_DUP == 4
    { int* cnt = (int*)(p.ws + OFF_CNT); if (bid == 0 && threadIdx.x < 256) cnt[threadIdx.x] = 0; } SEAM();
    phase4(p, lds, bid, nb); SEAM();
#endif
    phase5a(p, lds, bid, nb); SEAM();
#if PROBE_DUP == 5
    phase5a<PROBE_MODE>(p, lds, bid, nb); SEAM();
#endif
#if PROBE_DUP == 6
    phase5b<PROBE_MODE>(p, lds, bid, nb, (float*)(p.ws + OFF_B + 32 * MiB)); SEAM();
#endif
    phase5b(p, lds, bid, nb, p.out);
}

extern "C" void kernel_launch(void* const* d_in, const int* in_sizes, int n_in, void* d_out, int out_size, void* d_ws, size_t ws_size, hipStream_t stream) {
    static int init = 0;
    static int grid_blocks = 0;
    if (!init) {
        if (ws_size < WS_END) { fprintf(stderr, "workspace too small: %zu < %zu\n", ws_size, (size_t)WS_END); init = -1; return; }
        (void)hipFuncSetAttribute((const void*)mega_kernel, hipFuncAttributeMaxDynamicSharedMemorySize, LDS_BYTES);
        int dev = 0, cus = 0, per_cu = 0;
        (void)hipGetDevice(&dev);
        (void)hipDeviceGetAttribute(&cus, hipDeviceAttributeMultiprocessorCount, dev);
        (void)hipOccupancyMaxActiveBlocksPerMultiprocessor(&per_cu, (const void*)mega_kernel, 512, LDS_BYTES);
        if (per_cu < 1) { fprintf(stderr, "occupancy query says %d blocks/CU\n", per_cu); per_cu = 1; }
        if (per_cu > 1) per_cu = 1;
        grid_blocks = cus * per_cu;
        init = 1;
    }
    if (init < 0) return;
    Params p{};
    const float** f = (const float**)&p;
    for (int i = 0; i < 17; ++i) f[i] = (const float*)d_in[i];
    p.out = (float*)d_out; p.ws = (unsigned char*)d_ws;
    (void)hipMemsetAsync((unsigned char*)d_ws + OFF_BAR, 0, 16384, stream);
    void* args[] = {&p};
    hipError_t e = hipLaunchCooperativeKernel((const void*)mega_kernel, dim3(grid_blocks), dim3(512), args, LDS_BYTES, stream);
    if (e != hipSuccess) fprintf(stderr, "cooperative launch failed: %s (grid %d)\n", hipGetErrorString(e), grid_blocks);
}
```

```cpp
#include <hip/hip_runtime.h>
#include <hip/hip_cooperative_groups.h>
#include <cstdio>
#include <cstdint>
#include <type_traits>
namespace cg = cooperative_groups;
#define PROBE_DUP -1
#define PROBE_MODE 0

typedef unsigned short bf16_t;
typedef short bf16x8 __attribute__((ext_vector_type(8)));
typedef float f32x4 __attribute__((ext_vector_type(4)));
typedef unsigned u32x4 __attribute__((ext_vector_type(4)));
typedef long l64x2 __attribute__((ext_vector_type(2)));
typedef int i32x8 __attribute__((ext_vector_type(8)));
typedef int i32x4 __attribute__((ext_vector_type(4)));
__device__ __forceinline__ i32x8 cat8(bf16x8 lo, bf16x8 hi) { const i32x4 a = __builtin_bit_cast(i32x4, lo), b = __builtin_bit_cast(i32x4, hi); return (i32x8){a[0], a[1], a[2], a[3], b[0], b[1], b[2], b[3]}; }
#define MFMA_F8_K128(A, B, C) __builtin_amdgcn_mfma_scale_f32_16x16x128_f8f6f4((A), (B), (C), 0, 0, 0, 0x7f7f7f7f, 0, 0x7f7f7f7f)

constexpr int T = 32768, SEQ = 8192, D = 1024, NG = 2048  , NP = 1536  , DC = 512, NE = 32, DE = 256, NBUCK = 112;
constexpr float EPS = 1e-6f;
constexpr size_t MiB = 1024 * 1024;
constexpr size_t OFF_A = 0;
constexpr size_t OFF_B = 64 * MiB;
constexpr size_t OFF_C = 192 * MiB;
constexpr size_t OFF_WIN = 256 * MiB;
constexpr size_t OFF_WOUT = 260 * MiB;
constexpr size_t OFF_WGU = 262 * MiB;
constexpr size_t OFF_WD = 294 * MiB;
constexpr size_t OFF_POOL = 310 * MiB;
constexpr size_t OFF_WR = OFF_POOL + 128 * 1024;
constexpr size_t OFF_PM = OFF_WR + 128 * 1024;
constexpr size_t OFF_RSTD1 = OFF_PM + 64 * 1024;
constexpr size_t OFF_SSQ2 = OFF_RSTD1 + 128 * 1024;
constexpr size_t OFF_RT = OFF_SSQ2 + 2 * MiB;
constexpr size_t OFF_EL = OFF_RT + 512 * 1024;
constexpr size_t OFF_PL = OFF_EL + 4 * MiB;
constexpr size_t OFF_ERS = 332 * MiB;
constexpr size_t OFF_H = 336 * MiB;
constexpr size_t OFF_BAR = OFF_H + 64 * MiB;
constexpr size_t OFF_H8 = OFF_BAR + 1 * MiB;
constexpr size_t WS_END = OFF_H8 + 32 * MiB;
constexpr size_t OFF_CNT = OFF_BAR + 14336;

struct Params {
    const float *x, *meta, *norm_mix, *w_in, *conv_w, *norm_conv_out, *pool_w, *pool_scale, *norm_pool_out, *w_out, *norm_ffn,
        *w_rg, *w_re, *w_gate, *w_up, *w_down, *final_norm;
    float* out;
    unsigned char* ws;
};

__device__ __forceinline__ int tid_fresh() { int t = threadIdx.x; asm volatile("" : "+v"(t)); return t; }
__device__ __forceinline__ float bf2f(bf16_t v) { return __uint_as_float(((unsigned)v) << 16); }
__device__ __forceinline__ bf16_t f2bf(float f) { unsigned u = __float_as_uint(f); u += 0x7fffu + ((u >> 16) & 1u); return (bf16_t)(u >> 16); }
__device__ __forceinline__ unsigned pack2(float lo, float hi) { return (unsigned)f2bf(lo) | ((unsigned)f2bf(hi) << 16); }
__device__ __forceinline__ unsigned pack4_fp8(float a, float b, float c, float d) {
    a = __builtin_amdgcn_fmed3f(a, -448.f, 448.f); b = __builtin_amdgcn_fmed3f(b, -448.f, 448.f); c = __builtin_amdgcn_fmed3f(c, -448.f, 448.f); d = __builtin_amdgcn_fmed3f(d, -448.f, 448.f);
    int w = __builtin_amdgcn_cvt_pk_fp8_f32(a, b, 0, false); w = __builtin_amdgcn_cvt_pk_fp8_f32(c, d, w, true); return (unsigned)w; }
constexpr float SC_H8 = 16.f, SC_WGU = 512.f, SC_ACT = 8.f, SC_WD = 256.f;
__device__ __forceinline__ float wave_sum(float v) {
#pragma unroll
    for (int o = 32; o > 0; o >>= 1) v += __shfl_xor(v, o);
    return v;
}
__device__ __forceinline__ int pair_off(int a) { return a * 8 - (a * (a + 1)) / 2; }

struct TrItem { const float* src; bf16_t* dst; const float* kscale; int ld_src, ld_dst, k0, n0, mapmode; float f8scale; };
__device__ __forceinline__ int tr_map(int mode, int h) {
    if (mode == 0) return h;
    if (mode == 3) { if (h < 512 || h >= 1536) return h; const int isv = h >= 1024, ch = (h - 512) & 511;
        return 512 + (ch >> 7) * 256 + ((ch >> 6) & 1) * 128 + ((ch >> 4) & 3) * 32 + ((ch >> 2) & 3) * 8 + 4 * isv + (ch & 3); }
    return ((h >> 5) << 6) + (h & 31) + (mode == 2 ? 32 : 0); }

constexpr int P0_PM = 128, P0_XR = 1024  , P0_WIN = 16 * 8, P0_WOUT = 16 * 4, P0_GATE = 32 * 16, P0_UP = P0_GATE, P0_DOWN = 32 * 4 * 4, P0_WR = 16, P0_POOL = 8;
constexpr int P0_TR0 = P0_PM + P0_XR, P0_TR = P0_WIN + P0_WOUT + P0_GATE + P0_UP + P0_DOWN, P0_ITEMS = P0_TR0 + P0_TR + P0_WR + P0_POOL;

__device__ __forceinline__ bool p0_tr_decode(const Params& p, int it, TrItem& t) {
    int i = it - P0_TR0; if (i < 0 || i >= P0_TR) return false;
    if (i < P0_WIN) { t.src = p.w_in; t.ld_src = NG; t.dst = (bf16_t*)(p.ws + OFF_WIN); t.ld_dst = D; t.k0 = (i & 15) * 64; t.n0 = (i >> 4) * 256; t.kscale = p.norm_mix; t.mapmode = 3; t.f8scale = 0.f; return true; }
    i -= P0_WIN;
    if (i < P0_WOUT) { t.src = p.w_out; t.ld_src = D; t.dst = (bf16_t*)(p.ws + OFF_WOUT); t.ld_dst = D; t.k0 = (i & 15) * 64; t.n0 = (i >> 4) * 256;
        t.kscale = (t.k0 < DC) ? p.norm_conv_out : (p.norm_pool_out - DC); t.mapmode = 0; t.f8scale = 0.f; return true; }
    i -= P0_WOUT;
    if (i < P0_GATE + P0_UP) { const int up = i >= P0_GATE; if (up) i -= P0_GATE; const int ex = i >> 4;
        t.src = (up ? p.w_up : p.w_gate) + (size_t)ex * D * DE; t.ld_src = DE; t.dst = (bf16_t*)(p.ws + OFF_WGU + (size_t)ex * 512 * D); t.ld_dst = D; t.k0 = (i & 15) * 64; t.n0 = 0;
        t.kscale = p.norm_ffn; t.mapmode = up ? 2 : 1; t.f8scale = SC_WGU; return true; }
    i -= P0_GATE + P0_UP;
    { const int ex = i >> 4; t.src = p.w_down + (size_t)ex * DE * D; t.ld_src = D; t.dst = (bf16_t*)(p.ws + OFF_WD + (size_t)ex * D * DE); t.ld_dst = DE; t.k0 = ((i >> 2) & 3) * 64; t.n0 = (i & 3) * 256;
      t.kscale = nullptr; t.mapmode = 0; t.f8scale = SC_WD; return true; }
}
__device__ __forceinline__ void p0_tr_load(const TrItem& t, float4 (&v)[8]) {
    const int tid = threadIdx.x;
#pragma unroll
    for (int i = 0; i < 8; ++i) { const int idx = tid + 512 * i, k = idx >> 6, n4 = idx & 63;
        v[i] = *(const float4*)(t.src + (size_t)(t.k0 + k) * t.ld_src + t.n0 + n4 * 4);
        if (t.kscale) { const float s = t.kscale[t.k0 + k]; v[i].x *= s; v[i].y *= s; v[i].z *= s; v[i].w *= s; } }
}

template <int MODE = 0> __device__ __forceinline__ void phase0(const Params& p, unsigned char* lds, int bid, int nb) {
    float* tile = (float*)lds;
    const int t = tid_fresh(), wid = t >> 6, lane = t & 63;
    bf16_t* xb = (bf16_t*)(p.ws + OFF_A);
    float* rstd1 = (float*)(p.ws + OFF_RSTD1);
    int it = bid;
    float4 v[8];
    TrItem cur, nxt;
    int first = bid; while (first < P0_TR0) first += nb;
    bool have = p0_tr_decode(p, first, cur);
    if (have) p0_tr_load(cur, v);
    for (; it < P0_PM; it += nb) {
            const int c16 = t & 15, col = (c16 >> 2) * 512 + it * 4 + (c16 & 3), ks = t >> 4;
            float wv[32];
#pragma unroll
            for (int j = 0; j < 32; ++j) wv[j] = p.w_in[(size_t)(ks * 32 + j) * NG + col];
            float* metan = (float*)lds;
            float* red = (float*)(lds + 65536);
            for (int rr = 0; rr < 2; ++rr) { const int r = wid * 2 + rr; const float* mr = p.meta + (size_t)r * D;
                float mv[16]; float ss = 0.f;
#pragma unroll
                for (int j = 0; j < 16; ++j) { mv[j] = mr[j * 64 + lane]; ss += mv[j] * mv[j]; }
                ss = wave_sum(ss); const float rs = rsqrtf(ss * (1.0f / D) + EPS);
#pragma unroll
                for (int j = 0; j < 16; ++j) metan[r * D + j * 64 + lane] = mv[j] * rs * p.norm_mix[j * 64 + lane]; }
            __syncthreads();
            float acc[16];
#pragma unroll
            for (int r = 0; r < 16; ++r) acc[r] = 0.f;
#pragma unroll
            for (int j = 0; j < 32; ++j) {
#pragma unroll
                for (int r = 0; r < 16; ++r) acc[r] += metan[r * D + ks * 32 + j] * wv[j]; }
#pragma unroll
            for (int r = 0; r < 16; ++r) red[(ks * 16 + r) * 16 + c16] = acc[r];
            __syncthreads();
            if (t < 256) { const int r = t >> 4, c = t & 15; float s = 0.f;
#pragma unroll
                for (int k8 = 0; k8 < 32; ++k8) s += red[(k8 * 16 + r) * 16 + c];
                metan[r * 16 + c] = s; }
            __syncthreads();
            bf16_t* pm = (bf16_t*)(p.ws + OFF_PM);
            if (t < 192) { const int r = t / 12, o = t % 12, q = o & 3; const float* vr = metan + r * 16;
                const float val = o < 4 ? vr[q] : (o < 8 ? vr[4 + q] * vr[8 + q] : vr[12 + q]);
                pm[(size_t)r * NP + (o >> 2) * 512 + it * 4 + q] = f2bf(val); }
            __syncthreads();
    }
    for (; it < P0_TR0; it += nb) {
            if (MODE & 1) continue;
            const int r0 = (it - P0_PM) * 32 + wid * 4;
            float4 a[4][4];
#pragma unroll
            for (int q = 0; q < 4; ++q)
#pragma unroll
                for (int j = 0; j < 4; ++j) a[q][j] = *(const float4*)(p.x + (size_t)(r0 + q) * D + j * 256 + lane * 4);
#pragma unroll
            for (int q = 0; q < 4; ++q) { float ss = 0.f;
#pragma unroll
                for (int j = 0; j < 4; ++j) { const float4 u0 = a[q][j];
                    ss += u0.x * u0.x + u0.y * u0.y + u0.z * u0.z + u0.w * u0.w;
                    *(uint2*)(xb + (size_t)(r0 + q) * D + j * 256 + lane * 4) = make_uint2(pack2(u0.x, u0.y), pack2(u0.z, u0.w)); }
                ss = wave_sum(ss);
                if (lane == 0) rstd1[r0 + q] = rsqrtf(ss * (1.0f / D) + EPS); }
    }
    {
        for (; it < P0_TR0 + P0_TR; it += nb) {
            if (MODE & 2) continue;
            __syncthreads();
#pragma unroll
            for (int i = 0; i < 8; ++i) { const int idx = t + 512 * i, k = idx >> 6, n4 = idx & 63; float* d = tile + (n4 >> 4) * (64 * 65) + k * 65 + (n4 & 15) * 4;
                d[0] = v[i].x; d[1] = v[i].y; d[2] = v[i].z; d[3] = v[i].w; }
            const bool hn = p0_tr_decode(p, it + nb, nxt);
            if (hn) p0_tr_load(nxt, v);
            __syncthreads();
            { const int n = t >> 3, ko = t & 7;
#pragma unroll
              for (int sub = 0; sub < 4; ++sub) { const float* s = tile + sub * (64 * 65) + (ko * 8) * 65 + n;
                  const size_t o = (size_t)tr_map(cur.mapmode, cur.n0 + sub * 64 + n) * cur.ld_dst + cur.k0 + ko * 8;
                  if (cur.f8scale != 0.f) { const float f = cur.f8scale;
                      *(uint2*)((unsigned char*)cur.dst + o) = make_uint2(pack4_fp8(s[0] * f, s[65] * f, s[130] * f, s[195] * f), pack4_fp8(s[260] * f, s[325] * f, s[390] * f, s[455] * f)); }
                  else *(uint4*)(cur.dst + o) = make_uint4(pack2(s[0], s[65]), pack2(s[130], s[195]), pack2(s[260], s[325]), pack2(s[390], s[455])); } }
            cur = nxt; have = hn;
        }
        (void)have;
    }
    for (; it < P0_TR0 + P0_TR + P0_WR; it += nb) {
            const int i = it - (P0_TR0 + P0_TR);
            bf16_t* wr = (bf16_t*)(p.ws + OFF_WR);
            for (int q = t; q < 4096; q += 512) { const int j = q >> 6, k = i * 64 + (q & 63);
                float val = 0.f; if (j < 4) val = p.w_rg[k * 4 + j]; else if (j < 36) val = p.w_re[k * 32 + (j - 4)];
                wr[(size_t)j * D + k] = f2bf(val * p.norm_ffn[k]); }
    }
    for (; it < P0_ITEMS; it += nb) {
            const int i = it - (P0_TR0 + P0_TR + P0_WR);
            bf16_t* pt = (bf16_t*)(p.ws + OFF_POOL);
            for (int q = t; q < 8192; q += 512) { const int o = i * 8192 + q, g = o >> 14, dd = (o >> 7) & 127, c = o & 127;
                pt[o] = f2bf(p.pool_w[(size_t)g * 16384 + c * 128 + dd]); }
    }
}
__device__ __forceinline__ const bf16_t* proj_row(const Params& p, int b, int s) {
    return s >= 0 ? (const bf16_t*)(p.ws + OFF_B) + ((size_t)b * SEQ + s) * NP : (const bf16_t*)(p.ws + OFF_PM) + (size_t)(16 + s) * NP;
}
#define LAS __attribute__((address_space(3)))
constexpr int LDS_STAGE = 147456, LDS_MISC = LDS_STAGE, LDS_BYTES = LDS_STAGE + 8192;

template <int WM_, int WN_, int TM_, int TN_, int BK_, int NST_>
struct GemmCfg {
    static constexpr int WM = WM_, WN = WN_, TM = TM_, TN = TN_, BK = BK_, NST = NST_;
    static constexpr int BM = WM * TM * 16, BN = WN * TN * 16;
    static constexpr int SL = BK / 8, RPC = 64 / SL;
    static constexpr int A_CH = BM / RPC, B_CH = BN / RPC, NA = (A_CH + 7) / 8, NB = (B_CH + 7) / 8;
    static constexpr int ROWB = BK * 2, A_BYTES = BM * ROWB, B_BYTES = BN * ROWB, ST_BYTES = A_BYTES + B_BYTES, KS = BK / 32;
    static constexpr bool UNIFORM = (A_CH % 8 == 0) && (B_CH % 8 == 0);
    static_assert(WM * WN == 8, "8 waves");
    static_assert(NST * ST_BYTES <= LDS_STAGE, "LDS");
    static_assert(NST == 2 || UNIFORM, "counted waits need uniform piece counts");
};
template <int BK> __device__ __forceinline__ int swz_slot(int row, int slot) {
    if (BK == 64) return slot ^ ((row >> 1) & 7);
    return slot ^ ((0 - (row >> 2)) & 3);
}
template <int TN> __device__ __forceinline__ int perm_row(int rho) {
    const int g = rho / (TN * 16), w = rho % (TN * 16), n = w >> 4, q = (w >> 2) & 3, j = w & 3;
    return g * (TN * 16) + q * (TN * 4) + n * 4 + j;
}
template <int N> __device__ __forceinline__ void wait_vm() {
    static_assert(N == 0 || N == 3 || N == 4 || N == 6 || N == 9 || N == 12 || N == 15, "add the count");
    if (N == 0) asm volatile("s_waitcnt vmcnt(0)" ::: "memory");
    else if (N == 4) asm volatile("s_waitcnt vmcnt(4)" ::: "memory");
    else if (N == 3) asm volatile("s_waitcnt vmcnt(3)" ::: "memory");
    else if (N == 6) asm volatile("s_waitcnt vmcnt(6)" ::: "memory");
    else if (N == 9) asm volatile("s_waitcnt vmcnt(9)" ::: "memory");
    else if (N == 12) asm volatile("s_waitcnt vmcnt(12)" ::: "memory");
    else asm volatile("s_waitcnt vmcnt(15)" ::: "memory");
}

template <class C, class D, int MODE = 0>
__device__ __forceinline__ void gemm_stream(LAS unsigned char* lds, const D& d) {
    typedef typename D::U U;
    const int tid = tid_fresh(), wid = __builtin_amdgcn_readfirstlane(tid >> 6), lane = tid & 63, wr = wid / C::WN, wc = wid % C::WN, fr = lane & 15, fq = lane >> 4;
    const int nk = d.nk();
    U us, uc;
    int is = 0, kts = 0;
    bool more = d.get(0, us);
    unsigned offA[C::NA], offB[C::NB];
    auto set_offsets = [&](const U& u) {
#pragma unroll
        for (int i = 0; i < C::NA; ++i) { const int c = wid + 8 * i, row = c * C::RPC + lane / C::SL, sp = lane % C::SL;
            offA[i] = (c < C::A_CH) ? d.aoff(u, row) + (unsigned)swz_slot<C::BK>(row, sp) * 16u : 0u; }
#pragma unroll
        for (int i = 0; i < C::NB; ++i) { const int c = wid + 8 * i, row = c * C::RPC + lane / C::SL, sp = lane % C::SL;
            offB[i] = (c < C::B_CH) ? d.boff(u, row) + (unsigned)swz_slot<C::BK>(row, sp) * 16u : 0u; }
    };
    if (more) set_offsets(us);
    int aread[C::KS], bread[C::KS];
#pragma unroll
    for (int ks = 0; ks < C::KS; ++ks) {
        aread[ks] = (wr * C::TM * 16 + fr) * C::ROWB + swz_slot<C::BK>(fr, ks * 4 + fq) * 16;
        bread[ks] = C::A_BYTES + (wc * C::TN * 16 + fr) * C::ROWB + swz_slot<C::BK>(fr, ks * 4 + fq) * 16;
    }
    f32x4 acc[C::TM][C::TN];
    typename D::R rs;
    int issued = 0, sbuf = 0;
    auto stage_next = [&]() {
        if (!more) return;
        const char* ab = d.abase(us, kts); const char* bb = d.bbase(us, kts);
        LAS unsigned char* sa = lds + sbuf;
        if (!(MODE & 4)) {
#pragma unroll
        for (int i = 0; i < C::NA; ++i) { const int c = wid + 8 * i;
            if (c < C::A_CH) __builtin_amdgcn_global_load_lds((const unsigned*)(ab + offA[i]), (LAS unsigned*)(sa + c * 1024), 16, 0, 0); }
#pragma unroll
        for (int i = 0; i < C::NB; ++i) { const int c = wid + 8 * i;
            if (c < C::B_CH) __builtin_amdgcn_global_load_lds((const unsigned*)(bb + offB[i]), (LAS unsigned*)(sa + C::A_BYTES + c * 1024), 16, 0, 0); }
        }
        ++issued; sbuf += C::ST_BYTES; if (sbuf == C::NST * C::ST_BYTES) sbuf = 0;
        if (++kts == nk) { kts = 0; ++is; more = d.get(is, us); if (more) set_offsets(us); }
    };
    __syncthreads();
    stage_next();
    if (C::NST == 3) stage_next();
    int g = 0, cbuf = 0;
    for (int ic = 0; d.get(ic, uc); ++ic) {
        d.init(uc, acc, rs, wr, wc, fr, fq);
        for (int kt = 0; kt < nk; ++kt, ++g) {
            if (C::NST == 3 && issued > g + 1) wait_vm<C::UNIFORM ? C::NA + C::NB : 0>(); else wait_vm<0>();
            __builtin_amdgcn_s_barrier();
            asm volatile("" ::: "memory");
            stage_next();
            const LAS unsigned char* sa = lds + cbuf;
            if (!(MODE & 2)) {
#pragma unroll
            for (int ks = 0; ks < C::KS; ++ks) {
                bf16x8 af[C::TM], bfr[C::TN];
#pragma unroll
                for (int m = 0; m < C::TM; ++m) af[m] = *(const LAS bf16x8*)(sa + aread[ks] + m * 16 * C::ROWB);
#pragma unroll
                for (int n = 0; n < C::TN; ++n) bfr[n] = *(const LAS bf16x8*)(sa + bread[ks] + n * 16 * C::ROWB);
#pragma unroll
                for (int m = 0; m < C::TM; ++m)
#pragma unroll
                    for (int n = 0; n < C::TN; ++n) acc[m][n] = __builtin_amdgcn_mfma_f32_16x16x32_bf16(bfr[n], af[m], acc[m][n], 0, 0, 0);
            }
            }
            cbuf += C::ST_BYTES; if (cbuf == C::NST * C::ST_BYTES) cbuf = 0;
        }
        if (!(MODE & 1)) d.epi(uc, acc, rs, wr, wc, fr, fq);
        else { float s = 0.f;
#pragma unroll
            for (int m = 0; m < C::TM; ++m)
#pragma unroll
                for (int n = 0; n < C::TN; ++n) s += acc[m][n][0] + acc[m][n][1] + acc[m][n][2] + acc[m][n][3];
            if (s == 123.456f) *(float*)d.sink() = s; }
    }
}

template <class C, class D, int MODE = 0>
__device__ __forceinline__ void gemm_stream3(LAS unsigned char* lds, const D& d) {
    static_assert(C::KS == 2 && C::UNIFORM && C::NST == 3, "BK = 64, 3 buffers, uniform pieces");
    constexpr int P = C::NA + C::NB;
    typedef typename D::U U;
    const int tid = tid_fresh(), wid = __builtin_amdgcn_readfirstlane(tid >> 6), lane = tid & 63, wr = wid / C::WN, wc = wid % C::WN, fr = lane & 15, fq = lane >> 4;
    const int half = wid >> 2;
    const int nk = d.nk();
    U us, uc;
    int is = 0, kts = 0;
    bool more = d.get(0, us);
    if (!more) return;
    unsigned offA[C::NA], offB[C::NB];
    auto set_offsets = [&](const U& u) {
#pragma unroll
        for (int i = 0; i < C::NA; ++i) { const int c = wid + 8 * i, row = c * C::RPC + lane / C::SL, sp = lane % C::SL;
            offA[i] = d.aoff(u, row) + (unsigned)swz_slot<C::BK>(row, sp) * 16u; }
#pragma unroll
        for (int i = 0; i < C::NB; ++i) { const int c = wid + 8 * i, row = c * C::RPC + lane / C::SL, sp = lane % C::SL;
            offB[i] = d.boff(u, row) + (unsigned)swz_slot<C::BK>(row, sp) * 16u; }
    };
    set_offsets(us);
    int aread[2], bread[2];
#pragma unroll
    for (int ks = 0; ks < 2; ++ks) {
        aread[ks] = (wr * C::TM * 16 + fr) * C::ROWB + swz_slot<C::BK>(fr, ks * 4 + fq) * 16;
        bread[ks] = C::A_BYTES + (wc * C::TN * 16 + fr) * C::ROWB + swz_slot<C::BK>(fr, ks * 4 + fq) * 16;
    }
    f32x4 acc[C::TM][C::TN];
    typename D::R rs;
    int sbuf = 0;
    auto stage_next = [&]() -> bool {
        if (!more) return false;
        const char* ab = d.abase(us, kts); const char* bb = d.bbase(us, kts);
        LAS unsigned char* sa = lds + sbuf;
        if (!(MODE & 4)) {
#pragma unroll
        for (int i = 0; i < C::NA; ++i) __builtin_amdgcn_global_load_lds((const unsigned*)(ab + offA[i]), (LAS unsigned*)(sa + (wid + 8 * i) * 1024), 16, 0, 0);
#pragma unroll
        for (int i = 0; i < C::NB; ++i) __builtin_amdgcn_global_load_lds((const unsigned*)(bb + offB[i]), (LAS unsigned*)(sa + C::A_BYTES + (wid + 8 * i) * 1024), 16, 0, 0);
        }
        sbuf += C::ST_BYTES; if (sbuf == C::NST * C::ST_BYTES) sbuf = 0;
        if (++kts == nk) { kts = 0; ++is; more = d.get(is, us); if (more) set_offsets(us); }
        return true;
    };
    bf16x8 fa[C::TM], fb[C::TN], fa1[D::FP8 ? C::TM : 1], fb1[D::FP8 ? C::TN : 1];
    int cbuf = 0;
    auto read_frags = [&](int ks) {
        const LAS unsigned char* sa = lds + cbuf;
        if (!(MODE & 2)) {
        if (D::FP8) {
            if (ks == 0) {
#pragma unroll
                for (int m = 0; m < C::TM; ++m) { fa[m] = *(const LAS bf16x8*)(sa + aread[0] + m * 16 * C::ROWB); fa1[m] = *(const LAS bf16x8*)(sa + aread[1] + m * 16 * C::ROWB); }
#pragma unroll
                for (int n = 0; n < C::TN; ++n) { fb[n] = *(const LAS bf16x8*)(sa + bread[0] + n * 16 * C::ROWB); fb1[n] = *(const LAS bf16x8*)(sa + bread[1] + n * 16 * C::ROWB); }
            }
        } else {
#pragma unroll
        for (int m = 0; m < C::TM; ++m) fa[m] = *(const LAS bf16x8*)(sa + aread[ks] + m * 16 * C::ROWB);
#pragma unroll
        for (int n = 0; n < C::TN; ++n) fb[n] = *(const LAS bf16x8*)(sa + bread[ks] + n * 16 * C::ROWB);
        }
        }
    };
    auto mma = [&](auto ksc) {
        constexpr int ks = decltype(ksc)::value;
        asm volatile("s_waitcnt lgkmcnt(0)" ::: "memory");
        if (!(MODE & 2)) {
        __builtin_amdgcn_s_setprio(1);
        if (D::FP8) {
#pragma unroll
            for (int mm = 0; mm < C::TM / 2; ++mm) { const int m = ks * (C::TM / 2) + mm;
#pragma unroll
                for (int n = 0; n < C::TN; ++n) acc[m][n] = MFMA_F8_K128(cat8(fb[n], fb1[n]), cat8(fa[m], fa1[m]), acc[m][n]); }
        } else {
#pragma unroll
        for (int m = 0; m < C::TM; ++m)
#pragma unroll
            for (int n = 0; n < C::TN; ++n) acc[m][n] = __builtin_amdgcn_mfma_f32_16x16x32_bf16(fb[n], fa[m], acc[m][n], 0, 0, 0);
        }
        __builtin_amdgcn_s_setprio(0);
        }
    };
#define GS3_BAR() do { asm volatile("" ::: "memory"); __builtin_amdgcn_s_barrier(); asm volatile("" ::: "memory"); } while (0)
    __syncthreads();
    stage_next();
    const bool two = stage_next();
    if (two) wait_vm<P>(); else wait_vm<0>();
    GS3_BAR();
    if (half) GS3_BAR();
    for (int ic = 0; d.get(ic, uc); ++ic) {
        d.init(uc, acc, rs, wr, wc, fr, fq);
#pragma nounroll
        for (int kt = 0; kt < nk; ++kt) {
            bool staged = false;
            if (D::FP8) staged = stage_next();
            read_frags(0);
            GS3_BAR();
            mma(std::integral_constant<int, 0>{});
            GS3_BAR();
            read_frags(1);
            if (!D::FP8) staged = stage_next();
            if (staged) wait_vm<P>(); else wait_vm<0>();
            GS3_BAR();
            mma(std::integral_constant<int, 1>{});
            GS3_BAR();
            cbuf += C::ST_BYTES; if (cbuf == C::NST * C::ST_BYTES) cbuf = 0;
        }
        if (!(MODE & 1)) d.epi(uc, acc, rs, wr, wc, fr, fq);
        else { float s = 0.f;
#pragma unroll
            for (int m = 0; m < C::TM; ++m)
#pragma unroll
                for (int n = 0; n < C::TN; ++n) s += acc[m][n][0] + acc[m][n][1] + acc[m][n][2] + acc[m][n][3];
            if (s == 123.456f) *(float*)d.sink() = s; }
    }
    if (!half) GS3_BAR();
    asm volatile("s_waitcnt vmcnt(0) lgkmcnt(0)" ::: "memory");
#undef GS3_BAR
}

typedef GemmCfg<4, 2, 4, 4, 64, 3> CfgA;
typedef GemmCfg<8, 1, 1, 4, 64, 2> CfgR;

__device__ __forceinline__ float lo_bf(unsigned w) { return __uint_as_float(w << 16); }
__device__ __forceinline__ float hi_bf(unsigned w) { return __uint_as_float(w & 0xffff0000u); }

__device__ __forceinline__ void swap16(unsigned& a, unsigned& b) { const auto r = __builtin_amdgcn_permlane16_swap(a, b, false, false); a = r[0]; b = r[1]; }
namespace pg8 {
#define PG8_LAS __attribute__((address_space(3)))
typedef unsigned short bf16_t;
typedef short bf16x8 __attribute__((ext_vector_type(8)));
typedef float f32x4 __attribute__((ext_vector_type(4)));
typedef unsigned u32x4 __attribute__((ext_vector_type(4)));
constexpr int BM = 256, BK = 64, HALF = 128, HTB = HALF * BK * 2  , STAGE_BYTES = 8 * HTB, NXCD = 8, WGM = 8;

__host__ __device__ __forceinline__ int lds_byte(int r, int c) { const int st = (r >> 4) * 2 + (c >> 5), rr = r & 15, cc = c & 31, ob = rr * 64 + cc * 2; return st * 1024 + (ob ^ (((ob >> 9) & 1) << 5)); }
__host__ __device__ __forceinline__ void stage_rc(int b, int& R, int& C) { const int st = b / 1024, sb = b % 1024, swz = sb ^ (((sb >> 9) & 1) << 5); R = (st >> 1) * 16 + swz / 64; C = (st & 1) * 32 + (swz % 64) / 2; }
__host__ __device__ __forceinline__ int perm32(int rho) { const int n = rho >> 4, i = rho & 15; return 8 * (i >> 2) + 4 * n + (i & 3); }

struct Unit { int pm, pn; };
struct Gemm { const bf16_t* A; const bf16_t* Bt; int M, N, K; };

struct StaticOrder {
    int nM, nN, nwg, G, c;
    __host__ __device__ void init(int M, int N, int G_, int c_) { nM = M / BM; nN = N / BM; nwg = nM * nN; G = G_; c = c_; }
    __host__ __device__ bool next(int i, Unit& u) const {
        const long L = (long)i * G + c; if (L >= nwg) return false;
        int wgid = (int)L; { const int q = nwg / NXCD, r = nwg % NXCD, xcd = wgid % NXCD, off = wgid / NXCD; wgid = (xcd < r ? xcd * (q + 1) : r * (q + 1) + (xcd - r) * q) + off; }
        const int nig = WGM * nN, gid = wgid / nig, fm = gid * WGM, gsz = (nM - fm) < WGM ? (nM - fm) : WGM;
        u.pm = fm + ((wgid % nig) % gsz); u.pn = (wgid % nig) / gsz; return true;
    }
    __device__ __forceinline__ void a_ready(const Unit&) const {}
    __device__ __forceinline__ void done(const Unit&) const {}
};
__device__ __forceinline__ unsigned cvt_pk_bf16(float lo, float hi) { unsigned r; asm volatile("v_cvt_pk_bf16_f32 %0, %1, %2" : "=v"(r) : "v"(lo), "v"(hi)); return r; }

struct EpiProj {
    static constexpr bool PERM = true, AFTER_DRAIN = false;
    unsigned short* proj; const float* rstd;
    __device__ __forceinline__ void operator()(const f32x4 (&acc)[2][2][4][2], const Unit& u, int wr, int wc, int fr, int fq) const {
        const int row0 = u.pm * BM + wr * 64 + fr;
        float rsv[2][4];
        { const float r0 = rstd[row0 + fq * 16], r1 = rstd[row0 + HALF + fq * 16];
#pragma unroll
          for (int m = 0; m < 4; ++m) { rsv[0][m] = __shfl(r0, fr + 16 * m); rsv[1][m] = __shfl(r1, fr + 16 * m); } }
        if (u.pn >= 2 && u.pn < 6) {
            const int col0 = 512 + (u.pn - 2) * 128 + (fq & 1) * 64 + wc * 16 + (fq >> 1) * 8;
#pragma unroll
            for (int ai = 0; ai < 2; ++ai)
#pragma unroll
                for (int m = 0; m < 4; ++m) { const int row = row0 + ai * HALF + m * 16; const float rs = rsv[ai][m], rs2 = rs * rs;
                    const f32x4 u0 = acc[ai][0][m][0] * acc[ai][0][m][1] * rs2, u1 = acc[ai][1][m][0] * acc[ai][1][m][1] * rs2;
                    unsigned ax = cvt_pk_bf16(u0[0], u0[1]), ay = cvt_pk_bf16(u0[2], u0[3]), bx = cvt_pk_bf16(u1[0], u1[1]), by = cvt_pk_bf16(u1[2], u1[3]);
                    swap16(ax, bx); swap16(ay, by);
                    u32x4 w; w.x = ax; w.y = ay; w.z = bx; w.w = by;
                    *(u32x4*)(proj + (size_t)row * 1536 + col0) = w; }
        } else {
            const int col0 = (u.pn < 2 ? u.pn * BM : 1024 + (u.pn - 6) * BM) + wc * 32 + 8 * fq;
#pragma unroll
            for (int ai = 0; ai < 2; ++ai)
#pragma unroll
                for (int m = 0; m < 4; ++m) { const int row = row0 + ai * HALF + m * 16; const float rs = rsv[ai][m]; unsigned short* rowp = proj + (size_t)row * 1536 + col0;
#pragma unroll
                    for (int bj = 0; bj < 2; ++bj) { const f32x4 v0 = acc[ai][bj][m][0] * rs, v1 = acc[ai][bj][m][1] * rs;
                        u32x4 w; w.x = cvt_pk_bf16(v0[0], v0[1]); w.y = cvt_pk_bf16(v0[2], v0[3]); w.z = cvt_pk_bf16(v1[0], v1[1]); w.w = cvt_pk_bf16(v1[2], v1[3]);
                        *(u32x4*)(rowp + bj * HALF) = w; } }
        }
    }
};
struct EpiOut {
    static constexpr bool PERM = true, AFTER_DRAIN = false;
    const unsigned short* xb; unsigned short* hb; unsigned char* hb8; float* ssq2;
    __device__ __forceinline__ void operator()(const f32x4 (&acc)[2][2][4][2], const Unit& u, int wr, int wc, int fr, int fq) const {
        const int row0 = u.pm * BM + wr * 64 + fr, col0 = u.pn * BM + wc * 32 + 8 * fq;
        const int col8 = u.pn * BM + (fq & 1) * HALF + wc * 32 + (fq >> 1) * 16;
#pragma unroll
        for (int ai = 0; ai < 2; ++ai) {
            float ssv[4];
            u32x4 xr[4][2];
#pragma unroll
            for (int m = 0; m < 4; ++m)
#pragma unroll
                for (int bj = 0; bj < 2; ++bj) xr[m][bj] = *(const u32x4*)(xb + (size_t)(row0 + ai * HALF + m * 16) * 1024 + col0 + bj * HALF);
#pragma unroll
            for (int m = 0; m < 4; ++m) { const int row = row0 + ai * HALF + m * 16; const size_t o = (size_t)row * 1024 + col0; float ss = 0.f;
                unsigned q8[2][2];
#pragma unroll
                for (int bj = 0; bj < 2; ++bj) { f32x4 a = acc[ai][bj][m][0], b = acc[ai][bj][m][1]; const u32x4 x = xr[m][bj];
                    a[0] += lo_bf(x.x); a[1] += hi_bf(x.x); a[2] += lo_bf(x.y); a[3] += hi_bf(x.y);
                    b[0] += lo_bf(x.z); b[1] += hi_bf(x.z); b[2] += lo_bf(x.w); b[3] += hi_bf(x.w);
                    u32x4 w; w.x = cvt_pk_bf16(a[0], a[1]); w.y = cvt_pk_bf16(a[2], a[3]); w.z = cvt_pk_bf16(b[0], b[1]); w.w = cvt_pk_bf16(b[2], b[3]);
                    *(u32x4*)(hb + o + bj * HALF) = w;
                    q8[bj][0] = pack4_fp8(a[0] * SC_H8, a[1] * SC_H8, a[2] * SC_H8, a[3] * SC_H8); q8[bj][1] = pack4_fp8(b[0] * SC_H8, b[1] * SC_H8, b[2] * SC_H8, b[3] * SC_H8);
                    ss += a[0] * a[0] + a[1] * a[1] + a[2] * a[2] + a[3] * a[3] + b[0] * b[0] + b[1] * b[1] + b[2] * b[2] + b[3] * b[3]; }
                swap16(q8[0][0], q8[1][0]); swap16(q8[0][1], q8[1][1]);
                u32x4 w8; w8.x = q8[0][0]; w8.y = q8[0][1]; w8.z = q8[1][0]; w8.w = q8[1][1];
                *(u32x4*)(hb8 + (size_t)row * 1024 + col8) = w8;
                ss += __shfl_xor(ss, 16); ss += __shfl_xor(ss, 32);
                ssv[m] = ss; }
            { const float v = fq == 0 ? ssv[0] : (fq == 1 ? ssv[1] : (fq == 2 ? ssv[2] : ssv[3]));
              ssq2[(size_t)(row0 + ai * HALF + fq * 16) * 16 + u.pn * 4 + wc] = v; }
        }
    }
};
template <class Epi, class Sched, bool STAMP = false>
__device__ __forceinline__ void gemm_phase(PG8_LAS unsigned char* lds, const Gemm g, const Sched& S, const Epi& E, unsigned long long* stamps) {
    const int tid = tid_fresh(), wid = __builtin_amdgcn_readfirstlane(tid >> 6), lane = tid & 63, wr = wid >> 2, wc = wid & 3, fr = lane & 15, fq = lane >> 4;
    const int K = g.K, nt = K / BK;
    int ts_lo = 0, ts_hi = 0, nts = 0; const unsigned long long rt_entry = STAMP ? (unsigned long long)wall_clock64() : 0ull;
#define PG8_STAMP() do { if (STAMP && wid == 0 && nts < 64) { const unsigned long long _c = (unsigned long long)clock64(); \
        ts_lo = (lane == nts) ? (int)(unsigned)_c : ts_lo; ts_hi = (lane == nts) ? (int)(unsigned)(_c >> 32) : ts_hi; ++nts; } } while (0)
    PG8_STAMP();
    unsigned voffA[2], voffB[2];
#pragma unroll
    for (int i = 0; i < 2; ++i) { int R, C; stage_rc(tid * 16 + i * 8192, R, C); const int Rb = Epi::PERM ? ((R & ~31) + perm32(R & 31)) : R;
        voffA[i] = (unsigned)(R * K + C) * 2u; voffB[i] = (unsigned)(Rb * K + C) * 2u; }
    const size_t kstep = (size_t)(BK * 2);
    const size_t hstep = (size_t)HALF * K * 2;
    const size_t tstep = 2 * hstep;
    const unsigned ldsw = (unsigned)wid * 1024u;
    const int aoff = lds_byte(wr * 64 + fr, fq * 8), boff = lds_byte(wc * 32 + fr, fq * 8);
#define PG8_SA(b, h) (((b) * 2 + (h)) * HTB)
#define PG8_SB(b, h) ((4 + (b) * 2 + (h)) * HTB)
#define PG8_STAGE(bufoff, gbase, voff) do { _Pragma("unroll") for (int _i = 0; _i < 2; ++_i) \
        __builtin_amdgcn_global_load_lds((const unsigned*)((const char*)(gbase) + (voff)[_i]), (PG8_LAS unsigned*)(lds + (bufoff) + ldsw + _i * 8192), 16, 0, 0); } while (0)
#define PG8_LDA(dst, b, h) do { _Pragma("unroll") for (int m = 0; m < 4; ++m) _Pragma("unroll") for (int k = 0; k < 2; ++k) dst[m][k] = *(const PG8_LAS bf16x8*)(lds + PG8_SA(b, h) + aoff + m * 2048 + k * 1024); } while (0)
#define PG8_LDB(dst, b, h) do { _Pragma("unroll") for (int n = 0; n < 2; ++n) _Pragma("unroll") for (int k = 0; k < 2; ++k) dst[n][k] = *(const PG8_LAS bf16x8*)(lds + PG8_SB(b, h) + boff + n * 2048 + k * 1024); } while (0)
#define PG8_MMA(ai, bj, At, Bt) do { __builtin_amdgcn_s_setprio(1); _Pragma("unroll") for (int m = 0; m < 4; ++m) _Pragma("unroll") for (int n = 0; n < 2; ++n) _Pragma("unroll") for (int k = 0; k < 2; ++k) \
        acc[ai][bj][m][n] = __builtin_amdgcn_mfma_f32_16x16x32_bf16(Bt[n][k], At[m][k], acc[ai][bj][m][n], 0, 0, 0); __builtin_amdgcn_s_setprio(0); } while (0)
#define PG8_WAIT_V(n) asm volatile("s_waitcnt vmcnt(" #n ")" ::: "memory")
#define PG8_WAIT_L(n) asm volatile("s_waitcnt lgkmcnt(" #n ")" ::: "memory")
#define PG8_BAR __builtin_amdgcn_s_barrier()
#define PG8_SCHED __builtin_amdgcn_sched_barrier(0)
    Unit cur, nxt; int ui = 0;
    if (!S.next(0, cur)) return;
    f32x4 acc[2][2][4][2];
#pragma unroll
    for (int a = 0; a < 2; ++a)
#pragma unroll
        for (int b = 0; b < 2; ++b)
#pragma unroll
            for (int m = 0; m < 4; ++m)
#pragma unroll
                for (int n = 0; n < 2; ++n) acc[a][b][m][n] = (f32x4){0.f, 0.f, 0.f, 0.f};
    bf16x8 At[4][2], B0[2][2], B1[2][2];
    const char* cA = (const char*)g.A + (size_t)cur.pm * tstep; const char* cB = (const char*)g.Bt + (size_t)cur.pn * tstep;
    S.a_ready(cur);
    PG8_STAGE(PG8_SB(0, 0), cB, voffB); PG8_STAGE(PG8_SA(0, 0), cA, voffA); PG8_STAGE(PG8_SB(0, 1), cB + hstep, voffB); PG8_STAGE(PG8_SA(0, 1), cA + hstep, voffA);
    if (wr == 1) PG8_BAR;
    PG8_WAIT_V(4); PG8_BAR;
    PG8_STAGE(PG8_SB(1, 0), cB + kstep, voffB); PG8_STAGE(PG8_SA(1, 0), cA + kstep, voffA); PG8_STAGE(PG8_SB(1, 1), cB + hstep + kstep, voffB);
    PG8_WAIT_V(6); PG8_BAR;
    PG8_STAMP();
    for (;;) {
        const bool has_next = S.next(ui + 1, nxt);
        const char* nA = has_next ? (const char*)g.A + (size_t)nxt.pm * tstep : cA; const char* nB = has_next ? (const char*)g.Bt + (size_t)nxt.pn * tstep : cB;
        for (int t = 0; t < nt; t += 2) {
            const bool last = (t == nt - 2);
            const char* a1 = cA + (size_t)(t + 1) * kstep;
            const char* a2 = last ? nA : cA + (size_t)(t + 2) * kstep; const char* b2 = last ? nB : cB + (size_t)(t + 2) * kstep;
            const char* a3 = a2 + kstep; const char* b3 = b2 + kstep;
            if (last && has_next) S.a_ready(nxt);
            PG8_LDB(B0, 0, 0); PG8_SCHED; PG8_LDA(At, 0, 0); PG8_STAGE(PG8_SA(1, 1), a1 + hstep, voffA);
            PG8_WAIT_L(8); PG8_BAR; PG8_WAIT_L(0); PG8_MMA(0, 0, At, B0); PG8_BAR; PG8_SCHED;
            PG8_LDB(B1, 0, 1); PG8_STAGE(PG8_SB(0, 0), b2, voffB);
            PG8_BAR; PG8_WAIT_L(0); PG8_MMA(0, 1, At, B1); PG8_BAR;
            PG8_LDA(At, 0, 1); PG8_STAGE(PG8_SA(0, 0), a2, voffA);
            PG8_BAR; PG8_WAIT_L(0); PG8_MMA(1, 0, At, B0); PG8_BAR; PG8_SCHED;
            PG8_STAGE(PG8_SB(0, 1), b2 + hstep, voffB);
            PG8_WAIT_V(6); PG8_BAR; PG8_MMA(1, 1, At, B1); PG8_BAR;
            PG8_LDB(B0, 1, 0); PG8_SCHED; PG8_LDA(At, 1, 0); PG8_STAGE(PG8_SA(0, 1), a2 + hstep, voffA);
            PG8_WAIT_L(8); PG8_BAR; PG8_WAIT_L(0); PG8_MMA(0, 0, At, B0); PG8_BAR; PG8_SCHED;
            PG8_LDB(B1, 1, 1); PG8_STAGE(PG8_SB(1, 0), b3, voffB);
            PG8_BAR; PG8_WAIT_L(0); PG8_MMA(0, 1, At, B1); PG8_BAR;
            PG8_LDA(At, 1, 1); PG8_STAGE(PG8_SA(1, 0), a3, voffA);
            PG8_BAR; PG8_WAIT_L(0); PG8_MMA(1, 0, At, B0); PG8_BAR; PG8_SCHED;
            PG8_STAGE(PG8_SB(1, 1), b3 + hstep, voffB);
            PG8_WAIT_V(6); PG8_BAR; PG8_MMA(1, 1, At, B1); PG8_BAR;
        }
        PG8_STAMP();
        if constexpr (!Epi::AFTER_DRAIN) { E(acc, cur, wr, wc, fr, fq); S.done(cur); }
        PG8_STAMP();
        if (!has_next) break;
#pragma unroll
        for (int a = 0; a < 2; ++a)
#pragma unroll
            for (int b = 0; b < 2; ++b)
#pragma unroll
                for (int m = 0; m < 4; ++m)
#pragma unroll
                    for (int n = 0; n < 2; ++n) acc[a][b][m][n] = (f32x4){0.f, 0.f, 0.f, 0.f};
        cur = nxt; cA = nA; cB = nB; ++ui;
    }
    PG8_WAIT_V(0);
    if (wr == 0) PG8_BAR;
    PG8_BAR;
    if constexpr (Epi::AFTER_DRAIN) { E.fused(acc, cur, wr, wc, fr, fq, lds, wid, lane); S.done(cur); }
    PG8_STAMP();
    if (STAMP && wid == 0) { stamps[lane] = lane < nts ? (((unsigned long long)(unsigned)ts_hi << 32) | (unsigned)ts_lo) : 0ull;
        if (lane == 62) stamps[62] = rt_entry; if (lane == 63) stamps[63] = (unsigned long long)wall_clock64(); }
#undef PG8_STAMP
#undef PG8_SA
#undef PG8_SB
#undef PG8_STAGE
#undef PG8_LDA
#undef PG8_LDB
#undef PG8_MMA
#undef PG8_WAIT_V
#undef PG8_WAIT_L
#undef PG8_BAR
#undef PG8_SCHED
}
}

struct P1Desc {
    static constexpr bool FP8 = false;
    struct U { int mt, nt; };
    struct R { float rs[4]; };
    const char* xb; const char* w; bf16_t* proj; const float* rstd1; int bid, nb;
    __device__ __forceinline__ bool get(int i, U& u) const { const int uu = i * nb + bid; if (uu >= 2048) return false;
        const int g = uu >> 8, b = uu & 255, xcd = b & 7, j = b >> 3; u.mt = g * 16 + (xcd >> 1) * 4 + (j >> 3); u.nt = (xcd & 1) * 8 + (j & 7); return true; }
    __device__ __forceinline__ int nk() const { return 16; }
    __device__ __forceinline__ unsigned aoff(const U& u, int row) const { return (unsigned)(u.mt * 256 + row) * 2048u; }
    __device__ __forceinline__ unsigned boff(const U& u, int rho) const { return (unsigned)(u.nt * 128 + perm_row<4>(rho)) * 2048u; }
    __device__ __forceinline__ const char* abase(const U&, int kt) const { return xb + kt * 128; }
    __device__ __forceinline__ const char* bbase(const U&, int kt) const { return w + kt * 128; }
    __device__ __forceinline__ void* sink() const { return (void*)proj; }
    template <class Acc> __device__ __forceinline__ void init(const U& u, Acc& acc, R& r, int wr, int wc, int fr, int fq) const {
#pragma unroll
        for (int m = 0; m < 4; ++m) { r.rs[m] = rstd1[u.mt * 256 + wr * 64 + m * 16 + fr];
#pragma unroll
            for (int n = 0; n < 4; ++n) acc[m][n] = (f32x4){0.f, 0.f, 0.f, 0.f}; }
    }
    template <class Acc> __device__ __forceinline__ void epi(const U& u, Acc& acc, const R& r, int wr, int wc, int fr, int fq) const {
        const int col = u.nt * 128 + wc * 64 + fq * 16;
#pragma unroll
        for (int m = 0; m < 4; ++m) { const int row = u.mt * 256 + wr * 64 + m * 16 + fr; const float rs = r.rs[m];
            bf16_t* dst = proj + (size_t)row * NP + col;
#pragma unroll
            for (int h = 0; h < 2; ++h) { const f32x4 a = acc[m][2 * h] * rs, b = acc[m][2 * h + 1] * rs;
                *(uint4*)(dst + 8 * h) = make_uint4(pack2(a[0], a[1]), pack2(a[2], a[3]), pack2(b[0], b[1]), pack2(b[2], b[3])); } }
    }
};
template <int MODE = 0> __device__ __forceinline__ void phase1(const Params& p, LAS unsigned char* lds, int bid, int nb) {
    pg8::Gemm g; g.A = (const pg8::bf16_t*)(p.ws + OFF_A); g.Bt = (const pg8::bf16_t*)(p.ws + OFF_WIN); g.M = T; g.N = NG; g.K = D;
    pg8::StaticOrder S; S.init(T, NG, nb, bid);
    pg8::EpiProj E; E.proj = (unsigned short*)(p.ws + OFF_B); E.rstd = (const float*)(p.ws + OFF_RSTD1);
    pg8::gemm_phase<pg8::EpiProj, pg8::StaticOrder>(lds, g, S, E, nullptr);
}
struct P3Desc {
    static constexpr bool FP8 = false;
    __device__ __forceinline__ void* sink() const { return (void*)hb; }
    struct U { int mt, nt; };
    struct R { int dummy; };
    const char* y; const char* w; const bf16_t* xb; bf16_t* hb; unsigned char* hb8; float* ssq2; int bid, nb;
    __device__ __forceinline__ bool get(int i, U& u) const { const int uu = i * nb + bid; if (uu >= 1024) return false;
        const int g = uu >> 8, b = uu & 255, xcd = b & 7, j = b >> 3; u.mt = g * 32 + xcd * 4 + (j >> 3); u.nt = j & 7; return true; }
    __device__ __forceinline__ int nk() const { return 16; }
    __device__ __forceinline__ unsigned aoff(const U& u, int row) const { return (unsigned)(u.mt * 256 + row) * 2048u; }
    __device__ __forceinline__ unsigned boff(const U& u, int rho) const { return (unsigned)(u.nt * 128 + perm_row<4>(rho)) * 2048u; }
    __device__ __forceinline__ const char* abase(const U&, int kt) const { return y + kt * 128; }
    __device__ __forceinline__ const char* bbase(const U&, int kt) const { return w + kt * 128; }
    template <class Acc> __device__ __forceinline__ void init(const U& u, Acc& acc, R& r, int wr, int wc, int fr, int fq) const {
        const int col = u.nt * 128 + wc * 64 + fq * 16;
#pragma unroll
        for (int m = 0; m < 4; ++m) { const size_t o = (size_t)(u.mt * 256 + wr * 64 + m * 16 + fr) * D + col;
#pragma unroll
            for (int h = 0; h < 2; ++h) { const uint4 xr = *(const uint4*)(xb + o + 8 * h);
                acc[m][2 * h] = (f32x4){lo_bf(xr.x), hi_bf(xr.x), lo_bf(xr.y), hi_bf(xr.y)}; acc[m][2 * h + 1] = (f32x4){lo_bf(xr.z), hi_bf(xr.z), lo_bf(xr.w), hi_bf(xr.w)}; } }
    }
    template <class Acc> __device__ __forceinline__ void epi(const U& u, Acc& acc, const R& r, int wr, int wc, int fr, int fq) const {
        const int col = u.nt * 128 + wc * 64 + fq * 16;
#pragma unroll
        for (int m = 0; m < 4; ++m) { const int row = u.mt * 256 + wr * 64 + m * 16 + fr; const size_t o = (size_t)row * D + col; float ss = 0.f;
            *(uint4*)(hb8 + o) = make_uint4(pack4_fp8(acc[m][0][0] * SC_H8, acc[m][0][1] * SC_H8, acc[m][0][2] * SC_H8, acc[m][0][3] * SC_H8), pack4_fp8(acc[m][1][0] * SC_H8, acc[m][1][1] * SC_H8, acc[m][1][2] * SC_H8, acc[m][1][3] * SC_H8),
                                            pack4_fp8(acc[m][2][0] * SC_H8, acc[m][2][1] * SC_H8, acc[m][2][2] * SC_H8, acc[m][2][3] * SC_H8), pack4_fp8(acc[m][3][0] * SC_H8, acc[m][3][1] * SC_H8, acc[m][3][2] * SC_H8, acc[m][3][3] * SC_H8));
#pragma unroll
            for (int h = 0; h < 2; ++h) { const f32x4 a = acc[m][2 * h], b = acc[m][2 * h + 1];
                *(uint4*)(hb + o + 8 * h) = make_uint4(pack2(a[0], a[1]), pack2(a[2], a[3]), pack2(b[0], b[1]), pack2(b[2], b[3]));
                ss += a[0] * a[0] + a[1] * a[1] + a[2] * a[2] + a[3] * a[3] + b[0] * b[0] + b[1] * b[1] + b[2] * b[2] + b[3] * b[3]; }
            ss += __shfl_xor(ss, 16); ss += __shfl_xor(ss, 32);
            if (fq == 0) ssq2[(size_t)row * 16 + u.nt * 2 + wc] = ss; }
    }
};
__device__ __forceinline__ void phase3(const Params& p, LAS unsigned char* lds, int bid, int nb) {
    pg8::Gemm g; g.A = (const pg8::bf16_t*)(p.ws + OFF_C); g.Bt = (const pg8::bf16_t*)(p.ws + OFF_WOUT); g.M = T; g.N = D; g.K = D;
    pg8::StaticOrder S; S.init(T, D, nb, bid);
    pg8::EpiOut E; E.xb = (const unsigned short*)(p.ws + OFF_A); E.hb = (unsigned short*)(p.ws + OFF_H); E.hb8 = p.ws + OFF_H8; E.ssq2 = (float*)(p.ws + OFF_SSQ2);
    pg8::gemm_phase<pg8::EpiOut, pg8::StaticOrder>(lds, g, S, E, nullptr);
}
struct P4Desc {
    static constexpr bool FP8 = false;
    __device__ __forceinline__ void* sink() const { return (void*)ws; }
    struct U { int u; };
    struct R { int dummy; };
    template <class Acc> __device__ __forceinline__ void init(const U&, Acc& acc, R&, int, int, int, int) const {
#pragma unroll
        for (int n = 0; n < 4; ++n) acc[0][n] = (f32x4){0.f, 0.f, 0.f, 0.f}; }
    const char* hb; const char* w; const float* ssq2; unsigned char* ws; LAS unsigned char* lds; int bid, nb;
    __device__ __forceinline__ bool get(int i, U& u) const { u.u = i * nb + bid; return u.u < 256; }
    __device__ __forceinline__ int nk() const { return 16; }
    __device__ __forceinline__ unsigned aoff(const U& u, int row) const { return (unsigned)(u.u * 128 + row) * 2048u; }
    __device__ __forceinline__ unsigned boff(const U&, int rho) const { return (unsigned)rho * 2048u; }
    __device__ __forceinline__ const char* abase(const U&, int kt) const { return hb + kt * 128; }
    __device__ __forceinline__ const char* bbase(const U&, int kt) const { return w + kt * 128; }
    template <class Acc> __device__ __forceinline__ void epi(const U& uu, Acc& acc, const R&, int wr, int wc, int fr, int fq) const {
        LAS int* hist = (LAS int*)(lds + LDS_MISC);
        LAS int* base = (LAS int*)(lds + LDS_MISC + 1024);
        LAS float* lg = (LAS float*)(lds + 65536);
        int* cnt = (int*)(ws + OFF_CNT); int* el = (int*)(ws + OFF_EL); int* pl = (int*)(ws + OFF_PL);
        __syncthreads();
#pragma unroll
        for (int n = 0; n < 4; ++n)
#pragma unroll
            for (int j = 0; j < 4; ++j) { const int col = n * 16 + fq * 4 + j; if (col < 36) lg[(wr * 16 + fr) * 37 + col] = acc[0][n][j]; }
        if (threadIdx.x < 144) hist[threadIdx.x] = 0;
        __syncthreads();
        const int t = tid_fresh(), r = uu.u * 128 + t;
        int e0 = 0, e1 = 0, bucket = 0, r0 = 0, r1 = 0, rb = 0; float ga = 0.f, gb = 0.f, rstd2 = 0.f;
        if (t < 128) { const float* q = ssq2 + (size_t)r * 16; float ss = 0.f;
#pragma unroll
            for (int j = 0; j < 16; ++j) ss += q[j];
            rstd2 = rsqrtf(ss * (1.0f / D) + EPS);
            const LAS float* mine = lg + t * 37;
            int gs = 0; float gm = mine[0];
#pragma unroll
            for (int j = 1; j < 4; ++j) { const float v = mine[j]; if (v > gm) { gm = v; gs = j; } }
            float den = 0.f;
#pragma unroll
            for (int j = 0; j < 4; ++j) den += __expf((mine[j] - gm) * rstd2);
            const float g1 = 1.0f / den;
            const LAS float* le = mine + 4 + gs * 8;
            int i0 = 0; float l0 = le[0];
#pragma unroll
            for (int j = 1; j < 8; ++j) { const float v = le[j]; if (v > l0) { l0 = v; i0 = j; } }
            int i1 = -1; float l1 = -3.0e38f;
#pragma unroll
            for (int j = 0; j < 8; ++j) { const float v = le[j]; if (j != i0 && v > l1) { l1 = v; i1 = j; } }
            const float w0 = 1.0f / (1.0f + __expf((l1 - l0) * rstd2)), w1 = 1.0f - w0;
            int a = i0, bb = i1; ga = g1 * w0; gb = g1 * w1;
            if (a > bb) { const int ti = a; a = bb; bb = ti; const float tf = ga; ga = gb; gb = tf; }
            e0 = gs * 8 + a; e1 = gs * 8 + bb; bucket = gs * 28 + pair_off(a) + (bb - a - 1);
            r0 = __hip_atomic_fetch_add(&hist[e0], 1, __ATOMIC_RELAXED, __HIP_MEMORY_SCOPE_WORKGROUP); r1 = __hip_atomic_fetch_add(&hist[e1], 1, __ATOMIC_RELAXED, __HIP_MEMORY_SCOPE_WORKGROUP);
            rb = __hip_atomic_fetch_add(&hist[32 + bucket], 1, __ATOMIC_RELAXED, __HIP_MEMORY_SCOPE_WORKGROUP); }
        __syncthreads();
        if (t < 144) { const int c = hist[t]; base[t] = c ? atomicAdd(&cnt[t], c) : 0; }
        __syncthreads();
        if (t < 128) { int4 rec; rec.x = e0 | (e1 << 8) | (bucket << 16); rec.y = __float_as_int(ga); rec.z = __float_as_int(gb); rec.w = __float_as_int(rstd2);
            float* ers = (float*)(ws + OFF_ERS);
            const size_t p0 = (size_t)e0 * T + base[e0] + r0, p1 = (size_t)e1 * T + base[e1] + r1;
            el[p0] = (r << 17) | (int)f2bf(ga); el[p1] = (r << 17) | (1 << 16) | (int)f2bf(gb); ers[p0] = rstd2; ers[p1] = rstd2;
            pl[(size_t)bucket * T + base[32 + bucket] + rb] = r; }
    }
};
__device__ __forceinline__ void phase4(const Params& p, LAS unsigned char* lds, int bid, int nb) {
    P4Desc d; d.hb = (const char*)(p.ws + OFF_H); d.w = (const char*)(p.ws + OFF_WR); d.ssq2 = (const float*)(p.ws + OFF_SSQ2); d.ws = p.ws; d.lds = lds; d.bid = bid; d.nb = nb;
    gemm_stream<CfgR>(lds, d);
}
__device__ __forceinline__ int wave_prefix128(int v0, int v1, int& ex0, int& ex1) {
    const int lane = threadIdx.x & 63; int s0 = v0, s1 = v1;
#pragma unroll
    for (int o = 1; o < 64; o <<= 1) { const int t0 = __shfl_up(s0, o), t1 = __shfl_up(s1, o); if (lane >= o) { s0 += t0; s1 += t1; } }
    const int tot0 = __shfl(s0, 63), tot1 = __shfl(s1, 63);
    ex0 = s0 - v0; ex1 = tot0 + s1 - v1; return tot0 + tot1;
}
template <int TMV>
struct P5aDescT {
    static constexpr bool FP8 = true;
    __device__ __forceinline__ void* sink() const { return (void*)act; }
    struct U { int e, row0, ntile, ce; };
    struct R { int ent[TMV]; float rs[TMV]; };
    const char* hb8; const char* wgu; unsigned char* act; const int* cnt; const int* el; const float* ers; LAS int* pre; int bid, nb;
    __device__ __forceinline__ bool get(int i, U& u) const {
        const int total = pre[NE], nfull = total / nb, rem = total - nfull * nb; const bool split = rem > 0 && 2 * rem <= nb;
        int uu, half = 0;
        if (TMV == 4) { if (i > nfull || (i == nfull && split)) return false; uu = i * nb + bid; if (uu >= total) return false; }
        else { if (i != 0 || !split || bid >= 2 * rem) return false; uu = nfull * nb + (bid >> 1); half = bid & 1; }
        const int ln = threadIdx.x & 63; const int e = __builtin_popcountll(__ballot(ln < NE && pre[ln + 1] <= uu));
        const int local = uu - pre[e]; u.e = e; u.row0 = (local >> 2) * 256 + half * 128; u.ntile = local & 3; u.ce = pre[40 + e]; return true; }
    __device__ __forceinline__ int nk() const { return 8; }
    __device__ __forceinline__ unsigned aoff(const U& u, int row) const { const int li = min(u.row0 + row, u.ce - 1); return ((unsigned)el[(size_t)u.e * T + li] >> 17) * 1024u; }
    __device__ __forceinline__ unsigned boff(const U& u, int rho) const {
        const int w = rho & 31, n2 = w >> 4, q = (w >> 2) & 3, j = w & 3;
        return (unsigned)(u.e * 512 + u.ntile * 128 + (rho & ~31) + q * 8 + n2 * 4 + j) * 1024u; }
    __device__ __forceinline__ const char* abase(const U&, int kt) const { return hb8 + kt * 128; }
    __device__ __forceinline__ const char* bbase(const U&, int kt) const { return wgu + kt * 128; }
    template <class Acc> __device__ __forceinline__ void init(const U& u, Acc& acc, R& r, int wr, int wc, int fr, int fq) const {
        const size_t lb = (size_t)u.e * T;
        const int lq = min(u.row0 + wr * (TMV * 16) + (fq % TMV) * 16 + fr, u.ce - 1);
        const int eq = el[lb + lq]; const float rq = ers[lb + lq];
#pragma unroll
        for (int m = 0; m < TMV; ++m) { r.ent[m] = __shfl(eq, fr + 16 * m); r.rs[m] = __shfl(rq, fr + 16 * m);
#pragma unroll
            for (int n = 0; n < 4; ++n) acc[m][n] = (f32x4){0.f, 0.f, 0.f, 0.f}; }
    }
    template <class Acc> __device__ __forceinline__ void epi(const U& u, Acc& acc, const R& r, int wr, int wc, int fr, int fq) const {
#pragma unroll
        for (int m = 0; m < TMV; ++m) { const unsigned ent = (unsigned)r.ent[m]; const int tok = ent >> 17, slot = (ent >> 16) & 1;
            const float gate = __uint_as_float(ent << 16) * SC_ACT, rs = r.rs[m] * (1.0f / (SC_H8 * SC_WGU));
            float a[8];
#pragma unroll
            for (int n = 0; n < 2; ++n)
#pragma unroll
                for (int j = 0; j < 4; ++j) { const float G = acc[m][n][j] * rs, Uv = acc[m][n + 2][j] * rs; a[n * 4 + j] = G * __builtin_amdgcn_rcpf(1.0f + __expf(-G)) * Uv * gate; }
            *(uint2*)(act + (size_t)tok * 512 + slot * 256 + u.ntile * 64 + wc * 32 + fq * 8) = make_uint2(pack4_fp8(a[0], a[1], a[2], a[3]), pack4_fp8(a[4], a[5], a[6], a[7])); }
    }
};
typedef P5aDescT<4> P5aDesc;
typedef GemmCfg<4, 2, 2, 4, 64, 3> CfgA2;
template <int MODE = 0> __device__ __forceinline__ void phase5a(const Params& p, LAS unsigned char* lds, int bid, int nb) {
    P5aDesc d; d.hb8 = (const char*)(p.ws + OFF_H8); d.wgu = (const char*)(p.ws + OFF_WGU); d.act = p.ws + OFF_B; d.cnt = (const int*)(p.ws + OFF_CNT);
    d.el = (const int*)(p.ws + OFF_EL); d.ers = (const float*)(p.ws + OFF_ERS); d.pre = (LAS int*)(lds + LDS_MISC); d.bid = bid; d.nb = nb;
    __syncthreads();
    if (threadIdx.x < 64) { const int ln = threadIdx.x; const int c = ln < NE ? d.cnt[ln] : 0; int ex0, ex1; const int tot = wave_prefix128(((c + 255) >> 8) * 4, 0, ex0, ex1);
        if (ln < NE) { d.pre[ln] = ex0; d.pre[40 + ln] = c; } if (ln == 0) d.pre[NE] = tot; }
    __syncthreads();
    gemm_stream3<CfgA, P5aDesc, MODE>(lds, d);
    { P5aDescT<2> d2; d2.hb8 = d.hb8; d2.wgu = d.wgu; d2.act = d.act; d2.cnt = d.cnt; d2.el = d.el; d2.ers = d.ers; d2.pre = d.pre; d2.bid = bid; d2.nb = nb;
      gemm_stream3<CfgA2, P5aDescT<2>, MODE>(lds, d2); }
}
template <int MODE = 0>
__device__ __forceinline__ void phase5b(const Params& p, LAS unsigned char* lds, int bid, int nb, float* dst) {
    constexpr int A_BYTES = 64 * 128, B_BYTES = 512 * 128, ST = A_BYTES + B_BYTES;
    const char* act = (const char*)(p.ws + OFF_B); const char* wd = (const char*)(p.ws + OFF_WD);
    const int* cnt = (const int*)(p.ws + OFF_CNT) + 32; const int* pl = (const int*)(p.ws + OFF_PL); const bf16_t* hb = (const bf16_t*)(p.ws + OFF_H);
    LAS int* pre = (LAS int*)(lds + LDS_MISC); LAS float* red = (LAS float*)(lds + LDS_MISC + 1024); LAS float* fn = (LAS float*)(lds + LDS_MISC + 4096);
    const int tid = tid_fresh(), wid = __builtin_amdgcn_readfirstlane(tid >> 6), lane = tid & 63, wc = wid, fr = lane & 15, fq = lane >> 4;
    __syncthreads();
    fn[tid] = p.final_norm[tid]; fn[tid + 512] = p.final_norm[tid + 512];
    if (tid < 64) { const int c0 = cnt[tid], c1 = (tid + 64 < NBUCK) ? cnt[tid + 64] : 0; int ex0, ex1; const int tot = wave_prefix128((c0 + 63) >> 6, (c1 + 63) >> 6, ex0, ex1);
        pre[tid] = ex0; pre[128 + tid] = c0; if (tid + 64 < NBUCK) { pre[tid + 64] = ex1; pre[128 + tid + 64] = c1; } if (tid == 0) pre[NBUCK] = tot; }
    __syncthreads();
    const int total = pre[NBUCK];
    struct U { int b, mtile, cb, e0, e1, hm, j; };
    const int nfull = total / nb, rem = total - nfull * nb; const bool split = rem > 0 && 2 * rem <= nb;
    auto get = [&](int i, U& u) -> bool {
        int uu;
        if (i < nfull) { uu = i * nb + bid; u.hm = 3; u.j = 0; }
        else if (i == nfull && split) { if (bid >= 2 * rem) return false; uu = nfull * nb + (bid >> 1); u.hm = 1 << (bid & 1); u.j = bid >> 1; }
        else if (i == nfull) { uu = i * nb + bid; if (uu >= total) return false; u.hm = 3; u.j = 0; }
        else return false;
        const int ln = threadIdx.x & 63; const int b = __builtin_popcountll(__ballot(pre[ln + 1] <= uu)) + __builtin_popcountll(__ballot(ln + 64 < NBUCK && pre[ln + 65] <= uu));
        u.b = b; u.mtile = uu - pre[b]; u.cb = pre[128 + b]; const int g = b / 28, pi = b % 28;
        int a = 0;
#pragma unroll
        for (int q = 1; q < 7; ++q) a += (pair_off(q) <= pi) ? 1 : 0;
        u.e0 = g * 8 + a; u.e1 = g * 8 + a + 1 + (pi - pair_off(a)); return true; };
    U us, uc; int is = 0, ts = 0;
    bool more = get(0, us);
    if (!more) return;
    ts = (us.hm == 2) ? 4 : 0;
    unsigned offA, offB[8];
    {
#pragma unroll
        for (int i = 0; i < 8; ++i) { const int rho = (wid + 8 * i) * 8 + (lane >> 3); offB[i] = (unsigned)rho * 256u + (unsigned)swz_slot<64>(rho, lane & 7) * 16u; }
    }
    auto set_a = [&](const U& u) { const int row = wid * 8 + (lane >> 3), li = min(u.mtile * 64 + row, u.cb - 1);
        offA = (unsigned)pl[(size_t)u.b * T + li] * 512u + (unsigned)swz_slot<64>(row, lane & 7) * 16u; };
    set_a(us);
    int sbuf = 0;
    auto stage_next = [&]() {
        if (!more) return;
        const int nh = ts >> 2, kt = ts & 3;
        const char* ab = act + kt * 128;
        const char* bb = wd + (size_t)(kt < 2 ? us.e0 : us.e1) * (D * DE) + (kt & 1) * 128 + (size_t)nh * (512 * 256);
        LAS unsigned char* sa = lds + sbuf;
        if (!(MODE & 4)) {
        __builtin_amdgcn_global_load_lds((const unsigned*)(ab + offA), (LAS unsigned*)(sa + wid * 1024), 16, 0, 0);
#pragma unroll
        for (int i = 0; i < 8; ++i) __builtin_amdgcn_global_load_lds((const unsigned*)(bb + offB[i]), (LAS unsigned*)(sa + A_BYTES + (wid + 8 * i) * 1024), 16, 0, 0);
        }
        sbuf ^= ST;
        if (++ts == ((us.hm == 1) ? 4 : 8)) { ++is; more = get(is, us); if (more) { set_a(us); ts = (us.hm == 2) ? 4 : 0; } }
    };
    int aread[2], bread[2];
#pragma unroll
    for (int ks = 0; ks < 2; ++ks) { aread[ks] = fr * 128 + swz_slot<64>(fr, ks * 4 + fq) * 16; bread[ks] = A_BYTES + (wc * 64 + fr) * 128 + swz_slot<64>(fr, ks * 4 + fq) * 16; }
    f32x4 acc[2][4][4];
    int tok[4];
    __syncthreads();
    stage_next();
    int cbuf = 0;
    for (int ic = 0; get(ic, uc); ++ic) {
        {
            const int* list = pl + (size_t)uc.b * T;
#pragma unroll
            for (int m = 0; m < 4; ++m) tok[m] = list[min(uc.mtile * 64 + m * 16 + fr, uc.cb - 1)];
#pragma unroll
            for (int nh = 0; nh < 2; ++nh) {
                if (uc.hm & (1 << nh)) {
#pragma unroll
                    for (int m = 0; m < 4; ++m) { const bf16_t* hr = hb + (size_t)tok[m] * D + nh * 512 + wc * 64 + (fq & 1) * 16 + (fq >> 1) * 8;
#pragma unroll
                        for (int pr = 0; pr < 2; ++pr) { uint4 xr = *(const uint4*)(hr + pr * 32);
                            swap16(xr.x, xr.z); swap16(xr.y, xr.w);
                            acc[nh][m][2 * pr] = (f32x4){lo_bf(xr.x), hi_bf(xr.x), lo_bf(xr.y), hi_bf(xr.y)} * (SC_ACT * SC_WD);
                            acc[nh][m][2 * pr + 1] = (f32x4){lo_bf(xr.z), hi_bf(xr.z), lo_bf(xr.w), hi_bf(xr.w)} * (SC_ACT * SC_WD); } }
                } else {
#pragma unroll
                    for (int m = 0; m < 4; ++m)
#pragma unroll
                        for (int n = 0; n < 4; ++n) acc[nh][m][n] = (f32x4){0.f, 0.f, 0.f, 0.f};
                }
            }
        }
#pragma unroll
        for (int nh = 0; nh < 2; ++nh)
        if (uc.hm & (1 << nh))
#pragma nounroll
        for (int kt4 = 0; kt4 < 4; ++kt4) {
            asm volatile("s_waitcnt vmcnt(0)" ::: "memory");
            __builtin_amdgcn_s_barrier();
            asm volatile("" ::: "memory");
            stage_next();
            if (!(MODE & 2)) {
            const LAS unsigned char* sa = lds + cbuf;
            {
                i32x8 af[4];
#pragma unroll
                for (int m = 0; m < 4; ++m) af[m] = cat8(*(const LAS bf16x8*)(sa + aread[0] + m * 16 * 128), *(const LAS bf16x8*)(sa + aread[1] + m * 16 * 128));
#pragma unroll
                for (int np = 0; np < 2; ++np) {
                    i32x8 bfr[2];
#pragma unroll
                    for (int n = 0; n < 2; ++n) bfr[n] = cat8(*(const LAS bf16x8*)(sa + bread[0] + (np * 2 + n) * 16 * 128), *(const LAS bf16x8*)(sa + bread[1] + (np * 2 + n) * 16 * 128));
#pragma unroll
                    for (int m = 0; m < 4; ++m)
#pragma unroll
                        for (int n = 0; n < 2; ++n) acc[nh][m][np * 2 + n] = MFMA_F8_K128(bfr[n], af[m], acc[nh][m][np * 2 + n]);
                }
            }
            }
            cbuf ^= ST;
        }
        if (!(MODE & 1)) {
            constexpr float inv = 1.0f / (SC_ACT * SC_WD);
#pragma unroll
            for (int m = 0; m < 4; ++m) { float ss = 0.f;
#pragma unroll
                for (int nh = 0; nh < 2; ++nh)
#pragma unroll
                    for (int n = 0; n < 4; ++n) { acc[nh][m][n] *= inv; ss += acc[nh][m][n][0] * acc[nh][m][n][0] + acc[nh][m][n][1] * acc[nh][m][n][1] + acc[nh][m][n][2] * acc[nh][m][n][2] + acc[nh][m][n][3] * acc[nh][m][n][3]; }
                ss += __shfl_xor(ss, 16); ss += __shfl_xor(ss, 32);
                if (fq == 0) red[(m * 16 + fr) * 8 + wc] = ss; }
            __syncthreads();
            float ssr[4];
#pragma unroll
            for (int m = 0; m < 4; ++m) { float ss = 0.f;
#pragma unroll
                for (int w8 = 0; w8 < 8; ++w8) ss += red[(m * 16 + fr) * 8 + w8];
                ssr[m] = ss; }
            if (uc.hm != 3) {
                float* xch = (float*)(p.ws + OFF_RT) + (size_t)uc.j * 128; unsigned* flag = (unsigned*)(p.ws + OFF_BAR + 15360) + uc.j; const int hf = uc.hm >> 1;
                if (wid == 0 && fq == 0) {
#pragma unroll
                    for (int m = 0; m < 4; ++m) __hip_atomic_store(xch + hf * 64 + m * 16 + fr, ssr[m], __ATOMIC_RELAXED, __HIP_MEMORY_SCOPE_AGENT);
                }
                asm volatile("s_waitcnt vmcnt(0)" ::: "memory");
                __syncthreads();
                if (tid == 0) __hip_atomic_fetch_add(flag, 1u, __ATOMIC_RELAXED, __HIP_MEMORY_SCOPE_AGENT);
                if (wid == 0) { unsigned sp = 0;
                    while ((unsigned)__builtin_amdgcn_readfirstlane(__hip_atomic_load(flag, __ATOMIC_RELAXED, __HIP_MEMORY_SCOPE_AGENT)) < 2u && ++sp < (1u << 22)) __builtin_amdgcn_s_sleep(2);
                    __builtin_amdgcn_fence(__ATOMIC_ACQUIRE, "agent");
                    asm volatile("s_waitcnt vmcnt(0)" ::: "memory"); }
                __syncthreads();
#pragma unroll
                for (int m = 0; m < 4; ++m) ssr[m] += __hip_atomic_load(xch + (hf ^ 1) * 64 + m * 16 + fr, __ATOMIC_RELAXED, __HIP_MEMORY_SCOPE_AGENT);
            }
#pragma unroll
            for (int m = 0; m < 4; ++m) {
                const float rs = rsqrtf(ssr[m] * (1.0f / D) + EPS);
                if (uc.mtile * 64 + m * 16 + fr < uc.cb) {
#pragma unroll
                    for (int nh = 0; nh < 2; ++nh) if (uc.hm & (1 << nh)) { const int col = nh * 512 + wc * 64 + fq * 4; float* o = dst + (size_t)tok[m] * D + col;
#pragma unroll
                        for (int n = 0; n < 4; ++n) { const f32x4 gf = *(const LAS f32x4*)(fn + col + n * 16);
                            *(float4*)(o + n * 16) = make_float4(acc[nh][m][n][0] * rs * gf[0], acc[nh][m][n][1] * rs * gf[1], acc[nh][m][n][2] * rs * gf[2], acc[nh][m][n][3] * rs * gf[3]); } } } }
            __syncthreads();
        } else { float s = 0.f;
#pragma unroll
            for (int nh = 0; nh < 2; ++nh)
#pragma unroll
                for (int m = 0; m < 4; ++m)
#pragma unroll
                    for (int n = 0; n < 4; ++n) s += acc[nh][m][n][0] + acc[nh][m][n][1] + acc[nh][m][n][2] + acc[nh][m][n][3];
            if (s == 123.456f) *dst = s; }
    }
    asm volatile("s_waitcnt vmcnt(0)" ::: "memory");
}
__device__ __forceinline__ void unpack8(const uint4 v, float* f) {
    f[0] = __uint_as_float(v.x << 16); f[1] = __uint_as_float(v.x & 0xffff0000u); f[2] = __uint_as_float(v.y << 16); f[3] = __uint_as_float(v.y & 0xffff0000u);
    f[4] = __uint_as_float(v.z << 16); f[5] = __uint_as_float(v.z & 0xffff0000u); f[6] = __uint_as_float(v.w << 16); f[7] = __uint_as_float(v.w & 0xffff0000u);
}
__device__ __forceinline__ void phase2(const Params& p, LAS unsigned char* lds, int bid, int nb) {
    const int tid = tid_fresh(), wid = __builtin_amdgcn_readfirstlane(tid >> 6), lane = tid & 63, fr = lane & 15, fq = lane >> 4;
    bf16_t* y = (bf16_t*)(p.ws + OFF_C);
    LAS float* red = (LAS float*)(lds + LDS_MISC + 1024);
    const int cch = lane * 8;
    const int g = wid >> 1, nh = wid & 1;
    const bf16_t* pw = (const bf16_t*)(p.ws + OFF_POOL);
    for (int unit = bid; unit < T / 64; unit += nb) {
        const int R0 = unit * 64, b = R0 >> 13, s0 = R0 & 8191;
        __syncthreads();
        {
            const int cvl = lane & 15, rq = lane >> 4, rbase = (wid & 1) * 32 + rq * 8, col = 1024 + g * 128 + cvl * 8;
            auto pooled_rows = [&](auto wc_) {
                constexpr int W = decltype(wc_)::value;
                constexpr float invw = 1.0f / (float)W;
                uint4 raw[W + 7];
#pragma unroll
                for (int q = 0; q < W + 7; ++q) raw[q] = *(const uint4*)(proj_row(p, b, s0 + rbase - (W - 1) + q) + col);
                float run[8], f[8];
#pragma unroll
                for (int j = 0; j < 8; ++j) run[j] = 0.f;
#pragma unroll
                for (int q = 0; q < W - 1; ++q) { unpack8(raw[q], f);
#pragma unroll
                    for (int j = 0; j < 8; ++j) run[j] += f[j]; }
#pragma unroll
                for (int i = 0; i < 8; ++i) { const int row = rbase + i;
                    unpack8(raw[W - 1 + i], f);
                    float pv[8];
#pragma unroll
                    for (int j = 0; j < 8; ++j) { run[j] += f[j]; pv[j] = run[j] * invw - f[j]; }
                    *(LAS u32x4*)(lds + g * 16384 + (cvl >> 3) * 8192 + row * 128 + swz_slot<64>(row, cvl & 7) * 16) = (u32x4){pack2(pv[0], pv[1]), pack2(pv[2], pv[3]), pack2(pv[4], pv[5]), pack2(pv[6], pv[7])};
                    unpack8(raw[i], f);
#pragma unroll
                    for (int j = 0; j < 8; ++j) run[j] -= f[j]; }
            };
            if (g == 0) pooled_rows(std::integral_constant<int, 2>{});
            else if (g == 1) pooled_rows(std::integral_constant<int, 4>{});
            else if (g == 2) pooled_rows(std::integral_constant<int, 8>{});
            else pooled_rows(std::integral_constant<int, 16>{});
        }
        {
            const int sb = s0 + wid * 8;
            float w0[8], w1[8], w2[8];
#pragma unroll
            for (int j = 0; j < 8; ++j) { w0[j] = p.conv_w[cch + j]; w1[j] = p.conv_w[512 + cch + j]; w2[j] = p.conv_w[1024 + cch + j]; }
            float u2[8], u1[8], u0[8], b8[8];
            { const uint4 h2 = *(const uint4*)(proj_row(p, b, sb - 2) + 512 + cch), h1 = *(const uint4*)(proj_row(p, b, sb - 1) + 512 + cch); unpack8(h2, u2); unpack8(h1, u1); }
#pragma unroll
            for (int hb4 = 0; hb4 < 2; ++hb4) {
                uint4 uq[4], bq8[4];
#pragma unroll
                for (int i = 0; i < 4; ++i) { const bf16_t* r = proj_row(p, b, sb + hb4 * 4 + i); bq8[i] = *(const uint4*)(r + cch); uq[i] = *(const uint4*)(r + 512 + cch); }
#pragma unroll
                for (int i = 0; i < 4; ++i) {
                    unpack8(bq8[i], b8); unpack8(uq[i], u0);
                    float raw[8]; float ss = 0.f;
#pragma unroll
                    for (int j = 0; j < 8; ++j) { raw[j] = b8[j] * (w0[j] * u2[j] + w1[j] * u1[j] + w2[j] * u0[j]); ss += raw[j] * raw[j]; u2[j] = u1[j]; u1[j] = u0[j]; }
                    ss = wave_sum(ss); const float rs = rsqrtf(ss * (1.0f / 512) + EPS);
                    *(uint4*)(y + (size_t)(R0 + wid * 8 + hb4 * 4 + i) * D + cch) = make_uint4(pack2(raw[0] * rs, raw[1] * rs), pack2(raw[2] * rs, raw[3] * rs), pack2(raw[4] * rs, raw[5] * rs), pack2(raw[6] * rs, raw[7] * rs)); }
            }
        }
        bf16x8 bfr[4][4];
#pragma unroll
        for (int ks = 0; ks < 4; ++ks)
#pragma unroll
            for (int n = 0; n < 4; ++n) bfr[ks][n] = *(const bf16x8*)(pw + (size_t)(g * 128 + nh * 64 + n * 16 + fr) * 128 + ks * 32 + fq * 8);
        __syncthreads();
        f32x4 acc[4][4];
#pragma unroll
        for (int m = 0; m < 4; ++m)
#pragma unroll
            for (int n = 0; n < 4; ++n) acc[m][n] = (f32x4){0.f, 0.f, 0.f, 0.f};
#pragma unroll
        for (int ks = 0; ks < 4; ++ks) {
            bf16x8 af[4];
#pragma unroll
            for (int m = 0; m < 4; ++m) af[m] = *(const LAS bf16x8*)(lds + g * 16384 + (ks >> 1) * 8192 + (m * 16 + fr) * 128 + swz_slot<64>(fr, (ks & 1) * 4 + fq) * 16);
#pragma unroll
            for (int m = 0; m < 4; ++m)
#pragma unroll
                for (int n = 0; n < 4; ++n) acc[m][n] = __builtin_amdgcn_mfma_f32_16x16x32_bf16(bfr[ks][n], af[m], acc[m][n], 0, 0, 0);
        }
#pragma unroll
        for (int m = 0; m < 4; ++m) { float ss = 0.f;
#pragma unroll
            for (int n = 0; n < 4; ++n) { acc[m][n] *= *(const f32x4*)(p.pool_scale + g * 128 + nh * 64 + n * 16 + fq * 4); ss += acc[m][n][0] * acc[m][n][0] + acc[m][n][1] * acc[m][n][1] + acc[m][n][2] * acc[m][n][2] + acc[m][n][3] * acc[m][n][3]; }
            ss += __shfl_xor(ss, 16); ss += __shfl_xor(ss, 32);
            if (fq == 0) red[(m * 16 + fr) * 8 + wid] = ss; }
        __syncthreads();
#pragma unroll
        for (int m = 0; m < 4; ++m) { float ss = 0.f;
#pragma unroll
            for (int w8 = 0; w8 < 8; ++w8) ss += red[(m * 16 + fr) * 8 + w8];
            const float rs = rsqrtf(ss * (1.0f / 512) + EPS);
#pragma unroll
            for (int pr = 0; pr < 2; ++pr) { const f32x4 va = acc[m][2 * pr] * rs, vb = acc[m][2 * pr + 1] * rs;
                unsigned ax = pack2(va[0], va[1]), ay = pack2(va[2], va[3]), bx = pack2(vb[0], vb[1]), by = pack2(vb[2], vb[3]);
                swap16(ax, bx); swap16(ay, by);
                *(uint4*)(y + (size_t)(R0 + m * 16 + fr) * D + 512 + g * 128 + nh * 64 + pr * 32 + (fq & 1) * 16 + (fq >> 1) * 8) = make_uint4(ax, ay, bx, by); } }
    }
}

#define XB_TMO      128
#define XB_XCNT(j)  (256  + 64 * (j))
#define XB_XSUB(j)  (1280 + 64 * (j))
#define XB_XGEN(j)  (2304 + 64 * (j))
#define XB_TOP      3328
#define XB_TOPGEN   3392
#define XCD_BAR_WORDS 3456
#define XB_SPIN_CAP (1u << 18)
__device__ __forceinline__ unsigned xb_ld(unsigned* p)              { return __hip_atomic_load(p, __ATOMIC_RELAXED, __HIP_MEMORY_SCOPE_AGENT); }
__device__ __forceinline__ unsigned xb_add(unsigned* p, unsigned v) { return __hip_atomic_fetch_add(p, v, __ATOMIC_RELAXED, __HIP_MEMORY_SCOPE_AGENT); }
__device__ __forceinline__ unsigned xb_xcc_id() { return (unsigned)__builtin_amdgcn_s_getreg((3 << 11) | 20) & 0xFu; }
#define XB_SPIN(cond, bar) do { unsigned _sp = 0; while (cond) { __builtin_amdgcn_s_sleep(1); \
    if ((++_sp & 255u) == 0u) { if (xb_ld(&(bar)[XB_TMO])) break; if (_sp > XB_SPIN_CAP) { atomicAdd(&(bar)[XB_TMO], 1u); break; } } } } while (0)
struct XcdBarrier { unsigned* bar; unsigned x; volatile __attribute__((address_space(3))) unsigned* st; };
__device__ __forceinline__ XcdBarrier xcd_barrier_post(unsigned* bar, volatile __attribute__((address_space(3))) unsigned* st) {
    XcdBarrier b; b.bar = bar; b.x = xb_xcc_id(); b.st = st;
    if (threadIdx.x == 0) (void)xb_add(&bar[XB_XCNT(b.x)], 1u);
    return b;
}
__device__ __forceinline__ void xcd_barrier_complete(unsigned* bar, unsigned x, unsigned& nloc, unsigned& nx) {
    const unsigned G = gridDim.x * gridDim.y * gridDim.z;
    unsigned sum, cnt, mine, sp = 0u;
    for (;;) {
        sum = 0u; cnt = 0u; mine = 0u;
#pragma unroll
        for (unsigned j = 0; j < 16; ++j) { const unsigned c = xb_ld(&bar[XB_XCNT(j)]); sum += c; cnt += (c > 0u) ? 1u : 0u; mine = (j == x) ? c : mine; }
        if (sum == G) break;
        __builtin_amdgcn_s_sleep(1);
        if ((++sp & 255u) == 0u) { if (xb_ld(&bar[XB_TMO])) break; if (sp > XB_SPIN_CAP) { atomicAdd(&bar[XB_TMO], 1u); break; } }
    }
    nloc = mine > 0u ? mine : 1u; nx = cnt > 0u ? cnt : 1u;
}
__device__ __forceinline__ void xcd_barrier(const XcdBarrier& b) {
    asm volatile("s_waitcnt vmcnt(0)" ::: "memory");
    __syncthreads();
    if (threadIdx.x == 0) {
        unsigned* bar = b.bar;
        __builtin_amdgcn_s_waitcnt(0);
        unsigned nloc = b.st[0], nx = b.st[1];
        if (nloc == 0u) { xcd_barrier_complete(bar, b.x, nloc, nx); b.st[0] = nloc; b.st[1] = nx; }
        const unsigned old = xb_add(&bar[XB_XSUB(b.x)], 1u);
        const unsigned gen = old / nloc;
        if (old + 1u == (gen + 1u) * nloc) {
            __builtin_amdgcn_fence(__ATOMIC_RELEASE, "agent");
            asm volatile("s_waitcnt vmcnt(0)" ::: "memory");
            const unsigned og = xb_add(&bar[XB_TOP], 1u);
            const unsigned tg = og / nx;
            if (og + 1u == (tg + 1u) * nx) xb_add(&bar[XB_TOPGEN], 1u);
            else XB_SPIN(xb_ld(&bar[XB_TOPGEN]) == tg, bar);
            __builtin_amdgcn_fence(__ATOMIC_ACQUIRE, "agent");
            xb_add(&bar[XB_XGEN(b.x)], 1u);
            asm volatile("s_waitcnt vmcnt(0)" ::: "memory");
        } else {
            XB_SPIN(xb_ld(&bar[XB_XGEN(b.x)]) == gen, bar);
            __builtin_amdgcn_fence(__ATOMIC_ACQUIRE, "agent");
            asm volatile("s_waitcnt vmcnt(0)" ::: "memory");
        }
    }
    __syncthreads();
}

__global__ void __launch_bounds__(512, 2) mega_kernel(Params p) {
    extern __shared__ __attribute__((aligned(16))) unsigned char lds_raw[];
    LAS unsigned char* lds = (LAS unsigned char*)lds_raw;
    cg::grid_group grid = cg::this_grid();
    const int bid = blockIdx.x, nb = gridDim.x;
    volatile LAS unsigned* st = (volatile LAS unsigned*)(lds + LDS_MISC + 3072);
    if (threadIdx.x == 0) { st[0] = 0u; st[1] = 0u; }
    __syncthreads();
    XcdBarrier xb = xcd_barrier_post((unsigned*)(p.ws + OFF_BAR), st);
    if (p.ws == nullptr) grid.sync();
#define SEAM() xcd_barrier(xb)
    phase0(p, lds_raw, bid, nb); SEAM();
#if PROBE_DUP == 0
    phase0<PROBE_MODE>(p, lds_raw, bid, nb); SEAM();
#endif
    phase1(p, lds, bid, nb); SEAM();
#if PROBE_DUP == 1
    phase1<PROBE_MODE>(p, lds, bid, nb); SEAM();
#endif
    phase2(p, lds, bid, nb); SEAM();
#if PROBE_DUP == 2
    phase2(p, lds, bid, nb); SEAM();
#endif
    phase3(p, lds, bid, nb); SEAM();
#if PROBE_DUP == 3
    phase3(p, lds, bid, nb); SEAM();
#endif
    phase4(p, lds, bid, nb); SEAM();
#if PROBE_DUP == 4
    { int* cnt = (int*)(p.ws + OFF_CNT); if (bid == 0 && threadIdx.x < 256) cnt[threadIdx.x] = 0; } SEAM();
    phase4(p, lds, bid, nb); SEAM();
#endif
    phase5a(p, lds, bid, nb); SEAM();
#if PROBE_DUP == 5
    phase5a<PROBE_MODE>(p, lds, bid, nb); SEAM();
#endif
#if PROBE_DUP == 6
    phase5b<PROBE_MODE>(p, lds, bid, nb, (float*)(p.ws + OFF_B + 32 * MiB)); SEAM();
#endif
    phase5b(p, lds, bid, nb, p.out);
}

extern "C" void kernel_launch(void* const* d_in, const int* in_sizes, int n_in, void* d_out, int out_size, void* d_ws, size_t ws_size, hipStream_t stream) {
    static int init = 0;
    static int grid_blocks = 0;
    if (!init) {
        if (ws_size < WS_END) { fprintf(stderr, "workspace too small: %zu < %zu\n", ws_size, (size_t)WS_END); init = -1; return; }
        (void)hipFuncSetAttribute((const void*)mega_kernel, hipFuncAttributeMaxDynamicSharedMemorySize, LDS_BYTES);
        int dev = 0, cus = 0, per_cu = 0;
        (void)hipGetDevice(&dev);
        (void)hipDeviceGetAttribute(&cus, hipDeviceAttributeMultiprocessorCount, dev);
        (void)hipOccupancyMaxActiveBlocksPerMultiprocessor(&per_cu, (const void*)mega_kernel, 512, LDS_BYTES);
        if (per_cu < 1) { fprintf(stderr, "occupancy query says %d blocks/CU\n", per_cu); per_cu = 1; }
        if (per_cu > 1) per_cu = 1;
        grid_blocks = cus * per_cu;
        init = 1;
    }
    if (init < 0) return;
    Params p{};
    const float** f = (const float**)&p;
    for (int i = 0; i < 17; ++i) f[i] = (const float*)d_in[i];
    p.out = (float*)d_out; p.ws = (unsigned char*)d_ws;
    (void)hipMemsetAsync((unsigned char*)d_ws + OFF_BAR, 0, 16384, stream);
    void* args[] = {&p};
    hipError_t e = hipLaunchCooperativeKernel((const void*)mega_kernel, dim3(grid_blocks), dim3(512), args, LDS_BYTES, stream);
    if (e != hipSuccess) fprintf(stderr, "cooperative launch failed: %s (grid %d)\n", hipGetErrorString(e), grid_blocks);
}
```

```cpp
#include <hip/hip_runtime.h>
#include <hip/hip_cooperative_groups.h>
#include <cstdio>
#include <cstdint>
#include <type_traits>
namespace cg = cooperative_groups;
#define PROBE_DUP -1
#define PROBE_MODE 0

typedef unsigned short bf16_t;
typedef short bf16x8 __attribute__((ext_vector_type(8)));
typedef float f32x4 __attribute__((ext_vector_type(4)));
typedef unsigned u32x4 __attribute__((ext_vector_type(4)));
typedef long l64x2 __attribute__((ext_vector_type(2)));
typedef int i32x8 __attribute__((ext_vector_type(8)));
typedef int i32x4 __attribute__((ext_vector_type(4)));
__device__ __forceinline__ i32x8 cat8(bf16x8 lo, bf16x8 hi) { const i32x4 a = __builtin_bit_cast(i32x4, lo), b = __builtin_bit_cast(i32x4, hi); return (i32x8){a[0], a[1], a[2], a[3], b[0], b[1], b[2], b[3]}; }
#define MFMA_F8_K128(A, B, C) __builtin_amdgcn_mfma_scale_f32_16x16x128_f8f6f4((A), (B), (C), 0, 0, 0, 0x7f7f7f7f, 0, 0x7f7f7f7f)

constexpr int T = 32768, SEQ = 8192, D = 1024, NG = 2048  , NP = 1536  , DC = 512, NE = 32, DE = 256, NBUCK = 112;
constexpr float EPS = 1e-6f;
constexpr size_t MiB = 1024 * 1024;
constexpr size_t OFF_A = 0;
constexpr size_t OFF_B = 64 * MiB;
constexpr size_t OFF_C = 192 * MiB;
constexpr size_t OFF_WIN = 256 * MiB;
constexpr size_t OFF_WOUT = 260 * MiB;
constexpr size_t OFF_WGU = 262 * MiB;
constexpr size_t OFF_WD = 294 * MiB;
constexpr size_t OFF_POOL = 310 * MiB;
constexpr size_t OFF_WR = OFF_POOL + 128 * 1024;
constexpr size_t OFF_PM = OFF_WR + 128 * 1024;
constexpr size_t OFF_RSTD1 = OFF_PM + 64 * 1024;
constexpr size_t OFF_SSQ2 = OFF_RSTD1 + 128 * 1024;
constexpr size_t OFF_RT = OFF_SSQ2 + 2 * MiB;
constexpr size_t OFF_EL = OFF_RT + 512 * 1024;
constexpr size_t OFF_PL = OFF_EL + 4 * MiB;
constexpr size_t OFF_ERS = 332 * MiB;
constexpr size_t OFF_H = 336 * MiB;
constexpr size_t OFF_BAR = OFF_H + 64 * MiB;
constexpr size_t OFF_H8 = OFF_BAR + 1 * MiB;
constexpr size_t WS_END = OFF_H8 + 32 * MiB;
constexpr size_t OFF_CNT = OFF_BAR + 14336;

struct Params {
    const float *x, *meta, *norm_mix, *w_in, *conv_w, *norm_conv_out, *pool_w, *pool_scale, *norm_pool_out, *w_out, *norm_ffn,
        *w_rg, *w_re, *w_gate, *w_up, *w_down, *final_norm;
    float* out;
    unsigned char* ws;
};

__device__ __forceinline__ int tid_fresh() { int t = threadIdx.x; asm volatile("" : "+v"(t)); return t; }
__device__ __forceinline__ float bf2f(bf16_t v) { return __uint_as_float(((unsigned)v) << 16); }
__device__ __forceinline__ bf16_t f2bf(float f) { unsigned u = __float_as_uint(f); u += 0x7fffu + ((u >> 16) & 1u); return (bf16_t)(u >> 16); }
__device__ __forceinline__ unsigned pack2(float lo, float hi) { return (unsigned)f2bf(lo) | ((unsigned)f2bf(hi) << 16); }
__device__ __forceinline__ unsigned pack4_fp8(float a, float b, float c, float d) {
    a = __builtin_amdgcn_fmed3f(a, -448.f, 448.f); b = __builtin_amdgcn_fmed3f(b, -448.f, 448.f); c = __builtin_amdgcn_fmed3f(c, -448.f, 448.f); d = __builtin_amdgcn_fmed3f(d, -448.f, 448.f);
    int w = __builtin_amdgcn_cvt_pk_fp8_f32(a, b, 0, false); w = __builtin_amdgcn_cvt_pk_fp8_f32(c, d, w, true); return (unsigned)w; }
constexpr float SC_H8 = 16.f, SC_WGU = 512.f, SC_ACT = 8.f, SC_WD = 256.f;
__device__ __forceinline__ float wave_sum(float v) {
#pragma unroll
    for (int o = 32; o > 0; o >>= 1) v += __shfl_xor(v, o);
    return v;
}
__device__ __forceinline__ int pair_off(int a) { return a * 8 - (a * (a + 1)) / 2; }

struct TrItem { const float* src; bf16_t* dst; const float* kscale; int ld_src, ld_dst, k0, n0, mapmode; float f8scale; };
__device__ __forceinline__ int tr_map(int mode, int h) {
    if (mode == 0) return h;
    if (mode == 3) { if (h < 512 || h >= 1536) return h; const int isv = h >= 1024, ch = (h - 512) & 511;
        return 512 + (ch >> 7) * 256 + ((ch >> 6) & 1) * 128 + ((ch >> 4) & 3) * 32 + ((ch >> 2) & 3) * 8 + 4 * isv + (ch & 3); }
    return ((h >> 5) << 6) + (h & 31) + (mode == 2 ? 32 : 0); }

constexpr int P0_PM = 128, P0_XR = 1024  , P0_WIN = 16 * 8, P0_WOUT = 16 * 4, P0_GATE = 32 * 16, P0_UP = P0_GATE, P0_DOWN = 32 * 4 * 4, P0_WR = 16, P0_POOL = 8;
constexpr int P0_TR0 = P0_PM + P0_XR, P0_TR = P0_WIN + P0_WOUT + P0_GATE + P0_UP + P0_DOWN, P0_ITEMS = P0_TR0 + P0_TR + P0_WR + P0_POOL;

__device__ __forceinline__ bool p0_tr_decode(const Params& p, int it, TrItem& t) {
    int i = it - P0_TR0; if (i < 0 || i >= P0_TR) return false;
    if (i < P0_WIN) { t.src = p.w_in; t.ld_src = NG; t.dst = (bf16_t*)(p.ws + OFF_WIN); t.ld_dst = D; t.k0 = (i & 15) * 64; t.n0 = (i >> 4) * 256; t.kscale = p.norm_mix; t.mapmode = 3; t.f8scale = 0.f; return true; }
    i -= P0_WIN;
    if (i < P0_WOUT) { t.src = p.w_out; t.ld_src = D; t.dst = (bf16_t*)(p.ws + OFF_WOUT); t.ld_dst = D; t.k0 = (i & 15) * 64; t.n0 = (i >> 4) * 256;
        t.kscale = (t.k0 < DC) ? p.norm_conv_out : (p.norm_pool_out - DC); t.mapmode = 0; t.f8scale = 0.f; return true; }
    i -= P0_WOUT;
    if (i < P0_GATE + P0_UP) { const int up = i >= P0_GATE; if (up) i -= P0_GATE; const int ex = i >> 4;
        t.src = (up ? p.w_up : p.w_gate) + (size_t)ex * D * DE; t.ld_src = DE; t.dst = (bf16_t*)(p.ws + OFF_WGU + (size_t)ex * 512 * D); t.ld_dst = D; t.k0 = (i & 15) * 64; t.n0 = 0;
        t.kscale = p.norm_ffn; t.mapmode = up ? 2 : 1; t.f8scale = SC_WGU; return true; }
    i -= P0_GATE + P0_UP;
    { const int ex = i >> 4; t.src = p.w_down + (size_t)ex * DE * D; t.ld_src = D; t.dst = (bf16_t*)(p.ws + OFF_WD + (size_t)ex * D * DE); t.ld_dst = DE; t.k0 = ((i >> 2) & 3) * 64; t.n0 = (i & 3) * 256;
      t.kscale = nullptr; t.mapmode = 0; t.f8scale = SC_WD; return true; }
}
__device__ __forceinline__ void p0_tr_load(const TrItem& t, float4 (&v)[8]) {
    const int tid = threadIdx.x;
#pragma unroll
    for (int i = 0; i < 8; ++i) { const int idx = tid + 512 * i, k = idx >> 6, n4 = idx & 63;
        v[i] = *(const float4*)(t.src + (size_t)(t.k0 + k) * t.ld_src + t.n0 + n4 * 4);
        if (t.kscale) { const float s = t.kscale[t.k0 + k]; v[i].x *= s; v[i].y *= s; v[i].z *= s; v[i].w *= s; } }
}

template <int MODE = 0> __device__ __forceinline__ void phase0(const Params& p, unsigned char* lds, int bid, int nb) {
    float* tile = (float*)lds;
    const int t = tid_fresh(), wid = t >> 6, lane = t & 63;
    bf16_t* xb = (bf16_t*)(p.ws + OFF_A);
    float* rstd1 = (float*)(p.ws + OFF_RSTD1);
    int it = bid;
    float4 v[8];
    TrItem cur, nxt;
    int first = bid; while (first < P0_TR0) first += nb;
    bool have = p0_tr_decode(p, first, cur);
    if (have) p0_tr_load(cur, v);
    for (; it < P0_PM; it += nb) {
            const int c16 = t & 15, col = (c16 >> 2) * 512 + it * 4 + (c16 & 3), ks = t >> 4;
            float wv[32];
#pragma unroll
            for (int j = 0; j < 32; ++j) wv[j] = p.w_in[(size_t)(ks * 32 + j) * NG + col];
            float* metan = (float*)lds;
            float* red = (float*)(lds + 65536);
            for (int rr = 0; rr < 2; ++rr) { const int r = wid * 2 + rr; const float* mr = p.meta + (size_t)r * D;
                float mv[16]; float ss = 0.f;
#pragma unroll
                for (int j = 0; j < 16; ++j) { mv[j] = mr[j * 64 + lane]; ss += mv[j] * mv[j]; }
                ss = wave_sum(ss); const float rs = rsqrtf(ss * (1.0f / D) + EPS);
#pragma unroll
                for (int j = 0; j < 16; ++j) metan[r * D + j * 64 + lane] = mv[j] * rs * p.norm_mix[j * 64 + lane]; }
            __syncthreads();
            float acc[16];
#pragma unroll
            for (int r = 0; r < 16; ++r) acc[r] = 0.f;
#pragma unroll
            for (int j = 0; j < 32; ++j) {
#pragma unroll
                for (int r = 0; r < 16; ++r) acc[r] += metan[r * D + ks * 32 + j] * wv[j]; }
#pragma unroll
            for (int r = 0; r < 16; ++r) red[(ks * 16 + r) * 16 + c16] = acc[r];
            __syncthreads();
            if (t < 256) { const int r = t >> 4, c = t & 15; float s = 0.f;
#pragma unroll
                for (int k8 = 0; k8 < 32; ++k8) s += red[(k8 * 16 + r) * 16 + c];
                metan[r * 16 + c] = s; }
            __syncthreads();
            bf16_t* pm = (bf16_t*)(p.ws + OFF_PM);
            if (t < 192) { const int r = t / 12, o = t % 12, q = o & 3; const float* vr = metan + r * 16;
                const float val = o < 4 ? vr[q] : (o < 8 ? vr[4 + q] * vr[8 + q] : vr[12 + q]);
                pm[(size_t)r * NP + (o >> 2) * 512 + it * 4 + q] = f2bf(val); }
            __syncthreads();
    }
    for (; it < P0_TR0; it += nb) {
            if (MODE & 1) continue;
            const int r0 = (it - P0_PM) * 32 + wid * 4;
            float4 a[4][4];
#pragma unroll
            for (int q = 0; q < 4; ++q)
#pragma unroll
                for (int j = 0; j < 4; ++j) a[q][j] = *(const float4*)(p.x + (size_t)(r0 + q) * D + j * 256 + lane * 4);
#pragma unroll
            for (int q = 0; q < 4; ++q) { float ss = 0.f;
#pragma unroll
                for (int j = 0; j < 4; ++j) { const float4 u0 = a[q][j];
                    ss += u0.x * u0.x + u0.y * u0.y + u0.z * u0.z + u0.w * u0.w;
                    *(uint2*)(xb + (size_t)(r0 + q) * D + j * 256 + lane * 4) = make_uint2(pack2(u0.x, u0.y), pack2(u0.z, u0.w)); }
                ss = wave_sum(ss);
                if (lane == 0) rstd1[r0 + q] = rsqrtf(ss * (1.0f / D) + EPS); }
    }
    {
        for (; it < P0_TR0 + P0_TR; it += nb) {
            if (MODE & 2) continue;
            __syncthreads();
#pragma unroll
            for (int i = 0; i < 8; ++i) { const int idx = t + 512 * i, k = idx >> 6, n4 = idx & 63; float* d = tile + (n4 >> 4) * (64 * 65) + k * 65 + (n4 & 15) * 4;
                d[0] = v[i].x; d[1] = v[i].y; d[2] = v[i].z; d[3] = v[i].w; }
            const bool hn = p0_tr_decode(p, it + nb, nxt);
            if (hn) p0_tr_load(nxt, v);
            __syncthreads();
            { const int n = t >> 3, ko = t & 7;
#pragma unroll
              for (int sub = 0; sub < 4; ++sub) { const float* s = tile + sub * (64 * 65) + (ko * 8) * 65 + n;
                  const size_t o = (size_t)tr_map(cur.mapmode, cur.n0 + sub * 64 + n) * cur.ld_dst + cur.k0 + ko * 8;
                  if (cur.f8scale != 0.f) { const float f = cur.f8scale;
                      *(uint2*)((unsigned char*)cur.dst + o) = make_uint2(pack4_fp8(s[0] * f, s[65] * f, s[130] * f, s[195] * f), pack4_fp8(s[260] * f, s[325] * f, s[390] * f, s[455] * f)); }
                  else *(uint4*)(cur.dst + o) = make_uint4(pack2(s[0], s[65]), pack2(s[130], s[195]), pack2(s[260], s[325]), pack2(s[390], s[455])); } }
            cur = nxt; have = hn;
        }
        (void)have;
    }
    for (; it < P0_TR0 + P0_TR + P0_WR; it += nb) {
            const int i = it - (P0_TR0 + P0_TR);
            bf16_t* wr = (bf16_t*)(p.ws + OFF_WR);
            for (int q = t; q < 4096; q += 512) { const int j = q >> 6, k = i * 64 + (q & 63);
                float val = 0.f; if (j < 4) val = p.w_rg[k * 4 + j]; else if (j < 36) val = p.w_re[k * 32 + (j - 4)];
                wr[(size_t)j * D + k] = f2bf(val * p.norm_ffn[k]); }
    }
    for (; it < P0_ITEMS; it += nb) {
            const int i = it - (P0_TR0 + P0_TR + P0_WR);
            bf16_t* pt = (bf16_t*)(p.ws + OFF_POOL);
            for (int q = t; q < 8192; q += 512) { const int o = i * 8192 + q, g = o >> 14, dd = (o >> 7) & 127, c = o & 127;
                pt[o] = f2bf(p.pool_w[(size_t)g * 16384 + c * 128 + dd]); }
    }
}
__device__ __forceinline__ const bf16_t* proj_row(const Params& p, int b, int s) {
    return s >= 0 ? (const bf16_t*)(p.ws + OFF_B) + ((size_t)b * SEQ + s) * NP : (const bf16_t*)(p.ws + OFF_PM) + (size_t)(16 + s) * NP;
}
#define LAS __attribute__((address_space(3)))
constexpr int LDS_STAGE = 147456, LDS_MISC = LDS_STAGE, LDS_BYTES = LDS_STAGE + 8192;

template <int WM_, int WN_, int TM_, int TN_, int BK_, int NST_>
struct GemmCfg {
    static constexpr int WM = WM_, WN = WN_, TM = TM_, TN = TN_, BK = BK_, NST = NST_;
    static constexpr int BM = WM * TM * 16, BN = WN * TN * 16;
    static constexpr int SL = BK / 8, RPC = 64 / SL;
    static constexpr int A_CH = BM / RPC, B_CH = BN / RPC, NA = (A_CH + 7) / 8, NB = (B_CH + 7) / 8;
    static constexpr int ROWB = BK * 2, A_BYTES = BM * ROWB, B_BYTES = BN * ROWB, ST_BYTES = A_BYTES + B_BYTES, KS = BK / 32;
    static constexpr bool UNIFORM = (A_CH % 8 == 0) && (B_CH % 8 == 0);
    static_assert(WM * WN == 8, "8 waves");
    static_assert(NST * ST_BYTES <= LDS_STAGE, "LDS");
    static_assert(NST == 2 || UNIFORM, "counted waits need uniform piece counts");
};
template <int BK> __device__ __forceinline__ int swz_slot(int row, int slot) {
    if (BK == 64) return slot ^ ((row >> 1) & 7);
    return slot ^ ((0 - (row >> 2)) & 3);
}
template <int TN> __device__ __forceinline__ int perm_row(int rho) {
    const int g = rho / (TN * 16), w = rho % (TN * 16), n = w >> 4, q = (w >> 2) & 3, j = w & 3;
    return g * (TN * 16) + q * (TN * 4) + n * 4 + j;
}
template <int N> __device__ __forceinline__ void wait_vm() {
    static_assert(N == 0 || N == 3 || N == 4 || N == 6 || N == 9 || N == 12 || N == 15, "add the count");
    if (N == 0) asm volatile("s_waitcnt vmcnt(0)" ::: "memory");
    else if (N == 4) asm volatile("s_waitcnt vmcnt(4)" ::: "memory");
    else if (N == 3) asm volatile("s_waitcnt vmcnt(3)" ::: "memory");
    else if (N == 6) asm volatile("s_waitcnt vmcnt(6)" ::: "memory");
    else if (N == 9) asm volatile("s_waitcnt vmcnt(9)" ::: "memory");
    else if (N == 12) asm volatile("s_waitcnt vmcnt(12)" ::: "memory");
    else asm volatile("s_waitcnt vmcnt(15)" ::: "memory");
}

template <class C, class D, int MODE = 0>
__device__ __forceinline__ void gemm_stream(LAS unsigned char* lds, const D& d) {
    typedef typename D::U U;
    const int tid = tid_fresh(), wid = __builtin_amdgcn_readfirstlane(tid >> 6), lane = tid & 63, wr = wid / C::WN, wc = wid % C::WN, fr = lane & 15, fq = lane >> 4;
    const int nk = d.nk();
    U us, uc;
    int is = 0, kts = 0;
    bool more = d.get(0, us);
    unsigned offA[C::NA], offB[C::NB];
    auto set_offsets = [&](const U& u) {
#pragma unroll
        for (int i = 0; i < C::NA; ++i) { const int c = wid + 8 * i, row = c * C::RPC + lane / C::SL, sp = lane % C::SL;
            offA[i] = (c < C::A_CH) ? d.aoff(u, row) + (unsigned)swz_slot<C::BK>(row, sp) * 16u : 0u; }
#pragma unroll
        for (int i = 0; i < C::NB; ++i) { const int c = wid + 8 * i, row = c * C::RPC + lane / C::SL, sp = lane % C::SL;
            offB[i] = (c < C::B_CH) ? d.boff(u, row) + (unsigned)swz_slot<C::BK>(row, sp) * 16u : 0u; }
    };
    if (more) set_offsets(us);
    int aread[C::KS], bread[C::KS];
#pragma unroll
    for (int ks = 0; ks < C::KS; ++ks) {
        aread[ks] = (wr * C::TM * 16 + fr) * C::ROWB + swz_slot<C::BK>(fr, ks * 4 + fq) * 16;
        bread[ks] = C::A_BYTES + (wc * C::TN * 16 + fr) * C::ROWB + swz_slot<C::BK>(fr, ks * 4 + fq) * 16;
    }
    f32x4 acc[C::TM][C::TN];
    typename D::R rs;
    int issued = 0, sbuf = 0;
    auto stage_next = [&]() {
        if (!more) return;
        const char* ab = d.abase(us, kts); const char* bb = d.bbase(us, kts);
        LAS unsigned char* sa = lds + sbuf;
        if (!(MODE & 4)) {
#pragma unroll
        for (int i = 0; i < C::NA; ++i) { const int c = wid + 8 * i;
            if (c < C::A_CH) __builtin_amdgcn_global_load_lds((const unsigned*)(ab + offA[i]), (LAS unsigned*)(sa + c * 1024), 16, 0, 0); }
#pragma unroll
        for (int i = 0; i < C::NB; ++i) { const int c = wid + 8 * i;
            if (c < C::B_CH) __builtin_amdgcn_global_load_lds((const unsigned*)(bb + offB[i]), (LAS unsigned*)(sa + C::A_BYTES + c * 1024), 16, 0, 0); }
        }
        ++issued; sbuf += C::ST_BYTES; if (sbuf == C::NST * C::ST_BYTES) sbuf = 0;
        if (++kts == nk) { kts = 0; ++is; more = d.get(is, us); if (more) set_offsets(us); }
    };
    __syncthreads();
    stage_next();
    if (C::NST == 3) stage_next();
    int g = 0, cbuf = 0;
    for (int ic = 0; d.get(ic, uc); ++ic) {
        d.init(uc, acc, rs, wr, wc, fr, fq);
        for (int kt = 0; kt < nk; ++kt, ++g) {
            if (C::NST == 3 && issued > g + 1) wait_vm<C::UNIFORM ? C::NA + C::NB : 0>(); else wait_vm<0>();
            __builtin_amdgcn_s_barrier();
            asm volatile("" ::: "memory");
            stage_next();
            const LAS unsigned char* sa = lds + cbuf;
            if (!(MODE & 2)) {
#pragma unroll
            for (int ks = 0; ks < C::KS; ++ks) {
                bf16x8 af[C::TM], bfr[C::TN];
#pragma unroll
                for (int m = 0; m < C::TM; ++m) af[m] = *(const LAS bf16x8*)(sa + aread[ks] + m * 16 * C::ROWB);
#pragma unroll
                for (int n = 0; n < C::TN; ++n) bfr[n] = *(const LAS bf16x8*)(sa + bread[ks] + n * 16 * C::ROWB);
#pragma unroll
                for (int m = 0; m < C::TM; ++m)
#pragma unroll
                    for (int n = 0; n < C::TN; ++n) acc[m][n] = __builtin_amdgcn_mfma_f32_16x16x32_bf16(bfr[n], af[m], acc[m][n], 0, 0, 0);
            }
            }
            cbuf += C::ST_BYTES; if (cbuf == C::NST * C::ST_BYTES) cbuf = 0;
        }
        if (!(MODE & 1)) d.epi(uc, acc, rs, wr, wc, fr, fq);
        else { float s = 0.f;
#pragma unroll
            for (int m = 0; m < C::TM; ++m)
#pragma unroll
                for (int n = 0; n < C::TN; ++n) s += acc[m][n][0] + acc[m][n][1] + acc[m][n][2] + acc[m][n][3];
            if (s == 123.456f) *(float*)d.sink() = s; }
    }
}

template <class C, class D, int MODE = 0>
__device__ __forceinline__ void gemm_stream3(LAS unsigned char* lds, const D& d) {
    static_assert(C::KS == 2 && C::UNIFORM && C::NST == 3, "BK = 64, 3 buffers, uniform pieces");
    constexpr int P = C::NA + C::NB;
    typedef typename D::U U;
    const int tid = tid_fresh(), wid = __builtin_amdgcn_readfirstlane(tid >> 6), lane = tid & 63, wr = wid / C::WN, wc = wid % C::WN, fr = lane & 15, fq = lane >> 4;
    const int half = wid >> 2;
    const int nk = d.nk();
    U us, uc;
    int is = 0, kts = 0;
    bool more = d.get(0, us);
    if (!more) return;
    unsigned offA[C::NA], offB[C::NB];
    auto set_offsets = [&](const U& u) {
#pragma unroll
        for (int i = 0; i < C::NA; ++i) { const int c = wid + 8 * i, row = c * C::RPC + lane / C::SL, sp = lane % C::SL;
            offA[i] = d.aoff(u, row) + (unsigned)swz_slot<C::BK>(row, sp) * 16u; }
#pragma unroll
        for (int i = 0; i < C::NB; ++i) { const int c = wid + 8 * i, row = c * C::RPC + lane / C::SL, sp = lane % C::SL;
            offB[i] = d.boff(u, row) + (unsigned)swz_slot<C::BK>(row, sp) * 16u; }
    };
    set_offsets(us);
    int aread[2], bread[2];
#pragma unroll
    for (int ks = 0; ks < 2; ++ks) {
        aread[ks] = (wr * C::TM * 16 + fr) * C::ROWB + swz_slot<C::BK>(fr, ks * 4 + fq) * 16;
        bread[ks] = C::A_BYTES + (wc * C::TN * 16 + fr) * C::ROWB + swz_slot<C::BK>(fr, ks * 4 + fq) * 16;
    }
    f32x4 acc[C::TM][C::TN];
    typename D::R rs;
    int sbuf = 0;
    auto stage_next = [&]() -> bool {
        if (!more) return false;
        const char* ab = d.abase(us, kts); const char* bb = d.bbase(us, kts);
        LAS unsigned char* sa = lds + sbuf;
        if (!(MODE & 4)) {
#pragma unroll
        for (int i = 0; i < C::NA; ++i) __builtin_amdgcn_global_load_lds((const unsigned*)(ab + offA[i]), (LAS unsigned*)(sa + (wid + 8 * i) * 1024), 16, 0, 0);
#pragma unroll
        for (int i = 0; i < C::NB; ++i) __builtin_amdgcn_global_load_lds((const unsigned*)(bb + offB[i]), (LAS unsigned*)(sa + C::A_BYTES + (wid + 8 * i) * 1024), 16, 0, 0);
        }
        sbuf += C::ST_BYTES; if (sbuf == C::NST * C::ST_BYTES) sbuf = 0;
        if (++kts == nk) { kts = 0; ++is; more = d.get(is, us); if (more) set_offsets(us); }
        return true;
    };
    bf16x8 fa[C::TM], fb[C::TN], fa1[D::FP8 ? C::TM : 1], fb1[D::FP8 ? C::TN : 1];
    int cbuf = 0;
    auto read_frags = [&](int ks) {
        const LAS unsigned char* sa = lds + cbuf;
        if (!(MODE & 2)) {
        if (D::FP8) {
            if (ks == 0) {
#pragma unroll
                for (int m = 0; m < C::TM; ++m) { fa[m] = *(const LAS bf16x8*)(sa + aread[0] + m * 16 * C::ROWB); fa1[m] = *(const LAS bf16x8*)(sa + aread[1] + m * 16 * C::ROWB); }
#pragma unroll
                for (int n = 0; n < C::TN; ++n) { fb[n] = *(const LAS bf16x8*)(sa + bread[0] + n * 16 * C::ROWB); fb1[n] = *(const LAS bf16x8*)(sa + bread[1] + n * 16 * C::ROWB); }
            }
        } else {
#pragma unroll
        for (int m = 0; m < C::TM; ++m) fa[m] = *(const LAS bf16x8*)(sa + aread[ks] + m * 16 * C::ROWB);
#pragma unroll
        for (int n = 0; n < C::TN; ++n) fb[n] = *(const LAS bf16x8*)(sa + bread[ks] + n * 16 * C::ROWB);
        }
        }
    };
    auto mma = [&](auto ksc) {
        constexpr int ks = decltype(ksc)::value;
        asm volatile("s_waitcnt lgkmcnt(0)" ::: "memory");
        if (!(MODE & 2)) {
        __builtin_amdgcn_s_setprio(1);
        if (D::FP8) {
#pragma unroll
            for (int mm = 0; mm < C::TM / 2; ++mm) { const int m = ks * (C::TM / 2) + mm;
#pragma unroll
                for (int n = 0; n < C::TN; ++n) acc[m][n] = MFMA_F8_K128(cat8(fb[n], fb1[n]), cat8(fa[m], fa1[m]), acc[m][n]); }
        } else {
#pragma unroll
        for (int m = 0; m < C::TM; ++m)
#pragma unroll
            for (int n = 0; n < C::TN; ++n) acc[m][n] = __builtin_amdgcn_mfma_f32_16x16x32_bf16(fb[n], fa[m], acc[m][n], 0, 0, 0);
        }
        __builtin_amdgcn_s_setprio(0);
        }
    };
#define GS3_BAR() do { asm volatile("" ::: "memory"); __builtin_amdgcn_s_barrier(); asm volatile("" ::: "memory"); } while (0)
    __syncthreads();
    stage_next();
    const bool two = stage_next();
    if (two) wait_vm<P>(); else wait_vm<0>();
    GS3_BAR();
    if (half) GS3_BAR();
    for (int ic = 0; d.get(ic, uc); ++ic) {
        d.init(uc, acc, rs, wr, wc, fr, fq);
#pragma nounroll
        for (int kt = 0; kt < nk; ++kt) {
            bool staged = false;
            if (D::FP8) staged = stage_next();
            read_frags(0);
            GS3_BAR();
            mma(std::integral_constant<int, 0>{});
            GS3_BAR();
            read_frags(1);
            if (!D::FP8) staged = stage_next();
            if (staged) wait_vm<P>(); else wait_vm<0>();
            GS3_BAR();
            mma(std::integral_constant<int, 1>{});
            GS3_BAR();
            cbuf += C::ST_BYTES; if (cbuf == C::NST * C::ST_BYTES) cbuf = 0;
        }
        if (!(MODE & 1)) d.epi(uc, acc, rs, wr, wc, fr, fq);
        else { float s = 0.f;
#pragma unroll
            for (int m = 0; m < C::TM; ++m)
#pragma unroll
                for (int n = 0; n < C::TN; ++n) s += acc[m][n][0] + acc[m][n][1] + acc[m][n][2] + acc[m][n][3];
            if (s == 123.456f) *(float*)d.sink() = s; }
    }
    if (!half) GS3_BAR();
    asm volatile("s_waitcnt vmcnt(0) lgkmcnt(0)" ::: "memory");
#undef GS3_BAR
}

typedef GemmCfg<4, 2, 4, 4, 64, 3> CfgA;
typedef GemmCfg<8, 1, 1, 4, 64, 3> CfgR;

__device__ __forceinline__ float lo_bf(unsigned w) { return __uint_as_float(w << 16); }
__device__ __forceinline__ float hi_bf(unsigned w) { return __uint_as_float(w & 0xffff0000u); }

__device__ __forceinline__ void swap16(unsigned& a, unsigned& b) { const auto r = __builtin_amdgcn_permlane16_swap(a, b, false, false); a = r[0]; b = r[1]; }
namespace pg8 {
#define PG8_LAS __attribute__((address_space(3)))
typedef unsigned short bf16_t;
typedef short bf16x8 __attribute__((ext_vector_type(8)));
typedef float f32x4 __attribute__((ext_vector_type(4)));
typedef unsigned u32x4 __attribute__((ext_vector_type(4)));
constexpr int BM = 256, BK = 64, HALF = 128, HTB = HALF * BK * 2  , STAGE_BYTES = 8 * HTB, NXCD = 8, WGM = 8;

__host__ __device__ __forceinline__ int lds_byte(int r, int c) { const int st = (r >> 4) * 2 + (c >> 5), rr = r & 15, cc = c & 31, ob = rr * 64 + cc * 2; return st * 1024 + (ob ^ (((ob >> 9) & 1) << 5)); }
__host__ __device__ __forceinline__ void stage_rc(int b, int& R, int& C) { const int st = b / 1024, sb = b % 1024, swz = sb ^ (((sb >> 9) & 1) << 5); R = (st >> 1) * 16 + swz / 64; C = (st & 1) * 32 + (swz % 64) / 2; }
__host__ __device__ __forceinline__ int perm32(int rho) { const int n = rho >> 4, i = rho & 15; return 8 * (i >> 2) + 4 * n + (i & 3); }

struct Unit { int pm, pn; };
struct Gemm { const bf16_t* A; const bf16_t* Bt; int M, N, K; };

struct StaticOrder {
    int nM, nN, nwg, G, c;
    __host__ __device__ void init(int M, int N, int G_, int c_) { nM = M / BM; nN = N / BM; nwg = nM * nN; G = G_; c = c_; }
    __host__ __device__ bool next(int i, Unit& u) const {
        const long L = (long)i * G + c; if (L >= nwg) return false;
        int wgid = (int)L; { const int q = nwg / NXCD, r = nwg % NXCD, xcd = wgid % NXCD, off = wgid / NXCD; wgid = (xcd < r ? xcd * (q + 1) : r * (q + 1) + (xcd - r) * q) + off; }
        const int nig = WGM * nN, gid = wgid / nig, fm = gid * WGM, gsz = (nM - fm) < WGM ? (nM - fm) : WGM;
        u.pm = fm + ((wgid % nig) % gsz); u.pn = (wgid % nig) / gsz; return true;
    }
    __device__ __forceinline__ void a_ready(const Unit&) const {}
    __device__ __forceinline__ void done(const Unit&) const {}
};
__device__ __forceinline__ unsigned cvt_pk_bf16(float lo, float hi) { unsigned r; asm volatile("v_cvt_pk_bf16_f32 %0, %1, %2" : "=v"(r) : "v"(lo), "v"(hi)); return r; }

struct EpiProj {
    static constexpr bool PERM = true, AFTER_DRAIN = false;
    unsigned short* proj; const float* rstd;
    __device__ __forceinline__ void operator()(const f32x4 (&acc)[2][2][4][2], const Unit& u, int wr, int wc, int fr, int fq) const {
        const int row0 = u.pm * BM + wr * 64 + fr;
        float rsv[2][4];
        { const float r0 = rstd[row0 + fq * 16], r1 = rstd[row0 + HALF + fq * 16];
#pragma unroll
          for (int m = 0; m < 4; ++m) { rsv[0][m] = __shfl(r0, fr + 16 * m); rsv[1][m] = __shfl(r1, fr + 16 * m); } }
        if (u.pn >= 2 && u.pn < 6) {
            const int col0 = 512 + (u.pn - 2) * 128 + (fq & 1) * 64 + wc * 16 + (fq >> 1) * 8;
#pragma unroll
            for (int ai = 0; ai < 2; ++ai)
#pragma unroll
                for (int m = 0; m < 4; ++m) { const int row = row0 + ai * HALF + m * 16; const float rs = rsv[ai][m], rs2 = rs * rs;
                    const f32x4 u0 = acc[ai][0][m][0] * acc[ai][0][m][1] * rs2, u1 = acc[ai][1][m][0] * acc[ai][1][m][1] * rs2;
                    unsigned ax = cvt_pk_bf16(u0[0], u0[1]), ay = cvt_pk_bf16(u0[2], u0[3]), bx = cvt_pk_bf16(u1[0], u1[1]), by = cvt_pk_bf16(u1[2], u1[3]);
                    swap16(ax, bx); swap16(ay, by);
                    u32x4 w; w.x = ax; w.y = ay; w.z = bx; w.w = by;
                    *(u32x4*)(proj + (size_t)row * 1536 + col0) = w; }
        } else {
            const int col0 = (u.pn < 2 ? u.pn * BM : 1024 + (u.pn - 6) * BM) + wc * 32 + 8 * fq;
#pragma unroll
            for (int ai = 0; ai < 2; ++ai)
#pragma unroll
                for (int m = 0; m < 4; ++m) { const int row = row0 + ai * HALF + m * 16; const float rs = rsv[ai][m]; unsigned short* rowp = proj + (size_t)row * 1536 + col0;
#pragma unroll
                    for (int bj = 0; bj < 2; ++bj) { const f32x4 v0 = acc[ai][bj][m][0] * rs, v1 = acc[ai][bj][m][1] * rs;
                        u32x4 w; w.x = cvt_pk_bf16(v0[0], v0[1]); w.y = cvt_pk_bf16(v0[2], v0[3]); w.z = cvt_pk_bf16(v1[0], v1[1]); w.w = cvt_pk_bf16(v1[2], v1[3]);
                        *(u32x4*)(rowp + bj * HALF) = w; } }
        }
    }
};
struct EpiOut {
    static constexpr bool PERM = true, AFTER_DRAIN = false;
    const unsigned short* xb; unsigned short* hb; unsigned char* hb8; float* ssq2;
    __device__ __forceinline__ void operator()(const f32x4 (&acc)[2][2][4][2], const Unit& u, int wr, int wc, int fr, int fq) const {
        const int row0 = u.pm * BM + wr * 64 + fr, col0 = u.pn * BM + wc * 32 + 8 * fq;
        const int col8 = u.pn * BM + (fq & 1) * HALF + wc * 32 + (fq >> 1) * 16;
#pragma unroll
        for (int ai = 0; ai < 2; ++ai) {
            float ssv[4];
            u32x4 xr[4][2];
#pragma unroll
            for (int m = 0; m < 4; ++m)
#pragma unroll
                for (int bj = 0; bj < 2; ++bj) xr[m][bj] = *(const u32x4*)(xb + (size_t)(row0 + ai * HALF + m * 16) * 1024 + col0 + bj * HALF);
#pragma unroll
            for (int m = 0; m < 4; ++m) { const int row = row0 + ai * HALF + m * 16; const size_t o = (size_t)row * 1024 + col0; float ss = 0.f;
                unsigned q8[2][2];
#pragma unroll
                for (int bj = 0; bj < 2; ++bj) { f32x4 a = acc[ai][bj][m][0], b = acc[ai][bj][m][1]; const u32x4 x = xr[m][bj];
                    a[0] += lo_bf(x.x); a[1] += hi_bf(x.x); a[2] += lo_bf(x.y); a[3] += hi_bf(x.y);
                    b[0] += lo_bf(x.z); b[1] += hi_bf(x.z); b[2] += lo_bf(x.w); b[3] += hi_bf(x.w);
                    u32x4 w; w.x = cvt_pk_bf16(a[0], a[1]); w.y = cvt_pk_bf16(a[2], a[3]); w.z = cvt_pk_bf16(b[0], b[1]); w.w = cvt_pk_bf16(b[2], b[3]);
                    *(u32x4*)(hb + o + bj * HALF) = w;
                    q8[bj][0] = pack4_fp8(a[0] * SC_H8, a[1] * SC_H8, a[2] * SC_H8, a[3] * SC_H8); q8[bj][1] = pack4_fp8(b[0] * SC_H8, b[1] * SC_H8, b[2] * SC_H8, b[3] * SC_H8);
                    ss += a[0] * a[0] + a[1] * a[1] + a[2] * a[2] + a[3] * a[3] + b[0] * b[0] + b[1] * b[1] + b[2] * b[2] + b[3] * b[3]; }
                swap16(q8[0][0], q8[1][0]); swap16(q8[0][1], q8[1][1]);
                u32x4 w8; w8.x = q8[0][0]; w8.y = q8[0][1]; w8.z = q8[1][0]; w8.w = q8[1][1];
                *(u32x4*)(hb8 + (size_t)row * 1024 + col8) = w8;
                ss += __shfl_xor(ss, 16); ss += __shfl_xor(ss, 32);
                ssv[m] = ss; }
            { const float v = fq == 0 ? ssv[0] : (fq == 1 ? ssv[1] : (fq == 2 ? ssv[2] : ssv[3]));
              ssq2[(size_t)(row0 + ai * HALF + fq * 16) * 16 + u.pn * 4 + wc] = v; }
        }
    }
};
template <class Epi, class Sched, bool STAMP = false>
__device__ __forceinline__ void gemm_phase(PG8_LAS unsigned char* lds, const Gemm g, const Sched& S, const Epi& E, unsigned long long* stamps) {
    const int tid = tid_fresh(), wid = __builtin_amdgcn_readfirstlane(tid >> 6), lane = tid & 63, wr = wid >> 2, wc = wid & 3, fr = lane & 15, fq = lane >> 4;
    const int K = g.K, nt = K / BK;
    int ts_lo = 0, ts_hi = 0, nts = 0; const unsigned long long rt_entry = STAMP ? (unsigned long long)wall_clock64() : 0ull;
#define PG8_STAMP() do { if (STAMP && wid == 0 && nts < 64) { const unsigned long long _c = (unsigned long long)clock64(); \
        ts_lo = (lane == nts) ? (int)(unsigned)_c : ts_lo; ts_hi = (lane == nts) ? (int)(unsigned)(_c >> 32) : ts_hi; ++nts; } } while (0)
    PG8_STAMP();
    unsigned voffA[2], voffB[2];
#pragma unroll
    for (int i = 0; i < 2; ++i) { int R, C; stage_rc(tid * 16 + i * 8192, R, C); const int Rb = Epi::PERM ? ((R & ~31) + perm32(R & 31)) : R;
        voffA[i] = (unsigned)(R * K + C) * 2u; voffB[i] = (unsigned)(Rb * K + C) * 2u; }
    const size_t kstep = (size_t)(BK * 2);
    const size_t hstep = (size_t)HALF * K * 2;
    const size_t tstep = 2 * hstep;
    const unsigned ldsw = (unsigned)wid * 1024u;
    const int aoff = lds_byte(wr * 64 + fr, fq * 8), boff = lds_byte(wc * 32 + fr, fq * 8);
#define PG8_SA(b, h) (((b) * 2 + (h)) * HTB)
#define PG8_SB(b, h) ((4 + (b) * 2 + (h)) * HTB)
#define PG8_STAGE(bufoff, gbase, voff) do { _Pragma("unroll") for (int _i = 0; _i < 2; ++_i) \
        __builtin_amdgcn_global_load_lds((const unsigned*)((const char*)(gbase) + (voff)[_i]), (PG8_LAS unsigned*)(lds + (bufoff) + ldsw + _i * 8192), 16, 0, 0); } while (0)
#define PG8_LDA(dst, b, h) do { _Pragma("unroll") for (int m = 0; m < 4; ++m) _Pragma("unroll") for (int k = 0; k < 2; ++k) dst[m][k] = *(const PG8_LAS bf16x8*)(lds + PG8_SA(b, h) + aoff + m * 2048 + k * 1024); } while (0)
#define PG8_LDB(dst, b, h) do { _Pragma("unroll") for (int n = 0; n < 2; ++n) _Pragma("unroll") for (int k = 0; k < 2; ++k) dst[n][k] = *(const PG8_LAS bf16x8*)(lds + PG8_SB(b, h) + boff + n * 2048 + k * 1024); } while (0)
#define PG8_MMA(ai, bj, At, Bt) do { __builtin_amdgcn_s_setprio(1); _Pragma("unroll") for (int m = 0; m < 4; ++m) _Pragma("unroll") for (int n = 0; n < 2; ++n) _Pragma("unroll") for (int k = 0; k < 2; ++k) \
        acc[ai][bj][m][n] = __builtin_amdgcn_mfma_f32_16x16x32_bf16(Bt[n][k], At[m][k], acc[ai][bj][m][n], 0, 0, 0); __builtin_amdgcn_s_setprio(0); } while (0)
#define PG8_WAIT_V(n) asm volatile("s_waitcnt vmcnt(" #n ")" ::: "memory")
#define PG8_WAIT_L(n) asm volatile("s_waitcnt lgkmcnt(" #n ")" ::: "memory")
#define PG8_BAR __builtin_amdgcn_s_barrier()
#define PG8_SCHED __builtin_amdgcn_sched_barrier(0)
    Unit cur, nxt; int ui = 0;
    if (!S.next(0, cur)) return;
    f32x4 acc[2][2][4][2];
#pragma unroll
    for (int a = 0; a < 2; ++a)
#pragma unroll
        for (int b = 0; b < 2; ++b)
#pragma unroll
            for (int m = 0; m < 4; ++m)
#pragma unroll
                for (int n = 0; n < 2; ++n) acc[a][b][m][n] = (f32x4){0.f, 0.f, 0.f, 0.f};
    bf16x8 At[4][2], B0[2][2], B1[2][2];
    const char* cA = (const char*)g.A + (size_t)cur.pm * tstep; const char* cB = (const char*)g.Bt + (size_t)cur.pn * tstep;
    S.a_ready(cur);
    PG8_STAGE(PG8_SB(0, 0), cB, voffB); PG8_STAGE(PG8_SA(0, 0), cA, voffA); PG8_STAGE(PG8_SB(0, 1), cB + hstep, voffB); PG8_STAGE(PG8_SA(0, 1), cA + hstep, voffA);
    if (wr == 1) PG8_BAR;
    PG8_WAIT_V(4); PG8_BAR;
    PG8_STAGE(PG8_SB(1, 0), cB + kstep, voffB); PG8_STAGE(PG8_SA(1, 0), cA + kstep, voffA); PG8_STAGE(PG8_SB(1, 1), cB + hstep + kstep, voffB);
    PG8_WAIT_V(6); PG8_BAR;
    PG8_STAMP();
    for (;;) {
        const bool has_next = S.next(ui + 1, nxt);
        const char* nA = has_next ? (const char*)g.A + (size_t)nxt.pm * tstep : cA; const char* nB = has_next ? (const char*)g.Bt + (size_t)nxt.pn * tstep : cB;
        for (int t = 0; t < nt; t += 2) {
            const bool last = (t == nt - 2);
            const char* a1 = cA + (size_t)(t + 1) * kstep;
            const char* a2 = last ? nA : cA + (size_t)(t + 2) * kstep; const char* b2 = last ? nB : cB + (size_t)(t + 2) * kstep;
            const char* a3 = a2 + kstep; const char* b3 = b2 + kstep;
            if (last && has_next) S.a_ready(nxt);
            PG8_LDB(B0, 0, 0); PG8_SCHED; PG8_LDA(At, 0, 0); PG8_STAGE(PG8_SA(1, 1), a1 + hstep, voffA);
            PG8_WAIT_L(8); PG8_BAR; PG8_WAIT_L(0); PG8_MMA(0, 0, At, B0); PG8_BAR; PG8_SCHED;
            PG8_LDB(B1, 0, 1); PG8_STAGE(PG8_SB(0, 0), b2, voffB);
            PG8_BAR; PG8_WAIT_L(0); PG8_MMA(0, 1, At, B1); PG8_BAR;
            PG8_LDA(At, 0, 1); PG8_STAGE(PG8_SA(0, 0), a2, voffA);
            PG8_BAR; PG8_WAIT_L(0); PG8_MMA(1, 0, At, B0); PG8_BAR; PG8_SCHED;
            PG8_STAGE(PG8_SB(0, 1), b2 + hstep, voffB);
            PG8_WAIT_V(6); PG8_BAR; PG8_MMA(1, 1, At, B1); PG8_BAR;
            PG8_LDB(B0, 1, 0); PG8_SCHED; PG8_LDA(At, 1, 0); PG8_STAGE(PG8_SA(0, 1), a2 + hstep, voffA);
            PG8_WAIT_L(8); PG8_BAR; PG8_WAIT_L(0); PG8_MMA(0, 0, At, B0); PG8_BAR; PG8_SCHED;
            PG8_LDB(B1, 1, 1); PG8_STAGE(PG8_SB(1, 0), b3, voffB);
            PG8_BAR; PG8_WAIT_L(0); PG8_MMA(0, 1, At, B1); PG8_BAR;
            PG8_LDA(At, 1, 1); PG8_STAGE(PG8_SA(1, 0), a3, voffA);
            PG8_BAR; PG8_WAIT_L(0); PG8_MMA(1, 0, At, B0); PG8_BAR; PG8_SCHED;
            PG8_STAGE(PG8_SB(1, 1), b3 + hstep, voffB);
            PG8_WAIT_V(6); PG8_BAR; PG8_MMA(1, 1, At, B1); PG8_BAR;
        }
        PG8_STAMP();
        if constexpr (!Epi::AFTER_DRAIN) { E(acc, cur, wr, wc, fr, fq); S.done(cur); }
        PG8_STAMP();
        if (!has_next) break;
#pragma unroll
        for (int a = 0; a < 2; ++a)
#pragma unroll
            for (int b = 0; b < 2; ++b)
#pragma unroll
                for (int m = 0; m < 4; ++m)
#pragma unroll
                    for (int n = 0; n < 2; ++n) acc[a][b][m][n] = (f32x4){0.f, 0.f, 0.f, 0.f};
        cur = nxt; cA = nA; cB = nB; ++ui;
    }
    PG8_WAIT_V(0);
    if (wr == 0) PG8_BAR;
    PG8_BAR;
    if constexpr (Epi::AFTER_DRAIN) { E.fused(acc, cur, wr, wc, fr, fq, lds, wid, lane); S.done(cur); }
    PG8_STAMP();
    if (STAMP && wid == 0) { stamps[lane] = lane < nts ? (((unsigned long long)(unsigned)ts_hi << 32) | (unsigned)ts_lo) : 0ull;
        if (lane == 62) stamps[62] = rt_entry; if (lane == 63) stamps[63] = (unsigned long long)wall_clock64(); }
#undef PG8_STAMP
#undef PG8_SA
#undef PG8_SB
#undef PG8_STAGE
#undef PG8_LDA
#undef PG8_LDB
#undef PG8_MMA
#undef PG8_WAIT_V
#undef PG8_WAIT_L
#undef PG8_BAR
#undef PG8_SCHED
}
}

struct P1Desc {
    static constexpr bool FP8 = false;
    struct U { int mt, nt; };
    struct R { float rs[4]; };
    const char* xb; const char* w; bf16_t* proj; const float* rstd1; int bid, nb;
    __device__ __forceinline__ bool get(int i, U& u) const { const int uu = i * nb + bid; if (uu >= 2048) return false;
        const int g = uu >> 8, b = uu & 255, xcd = b & 7, j = b >> 3; u.mt = g * 16 + (xcd >> 1) * 4 + (j >> 3); u.nt = (xcd & 1) * 8 + (j & 7); return true; }
    __device__ __forceinline__ int nk() const { return 16; }
    __device__ __forceinline__ unsigned aoff(const U& u, int row) const { return (unsigned)(u.mt * 256 + row) * 2048u; }
    __device__ __forceinline__ unsigned boff(const U& u, int rho) const { return (unsigned)(u.nt * 128 + perm_row<4>(rho)) * 2048u; }
    __device__ __forceinline__ const char* abase(const U&, int kt) const { return xb + kt * 128; }
    __device__ __forceinline__ const char* bbase(const U&, int kt) const { return w + kt * 128; }
    __device__ __forceinline__ void* sink() const { return (void*)proj; }
    template <class Acc> __device__ __forceinline__ void init(const U& u, Acc& acc, R& r, int wr, int wc, int fr, int fq) const {
#pragma unroll
        for (int m = 0; m < 4; ++m) { r.rs[m] = rstd1[u.mt * 256 + wr * 64 + m * 16 + fr];
#pragma unroll
            for (int n = 0; n < 4; ++n) acc[m][n] = (f32x4){0.f, 0.f, 0.f, 0.f}; }
    }
    template <class Acc> __device__ __forceinline__ void epi(const U& u, Acc& acc, const R& r, int wr, int wc, int fr, int fq) const {
        const int col = u.nt * 128 + wc * 64 + fq * 16;
#pragma unroll
        for (int m = 0; m < 4; ++m) { const int row = u.mt * 256 + wr * 64 + m * 16 + fr; const float rs = r.rs[m];
            bf16_t* dst = proj + (size_t)row * NP + col;
#pragma unroll
            for (int h = 0; h < 2; ++h) { const f32x4 a = acc[m][2 * h] * rs, b = acc[m][2 * h + 1] * rs;
                *(uint4*)(dst + 8 * h) = make_uint4(pack2(a[0], a[1]), pack2(a[2], a[3]), pack2(b[0], b[1]), pack2(b[2], b[3])); } }
    }
};
template <int MODE = 0> __device__ __forceinline__ void phase1(const Params& p, LAS unsigned char* lds, int bid, int nb) {
    pg8::Gemm g; g.A = (const pg8::bf16_t*)(p.ws + OFF_A); g.Bt = (const pg8::bf16_t*)(p.ws + OFF_WIN); g.M = T; g.N = NG; g.K = D;
    pg8::StaticOrder S; S.init(T, NG, nb, bid);
    pg8::EpiProj E; E.proj = (unsigned short*)(p.ws + OFF_B); E.rstd = (const float*)(p.ws + OFF_RSTD1);
    pg8::gemm_phase<pg8::EpiProj, pg8::StaticOrder>(lds, g, S, E, nullptr);
}
struct P3Desc {
    static constexpr bool FP8 = false;
    __device__ __forceinline__ void* sink() const { return (void*)hb; }
    struct U { int mt, nt; };
    struct R { int dummy; };
    const char* y; const char* w; const bf16_t* xb; bf16_t* hb; unsigned char* hb8; float* ssq2; int bid, nb;
    __device__ __forceinline__ bool get(int i, U& u) const { const int uu = i * nb + bid; if (uu >= 1024) return false;
        const int g = uu >> 8, b = uu & 255, xcd = b & 7, j = b >> 3; u.mt = g * 32 + xcd * 4 + (j >> 3); u.nt = j & 7; return true; }
    __device__ __forceinline__ int nk() const { return 16; }
    __device__ __forceinline__ unsigned aoff(const U& u, int row) const { return (unsigned)(u.mt * 256 + row) * 2048u; }
    __device__ __forceinline__ unsigned boff(const U& u, int rho) const { return (unsigned)(u.nt * 128 + perm_row<4>(rho)) * 2048u; }
    __device__ __forceinline__ const char* abase(const U&, int kt) const { return y + kt * 128; }
    __device__ __forceinline__ const char* bbase(const U&, int kt) const { return w + kt * 128; }
    template <class Acc> __device__ __forceinline__ void init(const U& u, Acc& acc, R& r, int wr, int wc, int fr, int fq) const {
        const int col = u.nt * 128 + wc * 64 + fq * 16;
#pragma unroll
        for (int m = 0; m < 4; ++m) { const size_t o = (size_t)(u.mt * 256 + wr * 64 + m * 16 + fr) * D + col;
#pragma unroll
            for (int h = 0; h < 2; ++h) { const uint4 xr = *(const uint4*)(xb + o + 8 * h);
                acc[m][2 * h] = (f32x4){lo_bf(xr.x), hi_bf(xr.x), lo_bf(xr.y), hi_bf(xr.y)}; acc[m][2 * h + 1] = (f32x4){lo_bf(xr.z), hi_bf(xr.z), lo_bf(xr.w), hi_bf(xr.w)}; } }
    }
    template <class Acc> __device__ __forceinline__ void epi(const U& u, Acc& acc, const R& r, int wr, int wc, int fr, int fq) const {
        const int col = u.nt * 128 + wc * 64 + fq * 16;
#pragma unroll
        for (int m = 0; m < 4; ++m) { const int row = u.mt * 256 + wr * 64 + m * 16 + fr; const size_t o = (size_t)row * D + col; float ss = 0.f;
            *(uint4*)(hb8 + o) = make_uint4(pack4_fp8(acc[m][0][0] * SC_H8, acc[m][0][1] * SC_H8, acc[m][0][2] * SC_H8, acc[m][0][3] * SC_H8), pack4_fp8(acc[m][1][0] * SC_H8, acc[m][1][1] * SC_H8, acc[m][1][2] * SC_H8, acc[m][1][3] * SC_H8),
                                            pack4_fp8(acc[m][2][0] * SC_H8, acc[m][2][1] * SC_H8, acc[m][2][2] * SC_H8, acc[m][2][3] * SC_H8), pack4_fp8(acc[m][3][0] * SC_H8, acc[m][3][1] * SC_H8, acc[m][3][2] * SC_H8, acc[m][3][3] * SC_H8));
#pragma unroll
            for (int h = 0; h < 2; ++h) { const f32x4 a = acc[m][2 * h], b = acc[m][2 * h + 1];
                *(uint4*)(hb + o + 8 * h) = make_uint4(pack2(a[0], a[1]), pack2(a[2], a[3]), pack2(b[0], b[1]), pack2(b[2], b[3]));
                ss += a[0] * a[0] + a[1] * a[1] + a[2] * a[2] + a[3] * a[3] + b[0] * b[0] + b[1] * b[1] + b[2] * b[2] + b[3] * b[3]; }
            ss += __shfl_xor(ss, 16); ss += __shfl_xor(ss, 32);
            if (fq == 0) ssq2[(size_t)row * 16 + u.nt * 2 + wc] = ss; }
    }
};
__device__ __forceinline__ void phase3(const Params& p, LAS unsigned char* lds, int bid, int nb) {
    pg8::Gemm g; g.A = (const pg8::bf16_t*)(p.ws + OFF_C); g.Bt = (const pg8::bf16_t*)(p.ws + OFF_WOUT); g.M = T; g.N = D; g.K = D;
    pg8::StaticOrder S; S.init(T, D, nb, bid);
    pg8::EpiOut E; E.xb = (const unsigned short*)(p.ws + OFF_A); E.hb = (unsigned short*)(p.ws + OFF_H); E.hb8 = p.ws + OFF_H8; E.ssq2 = (float*)(p.ws + OFF_SSQ2);
    pg8::gemm_phase<pg8::EpiOut, pg8::StaticOrder>(lds, g, S, E, nullptr);
}
struct P4Desc {
    static constexpr bool FP8 = false;
    __device__ __forceinline__ void* sink() const { return (void*)ws; }
    struct U { int u; };
    struct R { int dummy; };
    template <class Acc> __device__ __forceinline__ void init(const U&, Acc& acc, R&, int, int, int, int) const {
#pragma unroll
        for (int n = 0; n < 4; ++n) acc[0][n] = (f32x4){0.f, 0.f, 0.f, 0.f}; }
    const char* hb; const char* w; const float* ssq2; unsigned char* ws; LAS unsigned char* lds; int bid, nb;
    __device__ __forceinline__ bool get(int i, U& u) const { u.u = i * nb + bid; return u.u < 256; }
    __device__ __forceinline__ int nk() const { return 16; }
    __device__ __forceinline__ unsigned aoff(const U& u, int row) const { return (unsigned)(u.u * 128 + row) * 2048u; }
    __device__ __forceinline__ unsigned boff(const U&, int rho) const { return (unsigned)rho * 2048u; }
    __device__ __forceinline__ const char* abase(const U&, int kt) const { return hb + kt * 128; }
    __device__ __forceinline__ const char* bbase(const U&, int kt) const { return w + kt * 128; }
    template <class Acc> __device__ __forceinline__ void epi(const U& uu, Acc& acc, const R&, int wr, int wc, int fr, int fq) const {
        LAS int* hist = (LAS int*)(lds + LDS_MISC);
        LAS int* base = (LAS int*)(lds + LDS_MISC + 1024);
        LAS float* lg = (LAS float*)(lds + 98304);
        int* cnt = (int*)(ws + OFF_CNT); int* el = (int*)(ws + OFF_EL); int* pl = (int*)(ws + OFF_PL);
        __syncthreads();
#pragma unroll
        for (int n = 0; n < 4; ++n)
#pragma unroll
            for (int j = 0; j < 4; ++j) { const int col = n * 16 + fq * 4 + j; if (col < 36) lg[(wr * 16 + fr) * 37 + col] = acc[0][n][j]; }
        if (threadIdx.x < 144) hist[threadIdx.x] = 0;
        __syncthreads();
        const int t = tid_fresh(), r = uu.u * 128 + t;
        int e0 = 0, e1 = 0, bucket = 0, r0 = 0, r1 = 0, rb = 0; float ga = 0.f, gb = 0.f, rstd2 = 0.f;
        if (t < 128) { const float* q = ssq2 + (size_t)r * 16; float ss = 0.f;
#pragma unroll
            for (int j = 0; j < 16; ++j) ss += q[j];
            rstd2 = rsqrtf(ss * (1.0f / D) + EPS);
            const LAS float* mine = lg + t * 37;
            int gs = 0; float gm = mine[0];
#pragma unroll
            for (int j = 1; j < 4; ++j) { const float v = mine[j]; if (v > gm) { gm = v; gs = j; } }
            float den = 0.f;
#pragma unroll
            for (int j = 0; j < 4; ++j) den += __expf((mine[j] - gm) * rstd2);
            const float g1 = 1.0f / den;
            const LAS float* le = mine + 4 + gs * 8;
            int i0 = 0; float l0 = le[0];
#pragma unroll
            for (int j = 1; j < 8; ++j) { const float v = le[j]; if (v > l0) { l0 = v; i0 = j; } }
            int i1 = -1; float l1 = -3.0e38f;
#pragma unroll
            for (int j = 0; j < 8; ++j) { const float v = le[j]; if (j != i0 && v > l1) { l1 = v; i1 = j; } }
            const float w0 = 1.0f / (1.0f + __expf((l1 - l0) * rstd2)), w1 = 1.0f - w0;
            int a = i0, bb = i1; ga = g1 * w0; gb = g1 * w1;
            if (a > bb) { const int ti = a; a = bb; bb = ti; const float tf = ga; ga = gb; gb = tf; }
            e0 = gs * 8 + a; e1 = gs * 8 + bb; bucket = gs * 28 + pair_off(a) + (bb - a - 1);
            r0 = __hip_atomic_fetch_add(&hist[e0], 1, __ATOMIC_RELAXED, __HIP_MEMORY_SCOPE_WORKGROUP); r1 = __hip_atomic_fetch_add(&hist[e1], 1, __ATOMIC_RELAXED, __HIP_MEMORY_SCOPE_WORKGROUP);
            rb = __hip_atomic_fetch_add(&hist[32 + bucket], 1, __ATOMIC_RELAXED, __HIP_MEMORY_SCOPE_WORKGROUP); }
        __syncthreads();
        if (t < 144) { const int c = hist[t]; base[t] = c ? atomicAdd(&cnt[t], c) : 0; }
        __syncthreads();
        if (t < 128) { int4 rec; rec.x = e0 | (e1 << 8) | (bucket << 16); rec.y = __float_as_int(ga); rec.z = __float_as_int(gb); rec.w = __float_as_int(rstd2);
            float* ers = (float*)(ws + OFF_ERS);
            const size_t p0 = (size_t)e0 * T + base[e0] + r0, p1 = (size_t)e1 * T + base[e1] + r1;
            el[p0] = (r << 17) | (int)f2bf(ga); el[p1] = (r << 17) | (1 << 16) | (int)f2bf(gb); ers[p0] = rstd2; ers[p1] = rstd2;
            pl[(size_t)bucket * T + base[32 + bucket] + rb] = r; }
    }
};
__device__ __forceinline__ void phase4(const Params& p, LAS unsigned char* lds, int bid, int nb) {
    P4Desc d; d.hb = (const char*)(p.ws + OFF_H); d.w = (const char*)(p.ws + OFF_WR); d.ssq2 = (const float*)(p.ws + OFF_SSQ2); d.ws = p.ws; d.lds = lds; d.bid = bid; d.nb = nb;
    gemm_stream<CfgR>(lds, d);
}
__device__ __forceinline__ int wave_prefix128(int v0, int v1, int& ex0, int& ex1) {
    const int lane = threadIdx.x & 63; int s0 = v0, s1 = v1;
#pragma unroll
    for (int o = 1; o < 64; o <<= 1) { const int t0 = __shfl_up(s0, o), t1 = __shfl_up(s1, o); if (lane >= o) { s0 += t0; s1 += t1; } }
    const int tot0 = __shfl(s0, 63), tot1 = __shfl(s1, 63);
    ex0 = s0 - v0; ex1 = tot0 + s1 - v1; return tot0 + tot1;
}
template <int TMV>
struct P5aDescT {
    static constexpr bool FP8 = true;
    __device__ __forceinline__ void* sink() const { return (void*)act; }
    struct U { int e, row0, ntile, ce; };
    struct R { int ent[TMV]; float rs[TMV]; };
    const char* hb8; const char* wgu; unsigned char* act; const int* cnt; const int* el; const float* ers; LAS int* pre; int bid, nb;
    __device__ __forceinline__ bool get(int i, U& u) const {
        const int total = pre[NE], nfull = total / nb, rem = total - nfull * nb; const bool split = rem > 0 && 2 * rem <= nb;
        int uu, half = 0;
        if (TMV == 4) { if (i > nfull || (i == nfull && split)) return false; uu = i * nb + bid; if (uu >= total) return false; }
        else { if (i != 0 || !split || bid >= 2 * rem) return false; uu = nfull * nb + (bid >> 1); half = bid & 1; }
        const int ln = threadIdx.x & 63; const int e = __builtin_popcountll(__ballot(ln < NE && pre[ln + 1] <= uu));
        const int local = uu - pre[e]; u.e = e; u.row0 = (local >> 2) * 256 + half * 128; u.ntile = local & 3; u.ce = pre[40 + e]; return true; }
    __device__ __forceinline__ int nk() const { return 8; }
    __device__ __forceinline__ unsigned aoff(const U& u, int row) const { const int li = min(u.row0 + row, u.ce - 1); return ((unsigned)el[(size_t)u.e * T + li] >> 17) * 1024u; }
    __device__ __forceinline__ unsigned boff(const U& u, int rho) const {
        const int w = rho & 31, n2 = w >> 4, q = (w >> 2) & 3, j = w & 3;
        return (unsigned)(u.e * 512 + u.ntile * 128 + (rho & ~31) + q * 8 + n2 * 4 + j) * 1024u; }
    __device__ __forceinline__ const char* abase(const U&, int kt) const { return hb8 + kt * 128; }
    __device__ __forceinline__ const char* bbase(const U&, int kt) const { return wgu + kt * 128; }
    template <class Acc> __device__ __forceinline__ void init(const U& u, Acc& acc, R& r, int wr, int wc, int fr, int fq) const {
        const size_t lb = (size_t)u.e * T;
        const int lq = min(u.row0 + wr * (TMV * 16) + (fq % TMV) * 16 + fr, u.ce - 1);
        const int eq = el[lb + lq]; const float rq = ers[lb + lq];
#pragma unroll
        for (int m = 0; m < TMV; ++m) { r.ent[m] = __shfl(eq, fr + 16 * m); r.rs[m] = __shfl(rq, fr + 16 * m);
#pragma unroll
            for (int n = 0; n < 4; ++n) acc[m][n] = (f32x4){0.f, 0.f, 0.f, 0.f}; }
    }
    template <class Acc> __device__ __forceinline__ void epi(const U& u, Acc& acc, const R& r, int wr, int wc, int fr, int fq) const {
#pragma unroll
        for (int m = 0; m < TMV; ++m) { const unsigned ent = (unsigned)r.ent[m]; const int tok = ent >> 17, slot = (ent >> 16) & 1;
            const float gate = __uint_as_float(ent << 16) * SC_ACT, rs = r.rs[m] * (1.0f / (SC_H8 * SC_WGU));
            float a[8];
#pragma unroll
            for (int n = 0; n < 2; ++n)
#pragma unroll
                for (int j = 0; j < 4; ++j) { const float G = acc[m][n][j] * rs, Uv = acc[m][n + 2][j] * rs; a[n * 4 + j] = G * __builtin_amdgcn_rcpf(1.0f + __expf(-G)) * Uv * gate; }
            *(uint2*)(act + (size_t)tok * 512 + slot * 256 + u.ntile * 64 + wc * 32 + fq * 8) = make_uint2(pack4_fp8(a[0], a[1], a[2], a[3]), pack4_fp8(a[4], a[5], a[6], a[7])); }
    }
};
typedef P5aDescT<4> P5aDesc;
typedef GemmCfg<4, 2, 2, 4, 64, 3> CfgA2;
template <int MODE = 0> __device__ __forceinline__ void phase5a(const Params& p, LAS unsigned char* lds, int bid, int nb) {
    P5aDesc d; d.hb8 = (const char*)(p.ws + OFF_H8); d.wgu = (const char*)(p.ws + OFF_WGU); d.act = p.ws + OFF_B; d.cnt = (const int*)(p.ws + OFF_CNT);
    d.el = (const int*)(p.ws + OFF_EL); d.ers = (const float*)(p.ws + OFF_ERS); d.pre = (LAS int*)(lds + LDS_MISC); d.bid = bid; d.nb = nb;
    __syncthreads();
    if (threadIdx.x < 64) { const int ln = threadIdx.x; const int c = ln < NE ? d.cnt[ln] : 0; int ex0, ex1; const int tot = wave_prefix128(((c + 255) >> 8) * 4, 0, ex0, ex1);
        if (ln < NE) { d.pre[ln] = ex0; d.pre[40 + ln] = c; } if (ln == 0) d.pre[NE] = tot; }
    __syncthreads();
    gemm_stream3<CfgA, P5aDesc, MODE>(lds, d);
    { P5aDescT<2> d2; d2.hb8 = d.hb8; d2.wgu = d.wgu; d2.act = d.act; d2.cnt = d.cnt; d2.el = d.el; d2.ers = d.ers; d2.pre = d.pre; d2.bid = bid; d2.nb = nb;
      gemm_stream3<CfgA2, P5aDescT<2>, MODE>(lds, d2); }
}
template <int MODE = 0>
__device__ __forceinline__ void phase5b(const Params& p, LAS unsigned char* lds, int bid, int nb, float* dst) {
    constexpr int A_BYTES = 64 * 128, B_BYTES = 512 * 128, ST = A_BYTES + B_BYTES;
    const char* act = (const char*)(p.ws + OFF_B); const char* wd = (const char*)(p.ws + OFF_WD);
    const int* cnt = (const int*)(p.ws + OFF_CNT) + 32; const int* pl = (const int*)(p.ws + OFF_PL); const bf16_t* hb = (const bf16_t*)(p.ws + OFF_H);
    LAS int* pre = (LAS int*)(lds + LDS_MISC); LAS float* red = (LAS float*)(lds + LDS_MISC + 1024); LAS float* fn = (LAS float*)(lds + LDS_MISC + 4096);
    const int tid = tid_fresh(), wid = __builtin_amdgcn_readfirstlane(tid >> 6), lane = tid & 63, wc = wid, fr = lane & 15, fq = lane >> 4;
    __syncthreads();
    fn[tid] = p.final_norm[tid]; fn[tid + 512] = p.final_norm[tid + 512];
    if (tid < 64) { const int c0 = cnt[tid], c1 = (tid + 64 < NBUCK) ? cnt[tid + 64] : 0; int ex0, ex1; const int tot = wave_prefix128((c0 + 63) >> 6, (c1 + 63) >> 6, ex0, ex1);
        pre[tid] = ex0; pre[128 + tid] = c0; if (tid + 64 < NBUCK) { pre[tid + 64] = ex1; pre[128 + tid + 64] = c1; } if (tid == 0) pre[NBUCK] = tot; }
    __syncthreads();
    const int total = pre[NBUCK];
    struct U { int b, mtile, cb, e0, e1, hm, j; };
    const int nfull = total / nb, rem = total - nfull * nb; const bool split = rem > 0 && 2 * rem <= nb;
    auto get = [&](int i, U& u) -> bool {
        int uu;
        if (i < nfull) { uu = i * nb + bid; u.hm = 3; u.j = 0; }
        else if (i == nfull && split) { if (bid >= 2 * rem) return false; uu = nfull * nb + (bid >> 1); u.hm = 1 << (bid & 1); u.j = bid >> 1; }
        else if (i == nfull) { uu = i * nb + bid; if (uu >= total) return false; u.hm = 3; u.j = 0; }
        else return false;
        const int ln = threadIdx.x & 63; const int b = __builtin_popcountll(__ballot(pre[ln + 1] <= uu)) + __builtin_popcountll(__ballot(ln + 64 < NBUCK && pre[ln + 65] <= uu));
        u.b = b; u.mtile = uu - pre[b]; u.cb = pre[128 + b]; const int g = b / 28, pi = b % 28;
        int a = 0;
#pragma unroll
        for (int q = 1; q < 7; ++q) a += (pair_off(q) <= pi) ? 1 : 0;
        u.e0 = g * 8 + a; u.e1 = g * 8 + a + 1 + (pi - pair_off(a)); return true; };
    U us, uc; int is = 0, ts = 0;
    bool more = get(0, us);
    if (!more) return;
    ts = (us.hm == 2) ? 4 : 0;
    unsigned offA, offB[8];
    {
#pragma unroll
        for (int i = 0; i < 8; ++i) { const int rho = (wid + 8 * i) * 8 + (lane >> 3); offB[i] = (unsigned)rho * 256u + (unsigned)swz_slot<64>(rho, lane & 7) * 16u; }
    }
    auto set_a = [&](const U& u) { const int row = wid * 8 + (lane >> 3), li = min(u.mtile * 64 + row, u.cb - 1);
        offA = (unsigned)pl[(size_t)u.b * T + li] * 512u + (unsigned)swz_slot<64>(row, lane & 7) * 16u; };
    set_a(us);
    int sbuf = 0;
    auto stage_next = [&]() {
        if (!more) return;
        const int nh = ts >> 2, kt = ts & 3;
        const char* ab = act + kt * 128;
        const char* bb = wd + (size_t)(kt < 2 ? us.e0 : us.e1) * (D * DE) + (kt & 1) * 128 + (size_t)nh * (512 * 256);
        LAS unsigned char* sa = lds + sbuf;
        if (!(MODE & 4)) {
        __builtin_amdgcn_global_load_lds((const unsigned*)(ab + offA), (LAS unsigned*)(sa + wid * 1024), 16, 0, 0);
#pragma unroll
        for (int i = 0; i < 8; ++i) __builtin_amdgcn_global_load_lds((const unsigned*)(bb + offB[i]), (LAS unsigned*)(sa + A_BYTES + (wid + 8 * i) * 1024), 16, 0, 0);
        }
        sbuf ^= ST;
        if (++ts == ((us.hm == 1) ? 4 : 8)) { ++is; more = get(is, us); if (more) { set_a(us); ts = (us.hm == 2) ? 4 : 0; } }
    };
    int aread[2], bread[2];
#pragma unroll
    for (int ks = 0; ks < 2; ++ks) { aread[ks] = fr * 128 + swz_slot<64>(fr, ks * 4 + fq) * 16; bread[ks] = A_BYTES + (wc * 64 + fr) * 128 + swz_slot<64>(fr, ks * 4 + fq) * 16; }
    f32x4 acc[2][4][4];
    int tok[4];
    __syncthreads();
    stage_next();
    int cbuf = 0;
    for (int ic = 0; get(ic, uc); ++ic) {
        {
            const int* list = pl + (size_t)uc.b * T;
#pragma unroll
            for (int m = 0; m < 4; ++m) tok[m] = list[min(uc.mtile * 64 + m * 16 + fr, uc.cb - 1)];
#pragma unroll
            for (int nh = 0; nh < 2; ++nh) {
                if (uc.hm & (1 << nh)) {
#pragma unroll
                    for (int m = 0; m < 4; ++m) { const bf16_t* hr = hb + (size_t)tok[m] * D + nh * 512 + wc * 64 + (fq & 1) * 16 + (fq >> 1) * 8;
#pragma unroll
                        for (int pr = 0; pr < 2; ++pr) { uint4 xr = *(const uint4*)(hr + pr * 32);
                            swap16(xr.x, xr.z); swap16(xr.y, xr.w);
                            acc[nh][m][2 * pr] = (f32x4){lo_bf(xr.x), hi_bf(xr.x), lo_bf(xr.y), hi_bf(xr.y)} * (SC_ACT * SC_WD);
                            acc[nh][m][2 * pr + 1] = (f32x4){lo_bf(xr.z), hi_bf(xr.z), lo_bf(xr.w), hi_bf(xr.w)} * (SC_ACT * SC_WD); } }
                } else {
#pragma unroll
                    for (int m = 0; m < 4; ++m)
#pragma unroll
                        for (int n = 0; n < 4; ++n) acc[nh][m][n] = (f32x4){0.f, 0.f, 0.f, 0.f};
                }
            }
        }
#pragma unroll
        for (int nh = 0; nh < 2; ++nh)
        if (uc.hm & (1 << nh))
#pragma nounroll
        for (int kt4 = 0; kt4 < 4; ++kt4) {
            asm volatile("s_waitcnt vmcnt(0)" ::: "memory");
            __builtin_amdgcn_s_barrier();
            asm volatile("" ::: "memory");
            stage_next();
            if (!(MODE & 2)) {
            const LAS unsigned char* sa = lds + cbuf;
            {
                i32x8 af[4];
#pragma unroll
                for (int m = 0; m < 4; ++m) af[m] = cat8(*(const LAS bf16x8*)(sa + aread[0] + m * 16 * 128), *(const LAS bf16x8*)(sa + aread[1] + m * 16 * 128));
#pragma unroll
                for (int np = 0; np < 2; ++np) {
                    i32x8 bfr[2];
#pragma unroll
                    for (int n = 0; n < 2; ++n) bfr[n] = cat8(*(const LAS bf16x8*)(sa + bread[0] + (np * 2 + n) * 16 * 128), *(const LAS bf16x8*)(sa + bread[1] + (np * 2 + n) * 16 * 128));
#pragma unroll
                    for (int m = 0; m < 4; ++m)
#pragma unroll
                        for (int n = 0; n < 2; ++n) acc[nh][m][np * 2 + n] = MFMA_F8_K128(bfr[n], af[m], acc[nh][m][np * 2 + n]);
                }
            }
            }
            cbuf ^= ST;
        }
        if (!(MODE & 1)) {
            constexpr float inv = 1.0f / (SC_ACT * SC_WD);
#pragma unroll
            for (int m = 0; m < 4; ++m) { float ss = 0.f;
#pragma unroll
                for (int nh = 0; nh < 2; ++nh)
#pragma unroll
                    for (int n = 0; n < 4; ++n) { acc[nh][m][n] *= inv; ss += acc[nh][m][n][0] * acc[nh][m][n][0] + acc[nh][m][n][1] * acc[nh][m][n][1] + acc[nh][m][n][2] * acc[nh][m][n][2] + acc[nh][m][n][3] * acc[nh][m][n][3]; }
                ss += __shfl_xor(ss, 16); ss += __shfl_xor(ss, 32);
                if (fq == 0) red[(m * 16 + fr) * 8 + wc] = ss; }
            __syncthreads();
            float ssr[4];
#pragma unroll
            for (int m = 0; m < 4; ++m) { float ss = 0.f;
#pragma unroll
                for (int w8 = 0; w8 < 8; ++w8) ss += red[(m * 16 + fr) * 8 + w8];
                ssr[m] = ss; }
            if (uc.hm != 3) {
                float* xch = (float*)(p.ws + OFF_RT) + (size_t)uc.j * 128; unsigned* flag = (unsigned*)(p.ws + OFF_BAR + 15360) + uc.j; const int hf = uc.hm >> 1;
                if (wid == 0 && fq == 0) {
#pragma unroll
                    for (int m = 0; m < 4; ++m) __hip_atomic_store(xch + hf * 64 + m * 16 + fr, ssr[m], __ATOMIC_RELAXED, __HIP_MEMORY_SCOPE_AGENT);
                }
                asm volatile("s_waitcnt vmcnt(0)" ::: "memory");
                __syncthreads();
                if (tid == 0) __hip_atomic_fetch_add(flag, 1u, __ATOMIC_RELAXED, __HIP_MEMORY_SCOPE_AGENT);
                if (wid == 0) { unsigned sp = 0;
                    while ((unsigned)__builtin_amdgcn_readfirstlane(__hip_atomic_load(flag, __ATOMIC_RELAXED, __HIP_MEMORY_SCOPE_AGENT)) < 2u && ++sp < (1u << 22)) __builtin_amdgcn_s_sleep(2);
                    __builtin_amdgcn_fence(__ATOMIC_ACQUIRE, "agent");
                    asm volatile("s_waitcnt vmcnt(0)" ::: "memory"); }
                __syncthreads();
#pragma unroll
                for (int m = 0; m < 4; ++m) ssr[m] += __hip_atomic_load(xch + (hf ^ 1) * 64 + m * 16 + fr, __ATOMIC_RELAXED, __HIP_MEMORY_SCOPE_AGENT);
            }
#pragma unroll
            for (int m = 0; m < 4; ++m) {
                const float rs = rsqrtf(ssr[m] * (1.0f / D) + EPS);
                if (uc.mtile * 64 + m * 16 + fr < uc.cb) {
#pragma unroll
                    for (int nh = 0; nh < 2; ++nh) if (uc.hm & (1 << nh)) { const int col = nh * 512 + wc * 64 + fq * 4; float* o = dst + (size_t)tok[m] * D + col;
#pragma unroll
                        for (int n = 0; n < 4; ++n) { const f32x4 gf = *(const LAS f32x4*)(fn + col + n * 16);
                            *(float4*)(o + n * 16) = make_float4(acc[nh][m][n][0] * rs * gf[0], acc[nh][m][n][1] * rs * gf[1], acc[nh][m][n][2] * rs * gf[2], acc[nh][m][n][3] * rs * gf[3]); } } } }
            __syncthreads();
        } else { float s = 0.f;
#pragma unroll
            for (int nh = 0; nh < 2; ++nh)
#pragma unroll
                for (int m = 0; m < 4; ++m)
#pragma unroll
                    for (int n = 0; n < 4; ++n) s += acc[nh][m][n][0] + acc[nh][m][n][1] + acc[nh][m][n][2] + acc[nh][m][n][3];
            if (s == 123.456f) *dst = s; }
    }
    asm volatile("s_waitcnt vmcnt(0)" ::: "memory");
}
__device__ __forceinline__ void unpack8(const uint4 v, float* f) {
    f[0] = __uint_as_float(v.x << 16); f[1] = __uint_as_float(v.x & 0xffff0000u); f[2] = __uint_as_float(v.y << 16); f[3] = __uint_as_float(v.y & 0xffff0000u);
    f[4] = __uint_as_float(v.z << 16); f[5] = __uint_as_float(v.z & 0xffff0000u); f[6] = __uint_as_float(v.w << 16); f[7] = __uint_as_float(v.w & 0xffff0000u);
}
__device__ __forceinline__ void phase2(const Params& p, LAS unsigned char* lds, int bid, int nb) {
    const int tid = tid_fresh(), wid = __builtin_amdgcn_readfirstlane(tid >> 6), lane = tid & 63, fr = lane & 15, fq = lane >> 4;
    bf16_t* y = (bf16_t*)(p.ws + OFF_C);
    LAS float* red = (LAS float*)(lds + LDS_MISC + 1024);
    const int cch = lane * 8;
    const int g = wid >> 1, nh = wid & 1;
    const bf16_t* pw = (const bf16_t*)(p.ws + OFF_POOL);
    for (int unit = bid; unit < T / 64; unit += nb) {
        const int R0 = unit * 64, b = R0 >> 13, s0 = R0 & 8191;
        __syncthreads();
        {
            const int cvl = lane & 15, rq = lane >> 4, rbase = (wid & 1) * 32 + rq * 8, col = 1024 + g * 128 + cvl * 8;
            auto pooled_rows = [&](auto wc_) {
                constexpr int W = decltype(wc_)::value;
                constexpr float invw = 1.0f / (float)W;
                uint4 raw[W + 7];
#pragma unroll
                for (int q = 0; q < W + 7; ++q) raw[q] = *(const uint4*)(proj_row(p, b, s0 + rbase - (W - 1) + q) + col);
                float run[8], f[8];
#pragma unroll
                for (int j = 0; j < 8; ++j) run[j] = 0.f;
#pragma unroll
                for (int q = 0; q < W - 1; ++q) { unpack8(raw[q], f);
#pragma unroll
                    for (int j = 0; j < 8; ++j) run[j] += f[j]; }
#pragma unroll
                for (int i = 0; i < 8; ++i) { const int row = rbase + i;
                    unpack8(raw[W - 1 + i], f);
                    float pv[8];
#pragma unroll
                    for (int j = 0; j < 8; ++j) { run[j] += f[j]; pv[j] = run[j] * invw - f[j]; }
                    *(LAS u32x4*)(lds + g * 16384 + (cvl >> 3) * 8192 + row * 128 + swz_slot<64>(row, cvl & 7) * 16) = (u32x4){pack2(pv[0], pv[1]), pack2(pv[2], pv[3]), pack2(pv[4], pv[5]), pack2(pv[6], pv[7])};
                    unpack8(raw[i], f);
#pragma unroll
                    for (int j = 0; j < 8; ++j) run[j] -= f[j]; }
            };
            if (g == 0) pooled_rows(std::integral_constant<int, 2>{});
            else if (g == 1) pooled_rows(std::integral_constant<int, 4>{});
            else if (g == 2) pooled_rows(std::integral_constant<int, 8>{});
            else pooled_rows(std::integral_constant<int, 16>{});
        }
        {
            const int sb = s0 + wid * 8;
            float w0[8], w1[8], w2[8];
#pragma unroll
            for (int j = 0; j < 8; ++j) { w0[j] = p.conv_w[cch + j]; w1[j] = p.conv_w[512 + cch + j]; w2[j] = p.conv_w[1024 + cch + j]; }
            float u2[8], u1[8], u0[8], b8[8];
            { const uint4 h2 = *(const uint4*)(proj_row(p, b, sb - 2) + 512 + cch), h1 = *(const uint4*)(proj_row(p, b, sb - 1) + 512 + cch); unpack8(h2, u2); unpack8(h1, u1); }
#pragma unroll
            for (int hb4 = 0; hb4 < 2; ++hb4) {
                uint4 uq[4], bq8[4];
#pragma unroll
                for (int i = 0; i < 4; ++i) { const bf16_t* r = proj_row(p, b, sb + hb4 * 4 + i); bq8[i] = *(const uint4*)(r + cch); uq[i] = *(const uint4*)(r + 512 + cch); }
#pragma unroll
                for (int i = 0; i < 4; ++i) {
                    unpack8(bq8[i], b8); unpack8(uq[i], u0);
                    float raw[8]; float ss = 0.f;
#pragma unroll
                    for (int j = 0; j < 8; ++j) { raw[j] = b8[j] * (w0[j] * u2[j] + w1[j] * u1[j] + w2[j] * u0[j]); ss += raw[j] * raw[j]; u2[j] = u1[j]; u1[j] = u0[j]; }
                    ss = wave_sum(ss); const float rs = rsqrtf(ss * (1.0f / 512) + EPS);
                    *(uint4*)(y + (size_t)(R0 + wid * 8 + hb4 * 4 + i) * D + cch) = make_uint4(pack2(raw[0] * rs, raw[1] * rs), pack2(raw[2] * rs, raw[3] * rs), pack2(raw[4] * rs, raw[5] * rs), pack2(raw[6] * rs, raw[7] * rs)); }
            }
        }
        bf16x8 bfr[4][4];
#pragma unroll
        for (int ks = 0; ks < 4; ++ks)
#pragma unroll
            for (int n = 0; n < 4; ++n) bfr[ks][n] = *(const bf16x8*)(pw + (size_t)(g * 128 + nh * 64 + n * 16 + fr) * 128 + ks * 32 + fq * 8);
        __syncthreads();
        f32x4 acc[4][4];
#pragma unroll
        for (int m = 0; m < 4; ++m)
#pragma unroll
            for (int n = 0; n < 4; ++n) acc[m][n] = (f32x4){0.f, 0.f, 0.f, 0.f};
#pragma unroll
        for (int ks = 0; ks < 4; ++ks) {
            bf16x8 af[4];
#pragma unroll
            for (int m = 0; m < 4; ++m) af[m] = *(const LAS bf16x8*)(lds + g * 16384 + (ks >> 1) * 8192 + (m * 16 + fr) * 128 + swz_slot<64>(fr, (ks & 1) * 4 + fq) * 16);
#pragma unroll
            for (int m = 0; m < 4; ++m)
#pragma unroll
                for (int n = 0; n < 4; ++n) acc[m][n] = __builtin_amdgcn_mfma_f32_16x16x32_bf16(bfr[ks][n], af[m], acc[m][n], 0, 0, 0);
        }
#pragma unroll
        for (int m = 0; m < 4; ++m) { float ss = 0.f;
#pragma unroll
            for (int n = 0; n < 4; ++n) { acc[m][n] *= *(const f32x4*)(p.pool_scale + g * 128 + nh * 64 + n * 16 + fq * 4); ss += acc[m][n][0] * acc[m][n][0] + acc[m][n][1] * acc[m][n][1] + acc[m][n][2] * acc[m][n][2] + acc[m][n][3] * acc[m][n][3]; }
            ss += __shfl_xor(ss, 16); ss += __shfl_xor(ss, 32);
            if (fq == 0) red[(m * 16 + fr) * 8 + wid] = ss; }
        __syncthreads();
#pragma unroll
        for (int m = 0; m < 4; ++m) { float ss = 0.f;
#pragma unroll
            for (int w8 = 0; w8 < 8; ++w8) ss += red[(m * 16 + fr) * 8 + w8];
            const float rs = rsqrtf(ss * (1.0f / 512) + EPS);
#pragma unroll
            for (int pr = 0; pr < 2; ++pr) { const f32x4 va = acc[m][2 * pr] * rs, vb = acc[m][2 * pr + 1] * rs;
                unsigned ax = pack2(va[0], va[1]), ay = pack2(va[2], va[3]), bx = pack2(vb[0], vb[1]), by = pack2(vb[2], vb[3]);
                swap16(ax, bx); swap16(ay, by);
                *(uint4*)(y + (size_t)(R0 + m * 16 + fr) * D + 512 + g * 128 + nh * 64 + pr * 32 + (fq & 1) * 16 + (fq >> 1) * 8) = make_uint4(ax, ay, bx, by); } }
    }
}

#define XB_TMO      128
#define XB_XCNT(j)  (256  + 64 * (j))
#define XB_XSUB(j)  (1280 + 64 * (j))
#define XB_XGEN(j)  (2304 + 64 * (j))
#define XB_TOP      3328
#define XB_TOPGEN   3392
#define XCD_BAR_WORDS 3456
#define XB_SPIN_CAP (1u << 18)
__device__ __forceinline__ unsigned xb_ld(unsigned* p)              { return __hip_atomic_load(p, __ATOMIC_RELAXED, __HIP_MEMORY_SCOPE_AGENT); }
__device__ __forceinline__ unsigned xb_add(unsigned* p, unsigned v) { return __hip_atomic_fetch_add(p, v, __ATOMIC_RELAXED, __HIP_MEMORY_SCOPE_AGENT); }
__device__ __forceinline__ unsigned xb_xcc_id() { return (unsigned)__builtin_amdgcn_s_getreg((3 << 11) | 20) & 0xFu; }
#define XB_SPIN(cond, bar) do { unsigned _sp = 0; while (cond) { __builtin_amdgcn_s_sleep(1); \
    if ((++_sp & 255u) == 0u) { if (xb_ld(&(bar)[XB_TMO])) break; if (_sp > XB_SPIN_CAP) { atomicAdd(&(bar)[XB_TMO], 1u); break; } } } } while (0)
struct XcdBarrier { unsigned* bar; unsigned x; volatile __attribute__((address_space(3))) unsigned* st; };
__device__ __forceinline__ XcdBarrier xcd_barrier_post(unsigned* bar, volatile __attribute__((address_space(3))) unsigned* st) {
    XcdBarrier b; b.bar = bar; b.x = xb_xcc_id(); b.st = st;
    if (threadIdx.x == 0) (void)xb_add(&bar[XB_XCNT(b.x)], 1u);
    return b;
}
__device__ __forceinline__ void xcd_barrier_complete(unsigned* bar, unsigned x, unsigned& nloc, unsigned& nx) {
    const unsigned G = gridDim.x * gridDim.y * gridDim.z;
    unsigned sum, cnt, mine, sp = 0u;
    for (;;) {
        sum = 0u; cnt = 0u; mine = 0u;
#pragma unroll
        for (unsigned j = 0; j < 16; ++j) { const unsigned c = xb_ld(&bar[XB_XCNT(j)]); sum += c; cnt += (c > 0u) ? 1u : 0u; mine = (j == x) ? c : mine; }
        if (sum == G) break;
        __builtin_amdgcn_s_sleep(1);
        if ((++sp & 255u) == 0u) { if (xb_ld(&bar[XB_TMO])) break; if (sp > XB_SPIN_CAP) { atomicAdd(&bar[XB_TMO], 1u); break; } }
    }
    nloc = mine > 0u ? mine : 1u; nx = cnt > 0u ? cnt : 1u;
}
__device__ __forceinline__ void xcd_barrier(const XcdBarrier& b) {
    asm volatile("s_waitcnt vmcnt(0)" ::: "memory");
    __syncthreads();
    if (threadIdx.x == 0) {
        unsigned* bar = b.bar;
        __builtin_amdgcn_s_waitcnt(0);
        unsigned nloc = b.st[0], nx = b.st[1];
        if (nloc == 0u) { xcd_barrier_complete(bar, b.x, nloc, nx); b.st[0] = nloc; b.st[1] = nx; }
        const unsigned old = xb_add(&bar[XB_XSUB(b.x)], 1u);
        const unsigned gen = old / nloc;
        if (old + 1u == (gen + 1u) * nloc) {
            __builtin_amdgcn_fence(__ATOMIC_RELEASE, "agent");
            asm volatile("s_waitcnt vmcnt(0)" ::: "memory");
            const unsigned og = xb_add(&bar[XB_TOP], 1u);
            const unsigned tg = og / nx;
            if (og + 1u == (tg + 1u) * nx) xb_add(&bar[XB_TOPGEN], 1u);
            else XB_SPIN(xb_ld(&bar[XB_TOPGEN]) == tg, bar);
            __builtin_amdgcn_fence(__ATOMIC_ACQUIRE, "agent");
            xb_add(&bar[XB_XGEN(b.x)], 1u);
            asm volatile("s_waitcnt vmcnt(0)" ::: "memory");
        } else {
            XB_SPIN(xb_ld(&bar[XB_XGEN(b.x)]) == gen, bar);
            __builtin_amdgcn_fence(__ATOMIC_ACQUIRE, "agent");
            asm volatile("s_waitcnt vmcnt(0)" ::: "memory");
        }
    }
    __syncthreads();
}

__global__ void __launch_bounds__(512, 2) mega_kernel(Params p) {
    extern __shared__ __attribute__((aligned(16))) unsigned char lds_raw[];
    LAS unsigned char* lds = (LAS unsigned char*)lds_raw;
    cg::grid_group grid = cg::this_grid();
    const int bid = blockIdx.x, nb = gridDim.x;
    volatile LAS unsigned* st = (volatile LAS unsigned*)(lds + LDS_MISC + 3072);
    if (threadIdx.x == 0) { st[0] = 0u; st[1] = 0u; }
    __syncthreads();
    XcdBarrier xb = xcd_barrier_post((unsigned*)(p.ws + OFF_BAR), st);
    if (p.ws == nullptr) grid.sync();
#define SEAM() xcd_barrier(xb)
    phase0(p, lds_raw, bid, nb); SEAM();
#if PROBE_DUP == 0
    phase0<PROBE_MODE>(p, lds_raw, bid, nb); SEAM();
#endif
    phase1(p, lds, bid, nb); SEAM();
#if PROBE_DUP == 1
    phase1<PROBE_MODE>(p, lds, bid, nb); SEAM();
#endif
    phase2(p, lds, bid, nb); SEAM();
#if PROBE_DUP == 2
    phase2(p, lds, bid, nb); SEAM();
#endif
    phase3(p, lds, bid, nb); SEAM();
#if PROBE_DUP == 3
    phase3(p, lds, bid, nb); SEAM();
#endif
    phase4(p, lds, bid, nb); SEAM();
#if PROBE_DUP == 4
    { int* cnt = (int*)(p.ws + OFF_CNT); if (bid == 0 && threadIdx.x < 256) cnt[threadIdx.x] = 0; } SEAM();
    phase4(p, lds, bid, nb); SEAM();
#endif
    phase5a(p, lds, bid, nb); SEAM();
#if PROBE_DUP == 5
    phase5a<PROBE_MODE>(p, lds, bid, nb); SEAM();
#endif
#if PROBE_DUP == 6
    phase5b<PROBE_MODE>(p, lds, bid, nb, (float*)(p.ws + OFF_B + 32 * MiB)); SEAM();
#endif
    phase5b(p, lds, bid, nb, p.out);
}

extern "C" void kernel_launch(void* const* d_in, const int* in_sizes, int n_in, void* d_out, int out_size, void* d_ws, size_t ws_size, hipStream_t stream) {
    static int init = 0;
    static int grid_blocks = 0;
    if (!init) {
        if (ws_size < WS_END) { fprintf(stderr, "workspace too small: %zu < %zu\n", ws_size, (size_t)WS_END); init = -1; return; }
        (void)hipFuncSetAttribute((const void*)mega_kernel, hipFuncAttributeMaxDynamicSharedMemorySize, LDS_BYTES);
        int dev = 0, cus = 0, per_cu = 0;
        (void)hipGetDevice(&dev);
        (void)hipDeviceGetAttribute(&cus, hipDeviceAttributeMultiprocessorCount, dev);
        (void)hipOccupancyMaxActiveBlocksPerMultiprocessor(&per_cu, (const void*)mega_kernel, 512, LDS_BYTES);
        if (per_cu < 1) { fprintf(stderr, "occupancy query says %d blocks/CU\n", per_cu); per_cu = 1; }
        if (per_cu > 1) per_cu = 1;
        grid_blocks = cus * per_cu;
        init = 1;
    }
    if (init < 0) return;
    Params p{};
    const float** f = (const float**)&p;
    for (int i = 0; i < 17; ++i) f[i] = (const float*)d_in[i];
    p.out = (float*)d_out; p.ws = (unsigned char*)d_ws;
    (void)hipMemsetAsync((unsigned char*)d_ws + OFF_BAR, 0, 16384, stream);
    void* args[] = {&p};
    hipError_t e = hipLaunchCooperativeKernel((const void*)mega_kernel, dim3(grid_blocks), dim3(512), args, LDS_BYTES, stream);
    if (e != hipSuccess) fprintf(stderr, "cooperative launch failed: %s (grid %d)\n", hipGetErrorString(e), grid_blocks);
}
```
